# Optimizing an MI355X kernel written in HIP

```python
import jax, jax.numpy as jnp
from jax import lax
import numpy as np

D_MODEL = 1024
BATCH = 32
SEQ = 2048
DEPTH = 4

CONF_WIDTH = D_MODEL // 4
CONF_KERNEL = 31
SC_WIDTH = D_MODEL // 4
SC_KERNEL = 3
ATTN_WIDTH = D_MODEL // 2
ATTN_HEADS = 4
V_HEAD_DIM = ATTN_WIDTH // ATTN_HEADS
QK_HEAD_DIM = V_HEAD_DIM // 2
D_MIX = CONF_WIDTH + SC_WIDTH + ATTN_WIDTH
QK_WIDTH = ATTN_HEADS * 2 * QK_HEAD_DIM
IN_WIDTH = 2 * CONF_WIDTH + 3 * SC_WIDTH + 2 * QK_WIDTH + ATTN_WIDTH
D_FF = -(-8 * D_MODEL // (3 * 256)) * 256
ROPE_THETA = 10000.0
Q_BLOCK = 128
EPS = 1e-6

kernel_name = "hybrid_conformer_shortconv_diffattn_encoder"


def rms_norm(x, g):
    xf = x.astype(jnp.float32)
    y = xf * lax.rsqrt(jnp.mean(xf * xf, axis=-1, keepdims=True) + EPS)
    return (y * g.astype(jnp.float32)).astype(x.dtype)


def modulate(h, shift, scale):
    return h * (1.0 + scale[:, None, :]) + shift[:, None, :]


def depthwise_conv(u, w, b=None):
    k = w.shape[0]
    out = lax.conv_general_dilated(
        u, w[:, None, :].astype(u.dtype), window_strides=(1,),
        padding=[(k // 2, k // 2)], dimension_numbers=("NWC", "WIO", "NWC"),
        feature_group_count=u.shape[-1])
    if b is not None:
        out = out + b.astype(out.dtype)
    return out


def rope_tables(positions):
    inv_freq = ROPE_THETA ** (-jnp.arange(0, QK_HEAD_DIM, 2, dtype=jnp.float32) / QK_HEAD_DIM)
    ang = positions.astype(jnp.float32)[:, None] * inv_freq[None, :]
    ang = jnp.concatenate([ang, ang], axis=-1)
    return jnp.cos(ang), jnp.sin(ang)


def apply_rope(t, cos, sin):
    half = QK_HEAD_DIM // 2
    rot = jnp.concatenate([-t[..., half:], t[..., :half]], axis=-1)
    return t * cos[None, :, None, None, :] + rot * sin[None, :, None, None, :]


def conformer_conv(za, conv_w, conv_b, norm_g):
    val, gate = jnp.split(za, 2, axis=-1)
    u = val * jax.nn.sigmoid(gate)
    u = depthwise_conv(u, conv_w, conv_b)
    return jax.nn.silu(rms_norm(u, norm_g))


def short_gated_conv(zb, conv_w, norm_g):
    bg, cg, hv = jnp.split(zb, 3, axis=-1)
    y = bg * depthwise_conv(cg * hv, conv_w)
    return rms_norm(y, norm_g)


def diff_attention(zq, zk, zv, cos, sin, q_g, k_g, lq1, lk1, lq2, lk2, out_g, lambda_init):
    bsz, seq = zq.shape[0], zq.shape[1]
    q = zq.reshape(bsz, seq, ATTN_HEADS, 2, QK_HEAD_DIM)
    k = zk.reshape(bsz, seq, ATTN_HEADS, 2, QK_HEAD_DIM)
    v = zv.reshape(bsz, seq, ATTN_HEADS, V_HEAD_DIM)
    q = apply_rope(rms_norm(q, q_g), cos, sin) * (QK_HEAD_DIM ** -0.5)
    k = apply_rope(rms_norm(k, k_g), cos, sin)
    lam = (jnp.exp(jnp.sum(lq1.astype(jnp.float32) * lk1.astype(jnp.float32)))
           - jnp.exp(jnp.sum(lq2.astype(jnp.float32) * lk2.astype(jnp.float32)))
           + lambda_init)
    n_blk = seq // Q_BLOCK
    q_blocks = jnp.moveaxis(q.reshape(bsz, n_blk, Q_BLOCK, ATTN_HEADS, 2, QK_HEAD_DIM), 1, 0)

    def block(qb):
        s = jnp.einsum("bqhcd,bkhcd->bhcqk", qb, k).astype(jnp.float32)
        p = jax.nn.softmax(s, axis=-1)
        w = p[:, :, 0] - lam * p[:, :, 1]
        return jnp.einsum("bhqk,bkhe->bqhe", w, v.astype(jnp.float32))

    o = lax.map(block, q_blocks)
    o = jnp.moveaxis(o, 0, 1).reshape(bsz, seq, ATTN_HEADS, V_HEAD_DIM).astype(zv.dtype)
    o = rms_norm(o, out_g) * (1.0 - lambda_init)
    return o.reshape(bsz, seq, ATTN_WIDTH)


def swiglu(h, w_gate_up, w_down):
    g, u = jnp.split(h @ w_gate_up, 2, axis=-1)
    return (jax.nn.silu(g) * u) @ w_down


def setup_inputs(seed: int = 0) -> dict:
    key = jax.random.key(seed)
    ks = jax.random.split(key, 24)
    f32 = jnp.float32
    nrm = lambda k, shape, s: jax.random.normal(k, shape, f32) * s
    gain = lambda k, shape: 1.0 + 0.02 * jax.random.normal(k, shape, f32)
    L, D = DEPTH, D_MODEL
    return {
        "x": nrm(ks[0], (BATCH, SEQ, D), 1.0),
        "c": nrm(ks[1], (BATCH, D), 1.0),
        "positions": jnp.arange(SEQ, dtype=jnp.int32),
        "norm1_g": gain(ks[2], (L, D)),
        "norm2_g": gain(ks[3], (L, D)),
        "w_ada": nrm(ks[4], (L, D, 6 * D), D ** -0.5),
        "b_ada": nrm(ks[5], (L, 6 * D), 0.02),
        "w_in": nrm(ks[6], (L, D, IN_WIDTH), D ** -0.5),
        "conv_a_w": nrm(ks[7], (L, CONF_KERNEL, CONF_WIDTH), CONF_KERNEL ** -0.5),
        "conv_a_b": nrm(ks[8], (L, CONF_WIDTH), 0.02),
        "conv_a_norm_g": gain(ks[9], (L, CONF_WIDTH)),
        "conv_b_w": nrm(ks[10], (L, SC_KERNEL, SC_WIDTH), SC_KERNEL ** -0.5),
        "sc_norm_g": gain(ks[11], (L, SC_WIDTH)),
        "q_norm_g": gain(ks[12], (L, QK_HEAD_DIM)),
        "k_norm_g": gain(ks[13], (L, QK_HEAD_DIM)),
        "lam_q1": nrm(ks[14], (L, QK_HEAD_DIM), 0.1),
        "lam_k1": nrm(ks[15], (L, QK_HEAD_DIM), 0.1),
        "lam_q2": nrm(ks[16], (L, QK_HEAD_DIM), 0.1),
        "lam_k2": nrm(ks[17], (L, QK_HEAD_DIM), 0.1),
        "attn_norm_g": gain(ks[18], (L, V_HEAD_DIM)),
        "w_out": nrm(ks[19], (L, D_MIX, D), D_MIX ** -0.5),
        "w_gate_up": nrm(ks[20], (L, D, 2 * D_FF), D ** -0.5),
        "w_down": nrm(ks[21], (L, D_FF, D), D_FF ** -0.5),
    }


def reference(x, c, positions, norm1_g, norm2_g, w_ada, b_ada, w_in, conv_a_w, conv_a_b,
              conv_a_norm_g, conv_b_w, sc_norm_g, q_norm_g, k_norm_g, lam_q1, lam_k1,
              lam_q2, lam_k2, attn_norm_g, w_out, w_gate_up, w_down):
    cos, sin = rope_tables(positions)
    c_act = jax.nn.silu(c)
    split_idx = np.cumsum([2 * CONF_WIDTH, 3 * SC_WIDTH, QK_WIDTH, QK_WIDTH])
    for l in range(DEPTH):
        lambda_init = 0.8 - 0.6 * float(np.exp(-0.3 * l))
        mod = c_act @ w_ada[l] + b_ada[l]
        sh1, sc1, g1, sh2, sc2, g2 = jnp.split(mod, 6, axis=-1)

        h = modulate(rms_norm(x, norm1_g[l]), sh1, sc1)
        z = h @ w_in[l]
        za, zb, zq, zk, zv = jnp.split(z, split_idx, axis=-1)
        ya = conformer_conv(za, conv_a_w[l], conv_a_b[l], conv_a_norm_g[l])
        yb = short_gated_conv(zb, conv_b_w[l], sc_norm_g[l])
        yc = diff_attention(zq, zk, zv, cos, sin, q_norm_g[l], k_norm_g[l], lam_q1[l], lam_k1[l],
                            lam_q2[l], lam_k2[l], attn_norm_g[l], lambda_init)
        mix = jnp.concatenate([ya, yb, yc], axis=-1) @ w_out[l]
        x = x + g1[:, None, :] * mix

        h = modulate(rms_norm(x, norm2_g[l]), sh2, sc2)
        x = x + g2[:, None, :] * swiglu(h, w_gate_up[l], w_down[l])
    return x
```

```cpp
#include <hip/hip_runtime.h>
#include <hip/hip_cooperative_groups.h>
#include <cstdio>
namespace cg = cooperative_groups;

#ifndef MK_MULTI
#define MK_MULTI 0
#endif

#define LAS __attribute__((address_space(3)))
#define DI __device__ __forceinline__
typedef unsigned short bf16_t;
typedef short bf16x8 __attribute__((ext_vector_type(8)));
typedef float f32x4 __attribute__((ext_vector_type(4)));
typedef float f32x2 __attribute__((ext_vector_type(2)));
typedef float f32x16 __attribute__((ext_vector_type(16)));
typedef unsigned u32x4 __attribute__((ext_vector_type(4)));
typedef unsigned u32x2 __attribute__((ext_vector_type(2)));
typedef __bf16 bf16x2n __attribute__((ext_vector_type(2)));

constexpr int NB = 32, SEQ = 2048, DM = 1024, MTOK = NB * SEQ, NL = 4, INW = 2816, DFF = 2816, GU = 2 * DFF;
constexpr int MODW = 6 * DM;
constexpr float EPS = 1e-6f;
constexpr float LOG2E = 1.4426950408889634f;
constexpr int LDS_BYTES = 131072;
constexpr int NPHASE = 1 + 8 * NL;

constexpr size_t WS_WT_IN = 0;
constexpr size_t WS_WT_OUT = WS_WT_IN + (size_t)NL * INW * DM * 2;
constexpr size_t WS_WT_GU = WS_WT_OUT + (size_t)NL * DM * DM * 2;
constexpr size_t WS_WT_DN = WS_WT_GU + (size_t)NL * GU * DM * 2;
constexpr size_t WS_MOD = WS_WT_DN + (size_t)NL * DM * DFF * 2;
constexpr size_t WS_ROPE = WS_MOD + (size_t)NL * NB * MODW * 4;
constexpr size_t WS_H = WS_ROPE + (size_t)2 * SEQ * 32 * 4;
constexpr size_t WS_Z = WS_H + (size_t)MTOK * DM * 2;
constexpr size_t WS_QH = WS_Z + (size_t)MTOK * INW * 2;
constexpr size_t WS_KH = WS_QH + (size_t)MTOK * 512 * 2;
constexpr size_t WS_MIX = WS_KH + (size_t)MTOK * 512 * 2;
constexpr size_t WS_END = WS_MIX + (size_t)MTOK * DM * 2;

struct Params {
    const float* x; const float* c; const int* pos;
    const float *norm1_g, *norm2_g, *w_ada, *b_ada, *w_in, *conv_a_w, *conv_a_b, *conv_a_norm_g, *conv_b_w, *sc_norm_g,
        *q_norm_g, *k_norm_g, *lam_q1, *lam_k1, *lam_q2, *lam_k2, *attn_norm_g, *w_out, *w_gate_up, *w_down;
    float* out; unsigned char* ws;
    int ph_lo, ph_hi;
};

DI unsigned pk2(float lo, float hi) { f32x2 v = {lo, hi}; return __builtin_bit_cast(unsigned, __builtin_convertvector(v, bf16x2n)); }
DI float bf_lo(unsigned u) { return __uint_as_float(u << 16); }
DI float bf_hi(unsigned u) { return __uint_as_float(u & 0xffff0000u); }
DI float wave_sum(float v) {
#pragma unroll
    for (int o = 1; o < 64; o <<= 1) v += __shfl_xor(v, o);
    return v;
}
DI float wave_max(float v) {
#pragma unroll
    for (int o = 1; o < 64; o <<= 1) v = fmaxf(v, __shfl_xor(v, o));
    return v;
}
DI int opq(int v) { asm volatile("" : "+v"(v)); return v; }
DI float sigmoidf_fast(float v) { return __builtin_amdgcn_rcpf(1.0f + __builtin_amdgcn_exp2f(-v * LOG2E)); }

namespace pg8 {
constexpr int BM = 256, BK = 64, HALF = 128, HTB = HALF * BK * 2, NXCD = 8, WGM = 8;
DI int lds_byte(int r, int c) { const int st = (r >> 4) * 2 + (c >> 5), rr = r & 15, cc = c & 31, ob = rr * 64 + cc * 2; return st * 1024 + (ob ^ (((ob >> 9) & 1) << 5)); }
DI void stage_rc(int b, int& R, int& C) { const int st = b / 1024, sb = b % 1024, swz = sb ^ (((sb >> 9) & 1) << 5); R = (st >> 1) * 16 + swz / 64; C = (st & 1) * 32 + (swz % 64) / 2; }
DI int perm32(int rho) { const int n = rho >> 4, i = rho & 15; return 8 * (i >> 2) + 4 * n + (i & 3); }
struct Unit { int pm, pn; };
struct Gemm { const bf16_t* A; const bf16_t* Bt; int M, N, K; };
struct StaticOrder {
    int nM, nN, nwg, G, c;
    DI void init(int M, int N, int G_, int c_) { nM = M / BM; nN = N / BM; nwg = nM * nN; G = G_; c = c_; }
    DI bool next(int i, Unit& u) const {
        const long L = (long)i * G + c; if (L >= nwg) return false;
        int wgid = (int)L; { const int q = nwg / NXCD, r = nwg % NXCD, xcd = wgid % NXCD, off = wgid / NXCD; wgid = (xcd < r ? xcd * (q + 1) : r * (q + 1) + (xcd - r) * q) + off; }
        const int nig = WGM * nN, gid = wgid / nig, fm = gid * WGM, gsz = (nM - fm) < WGM ? (nM - fm) : WGM;
        u.pm = fm + ((wgid % nig) % gsz); u.pn = (wgid % nig) / gsz; return true;
    }
};

struct EpiZ {
    static constexpr bool PERM = true;
    bf16_t* O; int ldc;
    DI void operator()(const f32x4 (&acc)[2][2][4][2], const Unit& u, int wr, int wc, int fr, int fq) const {
        const int row0 = u.pm * BM + wr * 64 + fr, col0 = u.pn * BM + wc * 32 + 8 * fq;
#pragma unroll
        for (int ai = 0; ai < 2; ++ai)
#pragma unroll
            for (int m = 0; m < 4; ++m) { bf16_t* rowp = O + (size_t)(row0 + ai * HALF + m * 16) * ldc + col0;
#pragma unroll
                for (int bj = 0; bj < 2; ++bj) { const f32x4 v0 = acc[ai][bj][m][0], v1 = acc[ai][bj][m][1];
                    u32x4 w; w.x = pk2(v0[0], v0[1]); w.y = pk2(v0[2], v0[3]); w.z = pk2(v1[0], v1[1]); w.w = pk2(v1[2], v1[3]);
                    *(u32x4*)(rowp + bj * HALF) = w; } }
    }
};
struct EpiRes {
    static constexpr bool PERM = false;
    const float* xin; float* xout; const float* gate;
    DI void operator()(const f32x4 (&acc)[2][2][4][2], const Unit& u, int wr, int wc, int fr, int fq) const {
        const int row0 = u.pm * BM + wr * 64 + fr, col0 = u.pn * BM + wc * 32 + 4 * fq, b = (u.pm * BM) / SEQ;
        f32x4 gv[2][2];
#pragma unroll
        for (int bj = 0; bj < 2; ++bj)
#pragma unroll
            for (int n = 0; n < 2; ++n) gv[bj][n] = *(const f32x4*)(gate + (size_t)b * MODW + col0 + bj * HALF + n * 16);
#pragma unroll
        for (int ai = 0; ai < 2; ++ai)
#pragma unroll
            for (int m = 0; m < 4; ++m) { const size_t off = (size_t)(row0 + ai * HALF + m * 16) * DM + col0;
#pragma unroll
                for (int bj = 0; bj < 2; ++bj)
#pragma unroll
                    for (int n = 0; n < 2; ++n) { const f32x4 xv = *(const f32x4*)(xin + off + bj * HALF + n * 16);
                        *(f32x4*)(xout + off + bj * HALF + n * 16) = xv + gv[bj][n] * acc[ai][bj][m][n]; }
                asm volatile("" ::: "memory"); }
    }
};
struct EpiSwiGLU {
    static constexpr bool PERM = true;
    bf16_t* O;
    DI void operator()(const f32x4 (&acc)[2][2][4][2], const Unit& u, int wr, int wc, int fr, int fq) const {
        const int row0 = u.pm * BM + wr * 64 + fr, colh = u.pn * 128 + wc * 16 + 4 * fq;
#pragma unroll
        for (int ai = 0; ai < 2; ++ai)
#pragma unroll
            for (int m = 0; m < 4; ++m) { bf16_t* rowp = O + (size_t)(row0 + ai * HALF + m * 16) * DFF + colh;
#pragma unroll
                for (int bj = 0; bj < 2; ++bj) { const f32x4 g = acc[ai][bj][m][0], uu = acc[ai][bj][m][1];
                    float a[4];
#pragma unroll
                    for (int i = 0; i < 4; ++i) a[i] = g[i] * sigmoidf_fast(g[i]) * uu[i];
                    u32x2 w; w.x = pk2(a[0], a[1]); w.y = pk2(a[2], a[3]);
                    *(u32x2*)(rowp + bj * 64) = w; } }
    }
};

template <class Epi, class Sched>
DI void gemm_phase(LAS unsigned char* lds, const Gemm g, const Sched& S, const Epi& E) {
    const int tid = opq(threadIdx.x), wid = __builtin_amdgcn_readfirstlane(tid >> 6), lane = tid & 63, wr = wid >> 2, wc = wid & 3, fr = lane & 15, fq = lane >> 4;
    const int K = g.K, nt = K / BK;
    unsigned voffA[2], voffB[2];
#pragma unroll
    for (int i = 0; i < 2; ++i) { int R, C; stage_rc(tid * 16 + i * 8192, R, C); const int Rb = Epi::PERM ? ((R & ~31) + perm32(R & 31)) : R;
        voffA[i] = (unsigned)(R * K + C) * 2u; voffB[i] = (unsigned)(Rb * K + C) * 2u; }
    const size_t kstep = (size_t)(BK * 2);
    const size_t hstep = (size_t)HALF * K * 2;
    const size_t tstep = 2 * hstep;
    const unsigned ldsw = (unsigned)wid * 1024u;
    const int aoff = lds_byte(wr * 64 + fr, fq * 8), boff = lds_byte(wc * 32 + fr, fq * 8);
#define PG8_SA(b, h) (((b) * 2 + (h)) * HTB)
#define PG8_SB(b, h) ((4 + (b) * 2 + (h)) * HTB)
#define PG8_STAGE(bufoff, gbase, voff) do { _Pragma("unroll") for (int _i = 0; _i < 2; ++_i) \
        __builtin_amdgcn_global_load_lds((const unsigned*)((const char*)(gbase) + (voff)[_i]), (LAS unsigned*)(lds + (bufoff) + ldsw + _i * 8192), 16, 0, 0); } while (0)
#define PG8_LDA(dst, b, h) do { _Pragma("unroll") for (int m = 0; m < 4; ++m) _Pragma("unroll") for (int k = 0; k < 2; ++k) dst[m][k] = *(const LAS bf16x8*)(lds + PG8_SA(b, h) + aoff + m * 2048 + k * 1024); } while (0)
#define PG8_LDB(dst, b, h) do { _Pragma("unroll") for (int n = 0; n < 2; ++n) _Pragma("unroll") for (int k = 0; k < 2; ++k) dst[n][k] = *(const LAS bf16x8*)(lds + PG8_SB(b, h) + boff + n * 2048 + k * 1024); } while (0)
#define PG8_MMA(ai, bj, At, Bt) do { __builtin_amdgcn_s_setprio(1); _Pragma("unroll") for (int m = 0; m < 4; ++m) _Pragma("unroll") for (int n = 0; n < 2; ++n) _Pragma("unroll") for (int k = 0; k < 2; ++k) \
        acc[ai][bj][m][n] = __builtin_amdgcn_mfma_f32_16x16x32_bf16(Bt[n][k], At[m][k], acc[ai][bj][m][n], 0, 0, 0); __builtin_amdgcn_s_setprio(0); } while (0)
#define PG8_WAIT_V(n) asm volatile("s_waitcnt vmcnt(" #n ")" ::: "memory")
#define PG8_WAIT_L(n) asm volatile("s_waitcnt lgkmcnt(" #n ")" ::: "memory")
#define PG8_BAR __builtin_amdgcn_s_barrier()
#define PG8_SCHED __builtin_amdgcn_sched_barrier(0)
    Unit cur, nxt; int ui = 0;
    if (!S.next(0, cur)) return;
    f32x4 acc[2][2][4][2];
#pragma unroll
    for (int a = 0; a < 2; ++a)
#pragma unroll
        for (int b = 0; b < 2; ++b)
#pragma unroll
            for (int m = 0; m < 4; ++m)
#pragma unroll
                for (int n = 0; n < 2; ++n) acc[a][b][m][n] = (f32x4){0.f, 0.f, 0.f, 0.f};
    bf16x8 At[4][2], B0[2][2], B1[2][2];
    const char* cA = (const char*)g.A + (size_t)cur.pm * tstep; const char* cB = (const char*)g.Bt + (size_t)cur.pn * tstep;
    PG8_STAGE(PG8_SB(0, 0), cB, voffB); PG8_STAGE(PG8_SA(0, 0), cA, voffA); PG8_STAGE(PG8_SB(0, 1), cB + hstep, voffB); PG8_STAGE(PG8_SA(0, 1), cA + hstep, voffA);
    if (wr == 1) PG8_BAR;
    PG8_WAIT_V(4); PG8_BAR;
    PG8_STAGE(PG8_SB(1, 0), cB + kstep, voffB); PG8_STAGE(PG8_SA(1, 0), cA + kstep, voffA); PG8_STAGE(PG8_SB(1, 1), cB + hstep + kstep, voffB);
    PG8_WAIT_V(6); PG8_BAR;
    for (;;) {
        const bool has_next = S.next(ui + 1, nxt);
        const char* nA = has_next ? (const char*)g.A + (size_t)nxt.pm * tstep : cA; const char* nB = has_next ? (const char*)g.Bt + (size_t)nxt.pn * tstep : cB;
        for (int t = 0; t < nt; t += 2) {
            const bool last = (t == nt - 2);
            const char* a1 = cA + (size_t)(t + 1) * kstep;
            const char* a2 = last ? nA : cA + (size_t)(t + 2) * kstep; const char* b2 = last ? nB : cB + (size_t)(t + 2) * kstep;
            const char* a3 = a2 + kstep; const char* b3 = b2 + kstep;
            PG8_LDB(B0, 0, 0); PG8_SCHED; PG8_LDA(At, 0, 0); PG8_STAGE(PG8_SA(1, 1), a1 + hstep, voffA);
            PG8_WAIT_L(8); PG8_BAR; PG8_WAIT_L(0); PG8_MMA(0, 0, At, B0); PG8_BAR; PG8_SCHED;
            PG8_LDB(B1, 0, 1); PG8_STAGE(PG8_SB(0, 0), b2, voffB);
            PG8_BAR; PG8_WAIT_L(0); PG8_MMA(0, 1, At, B1); PG8_BAR;
            PG8_LDA(At, 0, 1); PG8_STAGE(PG8_SA(0, 0), a2, voffA);
            PG8_BAR; PG8_WAIT_L(0); PG8_MMA(1, 0, At, B0); PG8_BAR; PG8_SCHED;
            PG8_STAGE(PG8_SB(0, 1), b2 + hstep, voffB);
            PG8_WAIT_V(6); PG8_BAR; PG8_MMA(1, 1, At, B1); PG8_BAR;
            PG8_LDB(B0, 1, 0); PG8_SCHED; PG8_LDA(At, 1, 0); PG8_STAGE(PG8_SA(0, 1), a2 + hstep, voffA);
            PG8_WAIT_L(8); PG8_BAR; PG8_WAIT_L(0); PG8_MMA(0, 0, At, B0); PG8_BAR; PG8_SCHED;
            PG8_LDB(B1, 1, 1); PG8_STAGE(PG8_SB(1, 0), b3, voffB);
            PG8_BAR; PG8_WAIT_L(0); PG8_MMA(0, 1, At, B1); PG8_BAR;
            PG8_LDA(At, 1, 1); PG8_STAGE(PG8_SA(1, 0), a3, voffA);
            PG8_BAR; PG8_WAIT_L(0); PG8_MMA(1, 0, At, B0); PG8_BAR; PG8_SCHED;
            PG8_STAGE(PG8_SB(1, 1), b3 + hstep, voffB);
            PG8_WAIT_V(6); PG8_BAR; PG8_MMA(1, 1, At, B1); PG8_BAR;
        }
        E(acc, cur, wr, wc, fr, fq);
        if (!has_next) break;
#pragma unroll
        for (int a = 0; a < 2; ++a)
#pragma unroll
            for (int b = 0; b < 2; ++b)
#pragma unroll
                for (int m = 0; m < 4; ++m)
#pragma unroll
                    for (int n = 0; n < 2; ++n) acc[a][b][m][n] = (f32x4){0.f, 0.f, 0.f, 0.f};
        cur = nxt; cA = nA; cB = nB; ++ui;
    }
    PG8_WAIT_V(0);
    if (wr == 0) PG8_BAR;
    PG8_BAR;
#undef PG8_SA
#undef PG8_SB
#undef PG8_STAGE
#undef PG8_LDA
#undef PG8_LDB
#undef PG8_MMA
#undef PG8_WAIT_V
#undef PG8_WAIT_L
#undef PG8_BAR
#undef PG8_SCHED
}
}

template <int MODE>
DI int wrow_map(int n) { if (MODE == 0) return n; const int isu = n >= DFF ? 1 : 0, j = n - isu * DFF; return 8 * (j >> 2) + 4 * isu + (j & 3); }
template <int MODE>
DI void p0_transpose_item(const float* W, int K, int N, bf16_t* WT, LAS float* scr, int item, int lane) {
    const int nblk = N / 32, kb = item / nblk, nb = item % nblk, k0 = 64 * kb, n0 = 32 * nb;
#pragma unroll 8
    for (int i = 0; i < 32; ++i) { const int kk = 2 * i + (lane >> 5); scr[kk * 33 + (lane & 31)] = W[(size_t)(k0 + kk) * N + n0 + (lane & 31)]; }
    asm volatile("s_waitcnt lgkmcnt(0)" ::: "memory");
    const int c = lane & 7;
#pragma unroll
    for (int j = 0; j < 4; ++j) { const int n = (lane >> 3) + 8 * j; const LAS float* s = scr + (8 * c) * 33 + n;
        u32x4 o; o.x = pk2(s[0 * 33], s[1 * 33]); o.y = pk2(s[2 * 33], s[3 * 33]); o.z = pk2(s[4 * 33], s[5 * 33]); o.w = pk2(s[6 * 33], s[7 * 33]);
        *(u32x4*)(WT + (size_t)wrow_map<MODE>(n0 + n) * K + k0 + 8 * c) = o; }
    asm volatile("s_waitcnt lgkmcnt(0)" ::: "memory");
}

DI void phase0(const Params& p, LAS unsigned char* lds) {
    const int tid = opq(threadIdx.x), lane = tid & 63, wave = tid >> 6, G = gridDim.x;
    {
        LAS float* cact = (LAS float*)lds;
        float* mod = (float*)(p.ws + WS_MOD);
        constexpr int NITEM = NL * (MODW / 64);
        for (int it = blockIdx.x; it < NITEM; it += G) {
            const int l = it / (MODW / 64), n0 = (it % (MODW / 64)) * 64;
            for (int idx = tid; idx < NB * DM; idx += 512) { const int k = idx >> 5, b = idx & 31; const float v = p.c[b * DM + k]; cact[idx] = v * sigmoidf_fast(v); }
            __syncthreads();
            float acc[32];
#pragma unroll
            for (int b = 0; b < 32; ++b) acc[b] = 0.f;
            const float* wp = p.w_ada + ((size_t)l * DM + 128 * wave) * MODW + n0 + lane;
            const LAS f32x4* cp = (const LAS f32x4*)(cact + (128 * wave) * 32);
#pragma unroll 8
            for (int kk = 0; kk < 128; ++kk) {
                const float wv = wp[(size_t)kk * MODW];
#pragma unroll
                for (int q = 0; q < 8; ++q) { const f32x4 cv = cp[kk * 8 + q]; acc[4 * q] += cv[0] * wv; acc[4 * q + 1] += cv[1] * wv; acc[4 * q + 2] += cv[2] * wv; acc[4 * q + 3] += cv[3] * wv; }
            }
            __syncthreads();
            LAS float* red = (LAS float*)lds;
#pragma unroll
            for (int b = 0; b < 32; ++b) red[(wave * 32 + b) * 64 + lane] = acc[b];
            __syncthreads();
#pragma unroll
            for (int j = 0; j < 4; ++j) { const int o = tid + 512 * j, b = o >> 6, n = o & 63; float s = p.b_ada[l * MODW + n0 + n];
#pragma unroll
                for (int w = 0; w < 8; ++w) s += red[(w * 32 + b) * 64 + n];
                mod[((size_t)l * NB + b) * MODW + n0 + n] = s; }
            __syncthreads();
        }
    }
    {
        LAS float* scr = (LAS float*)(lds + wave * 16384);
        const int gw = blockIdx.x * 8 + wave, NGW = G * 8;
        constexpr int I_IN = (DM / 64) * (INW / 32), I_OUT = (DM / 64) * (DM / 32), I_GU = (DM / 64) * (GU / 32), I_DN = (DFF / 64) * (DM / 32);
        constexpr int PER_L = I_IN + I_OUT + I_GU + I_DN;
        for (int it = gw; it < NL * PER_L; it += NGW) {
            const int l = it / PER_L; int r = it % PER_L;
            if (r < I_IN) { p0_transpose_item<0>(p.w_in + (size_t)l * DM * INW, DM, INW, (bf16_t*)(p.ws + WS_WT_IN) + (size_t)l * INW * DM, scr, r, lane); continue; } r -= I_IN;
            if (r < I_OUT) { p0_transpose_item<0>(p.w_out + (size_t)l * DM * DM, DM, DM, (bf16_t*)(p.ws + WS_WT_OUT) + (size_t)l * DM * DM, scr, r, lane); continue; } r -= I_OUT;
            if (r < I_GU) { p0_transpose_item<1>(p.w_gate_up + (size_t)l * DM * GU, DM, GU, (bf16_t*)(p.ws + WS_WT_GU) + (size_t)l * GU * DM, scr, r, lane); continue; } r -= I_GU;
            p0_transpose_item<0>(p.w_down + (size_t)l * DFF * DM, DFF, DM, (bf16_t*)(p.ws + WS_WT_DN) + (size_t)l * DM * DFF, scr, r, lane);
        }
    }
    {
        float* rc = (float*)(p.ws + WS_ROPE); float* rs = rc + SEQ * 32;
        for (int idx = blockIdx.x * 512 + tid; idx < SEQ * 32; idx += G * 512) {
            const int s = idx >> 5, i = idx & 31;
            const double inv = exp2(-(double)i * (13.287712379549449 / 32.0));
            const double rev = (double)p.pos[s] * inv * 0.15915494309189535;
            const float fr = (float)(rev - floor(rev));
            rc[idx] = __builtin_amdgcn_cosf(fr); rs[idx] = __builtin_amdgcn_sinf(fr);
        }
    }
}

DI void phase_norm(const float* x, const float* g, const float* modl, int sh_off, int sc_off, bf16_t* H) {
    const int tid = opq(threadIdx.x), lane = tid & 63, wave = tid >> 6, NGW = gridDim.x * 8;
    for (int rb = blockIdx.x * 8 + wave; rb < MTOK / 32; rb += NGW) {
        const int b = (rb * 32) / SEQ;
        f32x4 gs[4], sh[4];
#pragma unroll
        for (int j = 0; j < 4; ++j) { const int col = 4 * lane + 256 * j;
            const f32x4 gg = *(const f32x4*)(g + col), sc = *(const f32x4*)(modl + (size_t)b * MODW + sc_off + col);
            gs[j] = gg * (sc + 1.0f); sh[j] = *(const f32x4*)(modl + (size_t)b * MODW + sh_off + col); }
        for (int r = 0; r < 32; ++r) {
            const size_t row = (size_t)rb * 32 + r;
            const f32x4* xr = (const f32x4*)(x + row * DM) + lane;
            f32x4 v[4]; float s = 0.f;
#pragma unroll
            for (int j = 0; j < 4; ++j) { v[j] = xr[64 * j]; s += (v[j][0] * v[j][0] + v[j][1] * v[j][1]) + (v[j][2] * v[j][2] + v[j][3] * v[j][3]); }
            const float rstd = rsqrtf(wave_sum(s) * (1.f / DM) + EPS);
            u32x2* o8 = (u32x2*)(H + row * DM) + lane;
#pragma unroll
            for (int j = 0; j < 4; ++j) { const f32x4 y = v[j] * rstd * gs[j] + sh[j]; u32x2 w; w.x = pk2(y[0], y[1]); w.y = pk2(y[2], y[3]); o8[64 * j] = w; }
        }
    }
}

DI void phase_prep(const Params& p, int l, LAS unsigned char* lds) {
    const int tid = opq(threadIdx.x), lane = tid & 63, wave = tid >> 6, G = gridDim.x;
    const bf16_t* Z = (const bf16_t*)(p.ws + WS_Z);
    bf16_t* MIX = (bf16_t*)(p.ws + WS_MIX); bf16_t* QH = (bf16_t*)(p.ws + WS_QH); bf16_t* KH = (bf16_t*)(p.ws + WS_KH);
    const float* rc = (const float*)(p.ws + WS_ROPE); const float* rs = rc + SEQ * 32;
    LAS float* U = (LAS float*)lds;
    LAS float* CV = (LAS float*)(lds + 65536);
    const int cch = tid & 255, th = tid >> 8;
    float cw[31];
#pragma unroll
    for (int j = 0; j < 31; ++j) cw[j] = p.conv_a_w[((size_t)l * 31 + j) * 256 + cch];
    const float cbias = p.conv_a_b[l * 256 + cch];
    const f32x4 ga = *(const f32x4*)(p.conv_a_norm_g + l * 256 + 4 * lane);
    const f32x4 gb = *(const f32x4*)(p.sc_norm_g + l * 256 + 4 * lane);
    f32x4 wb[3];
#pragma unroll
    for (int j = 0; j < 3; ++j) wb[j] = *(const f32x4*)(p.conv_b_w + ((size_t)l * 3 + j) * 256 + 4 * lane);
    const int sub = lane & 7, d0 = sub * 8, dp = d0 ^ 32;
    float gq[8], gk[8], gqp[8], gkp[8];
#pragma unroll
    for (int i = 0; i < 8; ++i) { gq[i] = p.q_norm_g[l * 64 + d0 + i]; gk[i] = p.k_norm_g[l * 64 + d0 + i]; gqp[i] = p.q_norm_g[l * 64 + dp + i]; gkp[i] = p.k_norm_g[l * 64 + dp + i]; }
    const float qscale = LOG2E * 0.125f;
    const float sgn = (sub < 4) ? -1.f : 1.f;

    for (int it = blockIdx.x; it < MTOK / 32; it += G) {
        const int b = it >> 6, t0 = (it & 63) * 32;
        const size_t tokbase = (size_t)b * SEQ;
        for (int ci = tid; ci < 62 * 32; ci += 512) {
            const int row = ci >> 5, ch8 = ci & 31, tok = t0 - 15 + row;
            f32x4 o0 = {0.f, 0.f, 0.f, 0.f}, o1 = o0;
            if (tok >= 0 && tok < SEQ) {
                const bf16_t* zp = Z + (tokbase + tok) * INW + ch8 * 8;
                const u32x4 v = *(const u32x4*)zp, gt = *(const u32x4*)(zp + 256);
                o0[0] = bf_lo(v.x) * sigmoidf_fast(bf_lo(gt.x)); o0[1] = bf_hi(v.x) * sigmoidf_fast(bf_hi(gt.x));
                o0[2] = bf_lo(v.y) * sigmoidf_fast(bf_lo(gt.y)); o0[3] = bf_hi(v.y) * sigmoidf_fast(bf_hi(gt.y));
                o1[0] = bf_lo(v.z) * sigmoidf_fast(bf_lo(gt.z)); o1[1] = bf_hi(v.z) * sigmoidf_fast(bf_hi(gt.z));
                o1[2] = bf_lo(v.w) * sigmoidf_fast(bf_lo(gt.w)); o1[3] = bf_hi(v.w) * sigmoidf_fast(bf_hi(gt.w));
            }
            *(LAS f32x4*)(U + row * 256 + ch8 * 8) = o0; *(LAS f32x4*)(U + row * 256 + ch8 * 8 + 4) = o1;
        }
        __syncthreads();
#pragma unroll 1
        for (int chunk = 0; chunk < 2; ++chunk) {
            const int tb = th * 16 + chunk * 8;
            float uu[38];
#pragma unroll
            for (int i = 0; i < 38; ++i) uu[i] = U[(tb + i) * 256 + cch];
#pragma unroll
            for (int t = 0; t < 8; ++t) { float a = cbias;
#pragma unroll
                for (int j = 0; j < 31; ++j) a += cw[j] * uu[t + j];
                CV[(tb + t) * 256 + cch] = a; }
        }
        __syncthreads();
#pragma unroll
        for (int q = 0; q < 4; ++q) { const int t = wave * 4 + q;
            const f32x4 v = *(const LAS f32x4*)(CV + t * 256 + 4 * lane);
            const float ss = wave_sum((v[0] * v[0] + v[1] * v[1]) + (v[2] * v[2] + v[3] * v[3]));
            const f32x4 y = v * rsqrtf(ss * (1.f / 256.f) + EPS) * ga;
            f32x4 o;
#pragma unroll
            for (int i = 0; i < 4; ++i) o[i] = y[i] * sigmoidf_fast(y[i]);
            u32x2 w; w.x = pk2(o[0], o[1]); w.y = pk2(o[2], o[3]);
            *(u32x2*)(MIX + (tokbase + t0 + t) * DM + 4 * lane) = w; }
        {
            const int tw = t0 + wave * 4;
            f32x4 mrow[6], bgv[4];
#pragma unroll
            for (int r = 0; r < 6; ++r) { const int tok = tw - 1 + r; mrow[r] = (f32x4){0.f, 0.f, 0.f, 0.f};
                if (tok >= 0 && tok < SEQ) { const bf16_t* zp = Z + (tokbase + tok) * INW + 512 + 4 * lane;
                    const u32x2 cg = *(const u32x2*)(zp + 256), hv = *(const u32x2*)(zp + 512);
                    mrow[r][0] = bf_lo(cg.x) * bf_lo(hv.x); mrow[r][1] = bf_hi(cg.x) * bf_hi(hv.x); mrow[r][2] = bf_lo(cg.y) * bf_lo(hv.y); mrow[r][3] = bf_hi(cg.y) * bf_hi(hv.y);
                    if (r >= 1 && r <= 4) { const u32x2 bg = *(const u32x2*)zp; bgv[r - 1][0] = bf_lo(bg.x); bgv[r - 1][1] = bf_hi(bg.x); bgv[r - 1][2] = bf_lo(bg.y); bgv[r - 1][3] = bf_hi(bg.y); } } }
#pragma unroll
            for (int q = 0; q < 4; ++q) {
                const f32x4 y = bgv[q] * (wb[0] * mrow[q] + wb[1] * mrow[q + 1] + wb[2] * mrow[q + 2]);
                const float ss = wave_sum((y[0] * y[0] + y[1] * y[1]) + (y[2] * y[2] + y[3] * y[3]));
                const f32x4 o = y * rsqrtf(ss * (1.f / 256.f) + EPS) * gb;
                u32x2 w; w.x = pk2(o[0], o[1]); w.y = pk2(o[2], o[3]);
                *(u32x2*)(MIX + (tokbase + tw + q) * DM + 256 + 4 * lane) = w; }
        }
#pragma unroll 1
        for (int q = 0; q < 4; ++q) {
            const int ts = t0 + wave * 4 + q; const size_t tok = tokbase + ts;
            const f32x4 c0 = *(const f32x4*)(rc + ts * 32 + (sub & 3) * 8), c1 = *(const f32x4*)(rc + ts * 32 + (sub & 3) * 8 + 4);
            const f32x4 s0 = *(const f32x4*)(rs + ts * 32 + (sub & 3) * 8), s1 = *(const f32x4*)(rs + ts * 32 + (sub & 3) * 8 + 4);
            const float cs[8] = {c0[0], c0[1], c0[2], c0[3], c1[0], c1[1], c1[2], c1[3]};
            const float sn[8] = {s0[0], s0[1], s0[2], s0[3], s1[0], s1[1], s1[2], s1[3]};
#pragma unroll
            for (int qk = 0; qk < 2; ++qk) {
                const u32x4 raw = *(const u32x4*)(Z + tok * INW + 1280 + qk * 512 + lane * 8);
                float t[8] = {bf_lo(raw.x), bf_hi(raw.x), bf_lo(raw.y), bf_hi(raw.y), bf_lo(raw.z), bf_hi(raw.z), bf_lo(raw.w), bf_hi(raw.w)};
                float ss = 0.f;
#pragma unroll
                for (int i = 0; i < 8; ++i) ss += t[i] * t[i];
                ss += __shfl_xor(ss, 1); ss += __shfl_xor(ss, 2); ss += __shfl_xor(ss, 4);
                const float rstd = rsqrtf(ss * (1.f / 64.f) + EPS) * (qk == 0 ? qscale : 1.f);
                float o[8];
#pragma unroll
                for (int i = 0; i < 8; ++i) {
                    const float tp = __shfl_xor(t[i], 4);
                    const float a = t[i] * rstd * (qk == 0 ? gq[i] : gk[i]), bp = tp * rstd * (qk == 0 ? gqp[i] : gkp[i]);
                    o[i] = a * cs[i] + sgn * bp * sn[i];
                }
                u32x4 w; w.x = pk2(o[0], o[1]); w.y = pk2(o[2], o[3]); w.z = pk2(o[4], o[5]); w.w = pk2(o[6], o[7]);
                *(u32x4*)((qk == 0 ? QH : KH) + tok * 512 + lane * 8) = w;
            }
        }
        __syncthreads();
    }
}

constexpr int KROW = 272, VROW = 144, KBYTES = 64 * KROW, VBYTES = 128 * VROW, ABUF = KBYTES + VBYTES;
#define MFMA32(a, b, c) __builtin_amdgcn_mfma_f32_32x32x16_bf16((a), (b), (c), 0, 0, 0)

DI void phase_attn(const Params& p, int l, float lambda_init, LAS unsigned char* lds) {
    const int tid = opq(threadIdx.x), lane = tid & 63, wave = tid >> 6, G = gridDim.x, r = lane & 31, h = lane >> 5;
    const int rg = wave >> 1, hf = wave & 1;
    const bf16_t* Z = (const bf16_t*)(p.ws + WS_Z);
    const bf16_t* QH = (const bf16_t*)(p.ws + WS_QH); const bf16_t* KH = (const bf16_t*)(p.ws + WS_KH);
    bf16_t* MIX = (bf16_t*)(p.ws + WS_MIX);
    const float sa = wave_sum(p.lam_q1[l * 64 + lane] * p.lam_k1[l * 64 + lane]), sb = wave_sum(p.lam_q2[l * 64 + lane] * p.lam_k2[l * 64 + lane]);
    const float lam = expf(sa) - expf(sb) + lambda_init;
    const float oscale = 1.0f - lambda_init;
    const int kkey = tid >> 3, kch = tid & 7;
    const int vkp = tid & 31, vec = tid >> 5;
    const int vk = 2 * vkp, vkq = vk & 15;
    const int vpos = (vk & ~15) + 8 * ((vkq >> 2) & 1) + (vkq & 3) + 4 * (vkq >> 3);
    const int vcu = (G % 8 == 0) ? ((blockIdx.x & 7) * (G >> 3) + (blockIdx.x >> 3)) : blockIdx.x;
    LAS float* X = (LAS float*)lds + rg * (128 * 32);

    for (int it = vcu; it < NB * 4 * 16; it += G) {
        const int qblk = it & 15, head = (it >> 4) & 3, b = it >> 6;
        const size_t tokb = (size_t)b * SEQ;
        const size_t qtok = tokb + qblk * 128 + rg * 32 + r;
        bf16x8 qf[4];
#pragma unroll
        for (int kk = 0; kk < 4; ++kk) qf[kk] = *(const bf16x8*)(QH + qtok * 512 + head * 128 + hf * 64 + kk * 16 + h * 8);
        f32x16 o[4];
#pragma unroll
        for (int eb = 0; eb < 4; ++eb)
#pragma unroll
            for (int i = 0; i < 16; ++i) o[eb][i] = 0.f;
        float lsum = 0.f;
        const bf16_t* kg = KH + (tokb + kkey) * 512 + head * 128 + kch * 16;
        const bf16_t* vg = Z + (tokb + vk) * INW + 2304 + head * 128 + vec * 8;
        u32x4 kr0 = *(const u32x4*)kg, kr1 = *(const u32x4*)(kg + 8);
        u32x4 vr0 = *(const u32x4*)vg, vr1 = *(const u32x4*)(vg + INW);
#define ATT_WRITE(buf) do { LAS unsigned char* kb_ = lds + (buf) * ABUF; LAS unsigned char* vb_ = kb_ + KBYTES; \
            *(LAS u32x4*)(kb_ + kkey * KROW + kch * 32) = kr0; *(LAS u32x4*)(kb_ + kkey * KROW + kch * 32 + 16) = kr1; \
            _Pragma("unroll") for (int i_ = 0; i_ < 4; ++i_) { \
                *(LAS unsigned*)(vb_ + (vec * 8 + 2 * i_) * VROW + vpos * 2) = (vr0[i_] & 0xffffu) | (vr1[i_] << 16); \
                *(LAS unsigned*)(vb_ + (vec * 8 + 2 * i_ + 1) * VROW + vpos * 2) = (vr0[i_] >> 16) | (vr1[i_] & 0xffff0000u); } } while (0)
        ATT_WRITE(0);
        __syncthreads();
#pragma unroll 1
        for (int t = 0; t < SEQ / 64; ++t) {
            const bool more = (t + 1 < SEQ / 64);
            if (more) { const bf16_t* kg2 = kg + (size_t)(t + 1) * 64 * 512; const bf16_t* vg2 = vg + (size_t)(t + 1) * 64 * INW;
                kr0 = *(const u32x4*)kg2; kr1 = *(const u32x4*)(kg2 + 8); vr0 = *(const u32x4*)vg2; vr1 = *(const u32x4*)(vg2 + INW); }
            const LAS unsigned char* kb = lds + (t & 1) * ABUF; const LAS unsigned char* vb = kb + KBYTES;
#pragma unroll
            for (int kbk = 0; kbk < 2; ++kbk) {
                f32x16 s;
#pragma unroll
                for (int i = 0; i < 16; ++i) s[i] = 0.f;
#pragma unroll
                for (int kk = 0; kk < 4; ++kk) { const bf16x8 a = *(const LAS bf16x8*)(kb + (kbk * 32 + r) * KROW + hf * 128 + kk * 32 + h * 16); s = MFMA32(a, qf[kk], s); }
                float ls = 0.f;
#pragma unroll
                for (int i = 0; i < 16; ++i) { s[i] = __builtin_amdgcn_exp2f(s[i]); ls += s[i]; }
                lsum += ls;
                bf16x8 pf[2];
#pragma unroll
                for (int st = 0; st < 2; ++st) { u32x4 w; w.x = pk2(s[8 * st], s[8 * st + 1]); w.y = pk2(s[8 * st + 2], s[8 * st + 3]); w.z = pk2(s[8 * st + 4], s[8 * st + 5]); w.w = pk2(s[8 * st + 6], s[8 * st + 7]);
                    pf[st] = __builtin_bit_cast(bf16x8, w); }
#pragma unroll
                for (int st = 0; st < 2; ++st)
#pragma unroll
                    for (int eb = 0; eb < 4; ++eb) { const bf16x8 vf = *(const LAS bf16x8*)(vb + (eb * 32 + r) * VROW + (kbk * 2 + st) * 32 + h * 16);
                        o[eb] = MFMA32(vf, pf[st], o[eb]); }
            }
            if (more) ATT_WRITE((t + 1) & 1);
            __syncthreads();
        }
        const float lt = lsum + __shfl_xor(lsum, 32);
        if (hf == 1) {
            const float sc1 = lam / lt;
#pragma unroll
            for (int eb = 0; eb < 4; ++eb)
#pragma unroll
                for (int i = 0; i < 16; ++i) X[(eb * 32 + (i & 3) + 8 * (i >> 2) + 4 * h) * 32 + r] = o[eb][i] * sc1;
        }
        __syncthreads();
        if (hf == 0) {
            const float i0 = 1.0f / lt;
            float ss = 0.f;
#pragma unroll
            for (int eb = 0; eb < 4; ++eb)
#pragma unroll
                for (int i = 0; i < 16; ++i) { const float v = o[eb][i] * i0 - X[(eb * 32 + (i & 3) + 8 * (i >> 2) + 4 * h) * 32 + r]; o[eb][i] = v; ss += v * v; }
            ss += __shfl_xor(ss, 32);
            const float rn = rsqrtf(ss * (1.f / 128.f) + EPS) * oscale;
            bf16_t* orow = MIX + qtok * DM + 512 + head * 128;
#pragma unroll
            for (int eb = 0; eb < 4; ++eb)
#pragma unroll
                for (int g4 = 0; g4 < 4; ++g4) { const int e = eb * 32 + 8 * g4 + 4 * h;
                    const f32x4 gg = *(const f32x4*)(p.attn_norm_g + l * 128 + e);
                    u32x2 w; w.x = pk2(o[eb][4 * g4] * rn * gg[0], o[eb][4 * g4 + 1] * rn * gg[1]); w.y = pk2(o[eb][4 * g4 + 2] * rn * gg[2], o[eb][4 * g4 + 3] * rn * gg[3]);
                    *(u32x2*)(orow + e) = w; }
        }
        __syncthreads();
    }
#undef ATT_WRITE
}

__global__ void __launch_bounds__(512, 2) fwd_megakernel(Params p) {
    extern __shared__ __attribute__((aligned(16))) unsigned char shm[];
    LAS unsigned char* lds = (LAS unsigned char*)shm;
    cg::grid_group grid = cg::this_grid();
    const int G = gridDim.x, c = blockIdx.x;
    float* mod = (float*)(p.ws + WS_MOD);
    bf16_t* H = (bf16_t*)(p.ws + WS_H); bf16_t* Zb = (bf16_t*)(p.ws + WS_Z); bf16_t* MIX = (bf16_t*)(p.ws + WS_MIX);
    for (int ph = p.ph_lo; ph < p.ph_hi; ++ph) {
        if (ph > p.ph_lo) grid.sync();
        if (ph == 0) { phase0(p, lds); continue; }
        const int l = (ph - 1) >> 3, sub = (ph - 1) & 7;
        const float* modl = mod + (size_t)l * NB * MODW;
        const float* xcur = (l == 0) ? p.x : p.out;
        if (sub == 0) { phase_norm(xcur, p.norm1_g + l * DM, modl, 0, DM, H); }
        else if (sub == 1) { pg8::StaticOrder S; S.init(MTOK, INW, G, c); pg8::Gemm g{H, (const bf16_t*)(p.ws + WS_WT_IN) + (size_t)l * INW * DM, MTOK, INW, DM};
            pg8::EpiZ E{Zb, INW}; pg8::gemm_phase(lds, g, S, E); }
        else if (sub == 2) { phase_prep(p, l, lds); }
        else if (sub == 3) { const float lambda_init = 0.8f - 0.6f * expf(-0.3f * (float)l); phase_attn(p, l, lambda_init, lds); }
        else if (sub == 4 || sub == 7) {
            pg8::StaticOrder S; S.init(MTOK, DM, G, c);
            pg8::Gemm g; pg8::EpiRes E;
            if (sub == 4) { g = pg8::Gemm{MIX, (const bf16_t*)(p.ws + WS_WT_OUT) + (size_t)l * DM * DM, MTOK, DM, DM}; E = pg8::EpiRes{xcur, p.out, modl + 2 * DM}; }
            else { g = pg8::Gemm{Zb, (const bf16_t*)(p.ws + WS_WT_DN) + (size_t)l * DM * DFF, MTOK, DM, DFF}; E = pg8::EpiRes{p.out, p.out, modl + 5 * DM}; }
            pg8::gemm_phase(lds, g, S, E); }
        else if (sub == 5) { phase_norm(p.out, p.norm2_g + l * DM, modl, 3 * DM, 4 * DM, H); }
        else { pg8::StaticOrder S; S.init(MTOK, GU, G, c); pg8::Gemm g{H, (const bf16_t*)(p.ws + WS_WT_GU) + (size_t)l * GU * DM, MTOK, GU, DM};
            pg8::EpiSwiGLU E{Zb}; pg8::gemm_phase(lds, g, S, E); }
    }
}

extern "C" void kernel_launch(void* const* d_in, const int* in_sizes, int n_in, void* d_out, int out_size, void* d_ws, size_t ws_size, hipStream_t stream) {
    static int grid = 0;
    if (grid == 0) {
        if (n_in != 23 || ws_size < WS_END) { fprintf(stderr, "kernel_launch: unexpected n_in %d or ws_size %zu < %zu\n", n_in, ws_size, (size_t)WS_END); grid = -1; return; }
        int dev = 0, cus = 0, per_cu = 0;
        if (hipGetDevice(&dev) != hipSuccess || hipDeviceGetAttribute(&cus, hipDeviceAttributeMultiprocessorCount, dev) != hipSuccess) { grid = -1; return; }
        if (hipFuncSetAttribute((const void*)fwd_megakernel, hipFuncAttributeMaxDynamicSharedMemorySize, LDS_BYTES) != hipSuccess) { fprintf(stderr, "kernel_launch: hipFuncSetAttribute failed\n"); grid = -1; return; }
        if (hipOccupancyMaxActiveBlocksPerMultiprocessor(&per_cu, (const void*)fwd_megakernel, 512, LDS_BYTES) != hipSuccess || per_cu < 1) { fprintf(stderr, "kernel_launch: occupancy query says %d\n", per_cu); per_cu = 1; }
        (void)hipGetLastError();
        grid = cus;
    }
    if (grid < 0) return;
    Params p{};
    p.x = (const float*)d_in[0]; p.c = (const float*)d_in[1]; p.pos = (const int*)d_in[2];
    p.norm1_g = (const float*)d_in[3]; p.norm2_g = (const float*)d_in[4]; p.w_ada = (const float*)d_in[5]; p.b_ada = (const float*)d_in[6];
    p.w_in = (const float*)d_in[7]; p.conv_a_w = (const float*)d_in[8]; p.conv_a_b = (const float*)d_in[9]; p.conv_a_norm_g = (const float*)d_in[10];
    p.conv_b_w = (const float*)d_in[11]; p.sc_norm_g = (const float*)d_in[12]; p.q_norm_g = (const float*)d_in[13]; p.k_norm_g = (const float*)d_in[14];
    p.lam_q1 = (const float*)d_in[15]; p.lam_k1 = (const float*)d_in[16]; p.lam_q2 = (const float*)d_in[17]; p.lam_k2 = (const float*)d_in[18];
    p.attn_norm_g = (const float*)d_in[19]; p.w_out = (const float*)d_in[20]; p.w_gate_up = (const float*)d_in[21]; p.w_down = (const float*)d_in[22];
    p.out = (float*)d_out; p.ws = (unsigned char*)d_ws;
#if MK_MULTI
    for (int ph = 0; ph < NPHASE; ++ph) {
        p.ph_lo = ph; p.ph_hi = ph + 1;
        hipLaunchKernelGGL(fwd_megakernel, dim3(grid), dim3(512), LDS_BYTES, stream, p);
    }
#else
    p.ph_lo = 0; p.ph_hi = NPHASE;
    void* args[] = {&p};
    hipError_t e = hipLaunchCooperativeKernel((const void*)fwd_megakernel, dim3(grid), dim3(512), args, LDS_BYTES, stream);
    if (e != hipSuccess) fprintf(stderr, "kernel_launch: cooperative launch failed: %s (grid %d)\n", hipGetErrorString(e), grid);
#endif
}
```

```cpp
#include <hip/hip_runtime.h>
#include <hip/hip_cooperative_groups.h>
#include <cstdio>
namespace cg = cooperative_groups;

#ifndef MK_MULTI
#define MK_MULTI 0
#endif

#define LAS __attribute__((address_space(3)))
#define DI __device__ __forceinline__
typedef unsigned short bf16_t;
typedef short bf16x8 __attribute__((ext_vector_type(8)));
typedef float f32x4 __attribute__((ext_vector_type(4)));
typedef float f32x2 __attribute__((ext_vector_type(2)));
typedef float f32x16 __attribute__((ext_vector_type(16)));
typedef unsigned u32x4 __attribute__((ext_vector_type(4)));
typedef unsigned u32x2 __attribute__((ext_vector_type(2)));
typedef __bf16 bf16x2n __attribute__((ext_vector_type(2)));

constexpr int NB = 32, SEQ = 2048, DM = 1024, MTOK = NB * SEQ, NL = 4, INW = 2816, DFF = 2816, GU = 2 * DFF;
constexpr int MODW = 6 * DM;
constexpr float EPS = 1e-6f;
constexpr float LOG2E = 1.4426950408889634f;
constexpr int LDS_BYTES = 131072 + 16;
constexpr int NPHASE = 1 + 8 * NL;

constexpr size_t WS_WT_IN = 0;
constexpr size_t WS_WT_OUT = WS_WT_IN + (size_t)NL * INW * DM * 2;
constexpr size_t WS_WT_GU = WS_WT_OUT + (size_t)NL * DM * DM * 2;
constexpr size_t WS_WT_DN = WS_WT_GU + (size_t)NL * GU * DM * 2;
constexpr size_t WS_MOD = WS_WT_DN + (size_t)NL * DM * DFF * 2;
constexpr size_t WS_ROPE = WS_MOD + (size_t)NL * NB * MODW * 4;
constexpr size_t WS_H = WS_ROPE + (size_t)2 * SEQ * 32 * 4;
constexpr size_t WS_Z = WS_H + (size_t)MTOK * DM * 2;
constexpr size_t WS_QH = WS_Z + (size_t)MTOK * INW * 2;
constexpr size_t WS_KH = WS_QH + (size_t)MTOK * 512 * 2;
constexpr size_t WS_MIX = WS_KH + (size_t)MTOK * 512 * 2;
constexpr size_t WS_BAR = WS_MIX + (size_t)MTOK * DM * 2;
constexpr size_t WS_END = WS_BAR + 16384;

struct Params {
    const float* x; const float* c; const int* pos;
    const float *norm1_g, *norm2_g, *w_ada, *b_ada, *w_in, *conv_a_w, *conv_a_b, *conv_a_norm_g, *conv_b_w, *sc_norm_g,
        *q_norm_g, *k_norm_g, *lam_q1, *lam_k1, *lam_q2, *lam_k2, *attn_norm_g, *w_out, *w_gate_up, *w_down;
    float* out; unsigned char* ws;
    int ph_lo, ph_hi;
};

DI unsigned pk2(float lo, float hi) { f32x2 v = {lo, hi}; return __builtin_bit_cast(unsigned, __builtin_convertvector(v, bf16x2n)); }
DI float bf_lo(unsigned u) { return __uint_as_float(u << 16); }
DI float bf_hi(unsigned u) { return __uint_as_float(u & 0xffff0000u); }
DI float wave_sum(float v) {
#pragma unroll
    for (int o = 1; o < 64; o <<= 1) v += __shfl_xor(v, o);
    return v;
}
DI float wave_max(float v) {
#pragma unroll
    for (int o = 1; o < 64; o <<= 1) v = fmaxf(v, __shfl_xor(v, o));
    return v;
}
DI int opq(int v) { asm volatile("" : "+v"(v)); return v; }
DI float sigmoidf_fast(float v) { return __builtin_amdgcn_rcpf(1.0f + __builtin_amdgcn_exp2f(-v * LOG2E)); }

namespace pg8 {
constexpr int BM = 256, BK = 64, HALF = 128, HTB = HALF * BK * 2, NXCD = 8, WGM = 8;
DI int lds_byte(int r, int c) { const int st = (r >> 4) * 2 + (c >> 5), rr = r & 15, cc = c & 31, ob = rr * 64 + cc * 2; return st * 1024 + (ob ^ (((ob >> 9) & 1) << 5)); }
DI void stage_rc(int b, int& R, int& C) { const int st = b / 1024, sb = b % 1024, swz = sb ^ (((sb >> 9) & 1) << 5); R = (st >> 1) * 16 + swz / 64; C = (st & 1) * 32 + (swz % 64) / 2; }
DI int perm32(int rho) { const int n = rho >> 4, i = rho & 15; return 8 * (i >> 2) + 4 * n + (i & 3); }
struct Unit { int pm, pn; };
struct Gemm { const bf16_t* A; const bf16_t* Bt; int M, N, K; };
struct StaticOrder {
    int nM, nN, nwg, G, c;
    DI void init(int M, int N, int G_, int c_) { nM = M / BM; nN = N / BM; nwg = nM * nN; G = G_; c = c_; }
    DI bool next(int i, Unit& u) const {
        const long L = (long)i * G + c; if (L >= nwg) return false;
        int wgid = (int)L; { const int q = nwg / NXCD, r = nwg % NXCD, xcd = wgid % NXCD, off = wgid / NXCD; wgid = (xcd < r ? xcd * (q + 1) : r * (q + 1) + (xcd - r) * q) + off; }
        const int nig = WGM * nN, gid = wgid / nig, fm = gid * WGM, gsz = (nM - fm) < WGM ? (nM - fm) : WGM;
        u.pm = fm + ((wgid % nig) % gsz); u.pn = (wgid % nig) / gsz; return true;
    }
};

struct EpiZ {
    static constexpr bool PERM = true;
    bf16_t* O; int ldc;
    DI void operator()(const f32x4 (&acc)[2][2][4][2], const Unit& u, int wr, int wc, int fr, int fq) const {
        const int row0 = u.pm * BM + wr * 64 + fr, col0 = u.pn * BM + wc * 32 + 8 * fq;
#pragma unroll
        for (int ai = 0; ai < 2; ++ai)
#pragma unroll
            for (int m = 0; m < 4; ++m) { bf16_t* rowp = O + (size_t)(row0 + ai * HALF + m * 16) * ldc + col0;
#pragma unroll
                for (int bj = 0; bj < 2; ++bj) { const f32x4 v0 = acc[ai][bj][m][0], v1 = acc[ai][bj][m][1];
                    u32x4 w; w.x = pk2(v0[0], v0[1]); w.y = pk2(v0[2], v0[3]); w.z = pk2(v1[0], v1[1]); w.w = pk2(v1[2], v1[3]);
                    *(u32x4*)(rowp + bj * HALF) = w; } }
    }
};
struct EpiRes {
    static constexpr bool PERM = false;
    const float* xin; float* xout; const float* gate;
    DI void operator()(const f32x4 (&acc)[2][2][4][2], const Unit& u, int wr, int wc, int fr, int fq) const {
        const int row0 = u.pm * BM + wr * 64 + fr, col0 = u.pn * BM + wc * 32 + 4 * fq, b = (u.pm * BM) / SEQ;
        f32x4 gv[2][2];
#pragma unroll
        for (int bj = 0; bj < 2; ++bj)
#pragma unroll
            for (int n = 0; n < 2; ++n) gv[bj][n] = *(const f32x4*)(gate + (size_t)b * MODW + col0 + bj * HALF + n * 16);
#pragma unroll
        for (int ai = 0; ai < 2; ++ai)
#pragma unroll
            for (int mp = 0; mp < 2; ++mp) {
                f32x4 xv[2][2][2];
#pragma unroll
                for (int mm = 0; mm < 2; ++mm) { const size_t off = (size_t)(row0 + ai * HALF + (2 * mp + mm) * 16) * DM + col0;
#pragma unroll
                    for (int bj = 0; bj < 2; ++bj)
#pragma unroll
                        for (int n = 0; n < 2; ++n) xv[mm][bj][n] = *(const f32x4*)(xin + off + bj * HALF + n * 16); }
#pragma unroll
                for (int mm = 0; mm < 2; ++mm) { const size_t off = (size_t)(row0 + ai * HALF + (2 * mp + mm) * 16) * DM + col0;
#pragma unroll
                    for (int bj = 0; bj < 2; ++bj)
#pragma unroll
                        for (int n = 0; n < 2; ++n) *(f32x4*)(xout + off + bj * HALF + n * 16) = xv[mm][bj][n] + gv[bj][n] * acc[ai][bj][2 * mp + mm][n]; }
                asm volatile("" ::: "memory");
            }
    }
};
struct EpiSwiGLU {
    static constexpr bool PERM = true;
    bf16_t* O;
    DI void operator()(const f32x4 (&acc)[2][2][4][2], const Unit& u, int wr, int wc, int fr, int fq) const {
        const int row0 = u.pm * BM + wr * 64 + fr, colh = u.pn * 128 + wc * 16 + 4 * fq;
#pragma unroll
        for (int ai = 0; ai < 2; ++ai)
#pragma unroll
            for (int m = 0; m < 4; ++m) { bf16_t* rowp = O + (size_t)(row0 + ai * HALF + m * 16) * DFF + colh;
#pragma unroll
                for (int bj = 0; bj < 2; ++bj) { const f32x4 g = acc[ai][bj][m][0], uu = acc[ai][bj][m][1];
                    float a[4];
#pragma unroll
                    for (int i = 0; i < 4; ++i) a[i] = g[i] * sigmoidf_fast(g[i]) * uu[i];
                    u32x2 w; w.x = pk2(a[0], a[1]); w.y = pk2(a[2], a[3]);
                    *(u32x2*)(rowp + bj * 64) = w; } }
    }
};

template <class Epi, class Sched>
DI void gemm_phase(LAS unsigned char* lds, const Gemm g, const Sched& S, const Epi& E) {
    const int tid = opq(threadIdx.x), wid = __builtin_amdgcn_readfirstlane(tid >> 6), lane = tid & 63, wr = wid >> 2, wc = wid & 3, fr = lane & 15, fq = lane >> 4;
    const int K = g.K, nt = K / BK;
    unsigned voffA[2], voffB[2];
#pragma unroll
    for (int i = 0; i < 2; ++i) { int R, C; stage_rc(tid * 16 + i * 8192, R, C); const int Rb = Epi::PERM ? ((R & ~31) + perm32(R & 31)) : R;
        voffA[i] = (unsigned)(R * K + C) * 2u; voffB[i] = (unsigned)(Rb * K + C) * 2u; }
    const size_t kstep = (size_t)(BK * 2);
    const size_t hstep = (size_t)HALF * K * 2;
    const size_t tstep = 2 * hstep;
    const unsigned ldsw = (unsigned)wid * 1024u;
    const int aoff = lds_byte(wr * 64 + fr, fq * 8), boff = lds_byte(wc * 32 + fr, fq * 8);
#define PG8_SA(b, h) (((b) * 2 + (h)) * HTB)
#define PG8_SB(b, h) ((4 + (b) * 2 + (h)) * HTB)
#define PG8_STAGE(bufoff, gbase, voff) do { _Pragma("unroll") for (int _i = 0; _i < 2; ++_i) \
        __builtin_amdgcn_global_load_lds((const unsigned*)((const char*)(gbase) + (voff)[_i]), (LAS unsigned*)(lds + (bufoff) + ldsw + _i * 8192), 16, 0, 0); } while (0)
#define PG8_LDA(dst, b, h) do { _Pragma("unroll") for (int m = 0; m < 4; ++m) _Pragma("unroll") for (int k = 0; k < 2; ++k) dst[m][k] = *(const LAS bf16x8*)(lds + PG8_SA(b, h) + aoff + m * 2048 + k * 1024); } while (0)
#define PG8_LDB(dst, b, h) do { _Pragma("unroll") for (int n = 0; n < 2; ++n) _Pragma("unroll") for (int k = 0; k < 2; ++k) dst[n][k] = *(const LAS bf16x8*)(lds + PG8_SB(b, h) + boff + n * 2048 + k * 1024); } while (0)
#define PG8_MMA(ai, bj, At, Bt) do { __builtin_amdgcn_s_setprio(1); _Pragma("unroll") for (int m = 0; m < 4; ++m) _Pragma("unroll") for (int n = 0; n < 2; ++n) _Pragma("unroll") for (int k = 0; k < 2; ++k) \
        acc[ai][bj][m][n] = __builtin_amdgcn_mfma_f32_16x16x32_bf16(Bt[n][k], At[m][k], acc[ai][bj][m][n], 0, 0, 0); __builtin_amdgcn_s_setprio(0); } while (0)
#define PG8_WAIT_V(n) asm volatile("s_waitcnt vmcnt(" #n ")" ::: "memory")
#define PG8_WAIT_L(n) asm volatile("s_waitcnt lgkmcnt(" #n ")" ::: "memory")
#define PG8_BAR __builtin_amdgcn_s_barrier()
#define PG8_SCHED __builtin_amdgcn_sched_barrier(0)
    Unit cur, nxt; int ui = 0;
    if (!S.next(0, cur)) return;
    f32x4 acc[2][2][4][2];
#pragma unroll
    for (int a = 0; a < 2; ++a)
#pragma unroll
        for (int b = 0; b < 2; ++b)
#pragma unroll
            for (int m = 0; m < 4; ++m)
#pragma unroll
                for (int n = 0; n < 2; ++n) acc[a][b][m][n] = (f32x4){0.f, 0.f, 0.f, 0.f};
    bf16x8 At[4][2], B0[2][2], B1[2][2];
    const char* cA = (const char*)g.A + (size_t)cur.pm * tstep; const char* cB = (const char*)g.Bt + (size_t)cur.pn * tstep;
    PG8_STAGE(PG8_SB(0, 0), cB, voffB); PG8_STAGE(PG8_SA(0, 0), cA, voffA); PG8_STAGE(PG8_SB(0, 1), cB + hstep, voffB); PG8_STAGE(PG8_SA(0, 1), cA + hstep, voffA);
    if (wr == 1) PG8_BAR;
    PG8_WAIT_V(4); PG8_BAR;
    PG8_STAGE(PG8_SB(1, 0), cB + kstep, voffB); PG8_STAGE(PG8_SA(1, 0), cA + kstep, voffA); PG8_STAGE(PG8_SB(1, 1), cB + hstep + kstep, voffB);
    PG8_WAIT_V(6); PG8_BAR;
    for (;;) {
        const bool has_next = S.next(ui + 1, nxt);
        const char* nA = has_next ? (const char*)g.A + (size_t)nxt.pm * tstep : cA; const char* nB = has_next ? (const char*)g.Bt + (size_t)nxt.pn * tstep : cB;
        for (int t = 0; t < nt; t += 2) {
            const bool last = (t == nt - 2);
            const char* a1 = cA + (size_t)(t + 1) * kstep;
            const char* a2 = last ? nA : cA + (size_t)(t + 2) * kstep; const char* b2 = last ? nB : cB + (size_t)(t + 2) * kstep;
            const char* a3 = a2 + kstep; const char* b3 = b2 + kstep;
            PG8_LDB(B0, 0, 0); PG8_SCHED; PG8_LDA(At, 0, 0); PG8_STAGE(PG8_SA(1, 1), a1 + hstep, voffA);
            PG8_WAIT_L(8); PG8_BAR; PG8_WAIT_L(0); PG8_MMA(0, 0, At, B0); PG8_BAR; PG8_SCHED;
            PG8_LDB(B1, 0, 1); PG8_STAGE(PG8_SB(0, 0), b2, voffB);
            PG8_BAR; PG8_WAIT_L(0); PG8_MMA(0, 1, At, B1); PG8_BAR;
            PG8_LDA(At, 0, 1); PG8_STAGE(PG8_SA(0, 0), a2, voffA);
            PG8_BAR; PG8_WAIT_L(0); PG8_MMA(1, 0, At, B0); PG8_BAR; PG8_SCHED;
            PG8_STAGE(PG8_SB(0, 1), b2 + hstep, voffB);
            PG8_WAIT_V(6); PG8_BAR; PG8_MMA(1, 1, At, B1); PG8_BAR;
            PG8_LDB(B0, 1, 0); PG8_SCHED; PG8_LDA(At, 1, 0); PG8_STAGE(PG8_SA(0, 1), a2 + hstep, voffA);
            PG8_WAIT_L(8); PG8_BAR; PG8_WAIT_L(0); PG8_MMA(0, 0, At, B0); PG8_BAR; PG8_SCHED;
            PG8_LDB(B1, 1, 1); PG8_STAGE(PG8_SB(1, 0), b3, voffB);
            PG8_BAR; PG8_WAIT_L(0); PG8_MMA(0, 1, At, B1); PG8_BAR;
            PG8_LDA(At, 1, 1); PG8_STAGE(PG8_SA(1, 0), a3, voffA);
            PG8_BAR; PG8_WAIT_L(0); PG8_MMA(1, 0, At, B0); PG8_BAR; PG8_SCHED;
            PG8_STAGE(PG8_SB(1, 1), b3 + hstep, voffB);
            PG8_WAIT_V(6); PG8_BAR; PG8_MMA(1, 1, At, B1); PG8_BAR;
        }
        E(acc, cur, wr, wc, fr, fq);
        if (!has_next) break;
#pragma unroll
        for (int a = 0; a < 2; ++a)
#pragma unroll
            for (int b = 0; b < 2; ++b)
#pragma unroll
                for (int m = 0; m < 4; ++m)
#pragma unroll
                    for (int n = 0; n < 2; ++n) acc[a][b][m][n] = (f32x4){0.f, 0.f, 0.f, 0.f};
        cur = nxt; cA = nA; cB = nB; ++ui;
    }
    PG8_WAIT_V(0);
    if (wr == 0) PG8_BAR;
    PG8_BAR;
#undef PG8_SA
#undef PG8_SB
#undef PG8_STAGE
#undef PG8_LDA
#undef PG8_LDB
#undef PG8_MMA
#undef PG8_WAIT_V
#undef PG8_WAIT_L
#undef PG8_BAR
#undef PG8_SCHED
}
}

template <int MODE>
DI int wrow_map(int n) { if (MODE == 0) return n; const int isu = n >= DFF ? 1 : 0, j = n - isu * DFF; return 8 * (j >> 2) + 4 * isu + (j & 3); }
template <int MODE>
DI void p0_transpose_item(const float* W, int K, int N, bf16_t* WT, LAS float* scr, int item, int lane) {
    const int nblk = N / 32, kb = item / nblk, nb = item % nblk, k0 = 64 * kb, n0 = 32 * nb;
#pragma unroll 8
    for (int i = 0; i < 32; ++i) { const int kk = 2 * i + (lane >> 5); scr[kk * 33 + (lane & 31)] = W[(size_t)(k0 + kk) * N + n0 + (lane & 31)]; }
    asm volatile("s_waitcnt lgkmcnt(0)" ::: "memory");
    const int c = lane & 7;
#pragma unroll
    for (int j = 0; j < 4; ++j) { const int n = (lane >> 3) + 8 * j; const LAS float* s = scr + (8 * c) * 33 + n;
        u32x4 o; o.x = pk2(s[0 * 33], s[1 * 33]); o.y = pk2(s[2 * 33], s[3 * 33]); o.z = pk2(s[4 * 33], s[5 * 33]); o.w = pk2(s[6 * 33], s[7 * 33]);
        *(u32x4*)(WT + (size_t)wrow_map<MODE>(n0 + n) * K + k0 + 8 * c) = o; }
    asm volatile("s_waitcnt lgkmcnt(0)" ::: "memory");
}

DI void phase0(const Params& p, LAS unsigned char* lds) {
    const int tid = opq(threadIdx.x), lane = tid & 63, wave = tid >> 6, G = gridDim.x;
    {
        LAS float* cact = (LAS float*)lds;
        float* mod = (float*)(p.ws + WS_MOD);
        constexpr int NITEM = NL * (MODW / 64);
        for (int it = blockIdx.x; it < NITEM; it += G) {
            const int l = it / (MODW / 64), n0 = (it % (MODW / 64)) * 64;
            for (int idx = tid; idx < NB * DM; idx += 512) { const int k = idx >> 5, b = idx & 31; const float v = p.c[b * DM + k]; cact[idx] = v * sigmoidf_fast(v); }
            __syncthreads();
            float acc[32];
#pragma unroll
            for (int b = 0; b < 32; ++b) acc[b] = 0.f;
            const float* wp = p.w_ada + ((size_t)l * DM + 128 * wave) * MODW + n0 + lane;
            const LAS f32x4* cp = (const LAS f32x4*)(cact + (128 * wave) * 32);
#pragma unroll 8
            for (int kk = 0; kk < 128; ++kk) {
                const float wv = wp[(size_t)kk * MODW];
#pragma unroll
                for (int q = 0; q < 8; ++q) { const f32x4 cv = cp[kk * 8 + q]; acc[4 * q] += cv[0] * wv; acc[4 * q + 1] += cv[1] * wv; acc[4 * q + 2] += cv[2] * wv; acc[4 * q + 3] += cv[3] * wv; }
            }
            __syncthreads();
            LAS float* red = (LAS float*)lds;
#pragma unroll
            for (int b = 0; b < 32; ++b) red[(wave * 32 + b) * 64 + lane] = acc[b];
            __syncthreads();
#pragma unroll
            for (int j = 0; j < 4; ++j) { const int o = tid + 512 * j, b = o >> 6, n = o & 63; float s = p.b_ada[l * MODW + n0 + n];
#pragma unroll
                for (int w = 0; w < 8; ++w) s += red[(w * 32 + b) * 64 + n];
                mod[((size_t)l * NB + b) * MODW + n0 + n] = s; }
            __syncthreads();
        }
    }
    {
        LAS float* scr = (LAS float*)(lds + wave * 16384);
        const int gw = blockIdx.x * 8 + wave, NGW = G * 8;
        constexpr int I_IN = (DM / 64) * (INW / 32), I_OUT = (DM / 64) * (DM / 32), I_GU = (DM / 64) * (GU / 32), I_DN = (DFF / 64) * (DM / 32);
        constexpr int PER_L = I_IN + I_OUT + I_GU + I_DN;
        for (int it = gw; it < NL * PER_L; it += NGW) {
            const int l = it / PER_L; int r = it % PER_L;
            if (r < I_IN) { p0_transpose_item<0>(p.w_in + (size_t)l * DM * INW, DM, INW, (bf16_t*)(p.ws + WS_WT_IN) + (size_t)l * INW * DM, scr, r, lane); continue; } r -= I_IN;
            if (r < I_OUT) { p0_transpose_item<0>(p.w_out + (size_t)l * DM * DM, DM, DM, (bf16_t*)(p.ws + WS_WT_OUT) + (size_t)l * DM * DM, scr, r, lane); continue; } r -= I_OUT;
            if (r < I_GU) { p0_transpose_item<1>(p.w_gate_up + (size_t)l * DM * GU, DM, GU, (bf16_t*)(p.ws + WS_WT_GU) + (size_t)l * GU * DM, scr, r, lane); continue; } r -= I_GU;
            p0_transpose_item<0>(p.w_down + (size_t)l * DFF * DM, DFF, DM, (bf16_t*)(p.ws + WS_WT_DN) + (size_t)l * DM * DFF, scr, r, lane);
        }
    }
    {
        float* rc = (float*)(p.ws + WS_ROPE); float* rs = rc + SEQ * 32;
        for (int idx = blockIdx.x * 512 + tid; idx < SEQ * 32; idx += G * 512) {
            const int s = idx >> 5, i = idx & 31;
            const double inv = exp2(-(double)i * (13.287712379549449 / 32.0));
            const double rev = (double)p.pos[s] * inv * 0.15915494309189535;
            const float fr = (float)(rev - floor(rev));
            rc[idx] = __builtin_amdgcn_cosf(fr); rs[idx] = __builtin_amdgcn_sinf(fr);
        }
    }
}

DI void phase_norm(const float* x, const float* g, const float* modl, int sh_off, int sc_off, bf16_t* H) {
    const int tid = opq(threadIdx.x), lane = tid & 63, wave = tid >> 6, NGW = gridDim.x * 8;
    for (int rb = blockIdx.x * 8 + wave; rb < MTOK / 32; rb += NGW) {
        const int b = (rb * 32) / SEQ;
        f32x4 gs[4], sh[4];
#pragma unroll
        for (int j = 0; j < 4; ++j) { const int col = 4 * lane + 256 * j;
            const f32x4 gg = *(const f32x4*)(g + col), sc = *(const f32x4*)(modl + (size_t)b * MODW + sc_off + col);
            gs[j] = gg * (sc + 1.0f); sh[j] = *(const f32x4*)(modl + (size_t)b * MODW + sh_off + col); }
        for (int r = 0; r < 32; ++r) {
            const size_t row = (size_t)rb * 32 + r;
            const f32x4* xr = (const f32x4*)(x + row * DM) + lane;
            f32x4 v[4]; float s = 0.f;
#pragma unroll
            for (int j = 0; j < 4; ++j) { v[j] = xr[64 * j]; s += (v[j][0] * v[j][0] + v[j][1] * v[j][1]) + (v[j][2] * v[j][2] + v[j][3] * v[j][3]); }
            const float rstd = rsqrtf(wave_sum(s) * (1.f / DM) + EPS);
            u32x2* o8 = (u32x2*)(H + row * DM) + lane;
#pragma unroll
            for (int j = 0; j < 4; ++j) { const f32x4 y = v[j] * rstd * gs[j] + sh[j]; u32x2 w; w.x = pk2(y[0], y[1]); w.y = pk2(y[2], y[3]); o8[64 * j] = w; }
        }
    }
}

DI void phase_prep(const Params& p, int l, LAS unsigned char* lds) {
    const int tid = opq(threadIdx.x), lane = tid & 63, wave = tid >> 6, G = gridDim.x;
    const bf16_t* Z = (const bf16_t*)(p.ws + WS_Z);
    bf16_t* MIX = (bf16_t*)(p.ws + WS_MIX); bf16_t* QH = (bf16_t*)(p.ws + WS_QH); bf16_t* KH = (bf16_t*)(p.ws + WS_KH);
    const float* rc = (const float*)(p.ws + WS_ROPE); const float* rs = rc + SEQ * 32;
    LAS float* U = (LAS float*)lds;
    LAS float* CV = (LAS float*)(lds + 65536);
    const int cch = tid & 255, th = tid >> 8;
    float cw[31];
#pragma unroll
    for (int j = 0; j < 31; ++j) cw[j] = p.conv_a_w[((size_t)l * 31 + j) * 256 + cch];
    const float cbias = p.conv_a_b[l * 256 + cch];
    const f32x4 ga = *(const f32x4*)(p.conv_a_norm_g + l * 256 + 4 * lane);
    const f32x4 gb = *(const f32x4*)(p.sc_norm_g + l * 256 + 4 * lane);
    f32x4 wb[3];
#pragma unroll
    for (int j = 0; j < 3; ++j) wb[j] = *(const f32x4*)(p.conv_b_w + ((size_t)l * 3 + j) * 256 + 4 * lane);
    const int sub = lane & 7, d0 = sub * 8, dp = d0 ^ 32;
    float gq[8], gk[8], gqp[8], gkp[8];
#pragma unroll
    for (int i = 0; i < 8; ++i) { gq[i] = p.q_norm_g[l * 64 + d0 + i]; gk[i] = p.k_norm_g[l * 64 + d0 + i]; gqp[i] = p.q_norm_g[l * 64 + dp + i]; gkp[i] = p.k_norm_g[l * 64 + dp + i]; }
    const float qscale = LOG2E * 0.125f;
    const float sgn = (sub < 4) ? -1.f : 1.f;

    for (int it = blockIdx.x; it < MTOK / 32; it += G) {
        const int b = it >> 6, t0 = (it & 63) * 32;
        const size_t tokbase = (size_t)b * SEQ;
        for (int ci = tid; ci < 62 * 32; ci += 512) {
            const int row = ci >> 5, ch8 = ci & 31, tok = t0 - 15 + row;
            f32x4 o0 = {0.f, 0.f, 0.f, 0.f}, o1 = o0;
            if (tok >= 0 && tok < SEQ) {
                const bf16_t* zp = Z + (tokbase + tok) * INW + ch8 * 8;
                const u32x4 v = *(const u32x4*)zp, gt = *(const u32x4*)(zp + 256);
                o0[0] = bf_lo(v.x) * sigmoidf_fast(bf_lo(gt.x)); o0[1] = bf_hi(v.x) * sigmoidf_fast(bf_hi(gt.x));
                o0[2] = bf_lo(v.y) * sigmoidf_fast(bf_lo(gt.y)); o0[3] = bf_hi(v.y) * sigmoidf_fast(bf_hi(gt.y));
                o1[0] = bf_lo(v.z) * sigmoidf_fast(bf_lo(gt.z)); o1[1] = bf_hi(v.z) * sigmoidf_fast(bf_hi(gt.z));
                o1[2] = bf_lo(v.w) * sigmoidf_fast(bf_lo(gt.w)); o1[3] = bf_hi(v.w) * sigmoidf_fast(bf_hi(gt.w));
            }
            *(LAS f32x4*)(U + row * 256 + ch8 * 8) = o0; *(LAS f32x4*)(U + row * 256 + ch8 * 8 + 4) = o1;
        }
        __syncthreads();
#pragma unroll 1
        for (int chunk = 0; chunk < 2; ++chunk) {
            const int tb = th * 16 + chunk * 8;
            float uu[38];
#pragma unroll
            for (int i = 0; i < 38; ++i) uu[i] = U[(tb + i) * 256 + cch];
#pragma unroll
            for (int t = 0; t < 8; ++t) { float a = cbias;
#pragma unroll
                for (int j = 0; j < 31; ++j) a += cw[j] * uu[t + j];
                CV[(tb + t) * 256 + cch] = a; }
        }
        __syncthreads();
#pragma unroll
        for (int q = 0; q < 4; ++q) { const int t = wave * 4 + q;
            const f32x4 v = *(const LAS f32x4*)(CV + t * 256 + 4 * lane);
            const float ss = wave_sum((v[0] * v[0] + v[1] * v[1]) + (v[2] * v[2] + v[3] * v[3]));
            const f32x4 y = v * rsqrtf(ss * (1.f / 256.f) + EPS) * ga;
            f32x4 o;
#pragma unroll
            for (int i = 0; i < 4; ++i) o[i] = y[i] * sigmoidf_fast(y[i]);
            u32x2 w; w.x = pk2(o[0], o[1]); w.y = pk2(o[2], o[3]);
            *(u32x2*)(MIX + (tokbase + t0 + t) * DM + 4 * lane) = w; }
        {
            const int tw = t0 + wave * 4;
            f32x4 mrow[6], bgv[4];
#pragma unroll
            for (int r = 0; r < 6; ++r) { const int tok = tw - 1 + r; mrow[r] = (f32x4){0.f, 0.f, 0.f, 0.f};
                if (tok >= 0 && tok < SEQ) { const bf16_t* zp = Z + (tokbase + tok) * INW + 512 + 4 * lane;
                    const u32x2 cg = *(const u32x2*)(zp + 256), hv = *(const u32x2*)(zp + 512);
                    mrow[r][0] = bf_lo(cg.x) * bf_lo(hv.x); mrow[r][1] = bf_hi(cg.x) * bf_hi(hv.x); mrow[r][2] = bf_lo(cg.y) * bf_lo(hv.y); mrow[r][3] = bf_hi(cg.y) * bf_hi(hv.y);
                    if (r >= 1 && r <= 4) { const u32x2 bg = *(const u32x2*)zp; bgv[r - 1][0] = bf_lo(bg.x); bgv[r - 1][1] = bf_hi(bg.x); bgv[r - 1][2] = bf_lo(bg.y); bgv[r - 1][3] = bf_hi(bg.y); } } }
#pragma unroll
            for (int q = 0; q < 4; ++q) {
                const f32x4 y = bgv[q] * (wb[0] * mrow[q] + wb[1] * mrow[q + 1] + wb[2] * mrow[q + 2]);
                const float ss = wave_sum((y[0] * y[0] + y[1] * y[1]) + (y[2] * y[2] + y[3] * y[3]));
                const f32x4 o = y * rsqrtf(ss * (1.f / 256.f) + EPS) * gb;
                u32x2 w; w.x = pk2(o[0], o[1]); w.y = pk2(o[2], o[3]);
                *(u32x2*)(MIX + (tokbase + tw + q) * DM + 256 + 4 * lane) = w; }
        }
#pragma unroll 1
        for (int q = 0; q < 4; ++q) {
            const int ts = t0 + wave * 4 + q; const size_t tok = tokbase + ts;
            const f32x4 c0 = *(const f32x4*)(rc + ts * 32 + (sub & 3) * 8), c1 = *(const f32x4*)(rc + ts * 32 + (sub & 3) * 8 + 4);
            const f32x4 s0 = *(const f32x4*)(rs + ts * 32 + (sub & 3) * 8), s1 = *(const f32x4*)(rs + ts * 32 + (sub & 3) * 8 + 4);
            const float cs[8] = {c0[0], c0[1], c0[2], c0[3], c1[0], c1[1], c1[2], c1[3]};
            const float sn[8] = {s0[0], s0[1], s0[2], s0[3], s1[0], s1[1], s1[2], s1[3]};
#pragma unroll
            for (int qk = 0; qk < 2; ++qk) {
                const u32x4 raw = *(const u32x4*)(Z + tok * INW + 1280 + qk * 512 + lane * 8);
                float t[8] = {bf_lo(raw.x), bf_hi(raw.x), bf_lo(raw.y), bf_hi(raw.y), bf_lo(raw.z), bf_hi(raw.z), bf_lo(raw.w), bf_hi(raw.w)};
                float ss = 0.f;
#pragma unroll
                for (int i = 0; i < 8; ++i) ss += t[i] * t[i];
                ss += __shfl_xor(ss, 1); ss += __shfl_xor(ss, 2); ss += __shfl_xor(ss, 4);
                const float rstd = rsqrtf(ss * (1.f / 64.f) + EPS) * (qk == 0 ? qscale : 1.f);
                float o[8];
#pragma unroll
                for (int i = 0; i < 8; ++i) {
                    const float tp = __shfl_xor(t[i], 4);
                    const float a = t[i] * rstd * (qk == 0 ? gq[i] : gk[i]), bp = tp * rstd * (qk == 0 ? gqp[i] : gkp[i]);
                    o[i] = a * cs[i] + sgn * bp * sn[i];
                }
                u32x4 w; w.x = pk2(o[0], o[1]); w.y = pk2(o[2], o[3]); w.z = pk2(o[4], o[5]); w.w = pk2(o[6], o[7]);
                *(u32x4*)((qk == 0 ? QH : KH) + tok * 512 + lane * 8) = w;
            }
        }
        __syncthreads();
    }
}

constexpr int KROW = 272, VROW = 144, KBYTES = 64 * KROW, VBYTES = 128 * VROW, ABUF = KBYTES + VBYTES;
#define MFMA32(a, b, c) __builtin_amdgcn_mfma_f32_32x32x16_bf16((a), (b), (c), 0, 0, 0)

DI void phase_attn(const Params& p, int l, float lambda_init, LAS unsigned char* lds) {
    const int tid = opq(threadIdx.x), lane = tid & 63, wave = tid >> 6, G = gridDim.x, r = lane & 31, h = lane >> 5;
    const int rg = wave >> 1, hf = wave & 1;
    const bf16_t* Z = (const bf16_t*)(p.ws + WS_Z);
    const bf16_t* QH = (const bf16_t*)(p.ws + WS_QH); const bf16_t* KH = (const bf16_t*)(p.ws + WS_KH);
    bf16_t* MIX = (bf16_t*)(p.ws + WS_MIX);
    const float sa = wave_sum(p.lam_q1[l * 64 + lane] * p.lam_k1[l * 64 + lane]), sb = wave_sum(p.lam_q2[l * 64 + lane] * p.lam_k2[l * 64 + lane]);
    const float lam = expf(sa) - expf(sb) + lambda_init;
    const float oscale = 1.0f - lambda_init;
    const int kkey = tid >> 3, kch = tid & 7;
    const int vkp = tid & 31, vec = tid >> 5;
    const int vk = 2 * vkp, vkq = vk & 15;
    const int vpos = (vk & ~15) + 8 * ((vkq >> 2) & 1) + (vkq & 3) + 4 * (vkq >> 3);
    const int vcu = (G % 8 == 0) ? ((blockIdx.x & 7) * (G >> 3) + (blockIdx.x >> 3)) : blockIdx.x;
    LAS float* X = (LAS float*)lds + rg * (128 * 32);

    for (int it = vcu; it < NB * 4 * 16; it += G) {
        const int qblk = it & 15, head = (it >> 4) & 3, b = it >> 6;
        const size_t tokb = (size_t)b * SEQ;
        const size_t qtok = tokb + qblk * 128 + rg * 32 + r;
        bf16x8 qf[4];
#pragma unroll
        for (int kk = 0; kk < 4; ++kk) qf[kk] = *(const bf16x8*)(QH + qtok * 512 + head * 128 + hf * 64 + kk * 16 + h * 8);
        f32x16 o[4];
#pragma unroll
        for (int eb = 0; eb < 4; ++eb)
#pragma unroll
            for (int i = 0; i < 16; ++i) o[eb][i] = 0.f;
        float lsum = 0.f;
        const bf16_t* kg = KH + (tokb + kkey) * 512 + head * 128 + kch * 16;
        const bf16_t* vg = Z + (tokb + vk) * INW + 2304 + head * 128 + vec * 8;
        u32x4 kr0 = *(const u32x4*)kg, kr1 = *(const u32x4*)(kg + 8);
        u32x4 vr0 = *(const u32x4*)vg, vr1 = *(const u32x4*)(vg + INW);
#define ATT_WRITE(buf) do { LAS unsigned char* kb_ = lds + (buf) * ABUF; LAS unsigned char* vb_ = kb_ + KBYTES; \
            *(LAS u32x4*)(kb_ + kkey * KROW + kch * 32) = kr0; *(LAS u32x4*)(kb_ + kkey * KROW + kch * 32 + 16) = kr1; \
            _Pragma("unroll") for (int i_ = 0; i_ < 4; ++i_) { \
                *(LAS unsigned*)(vb_ + (vec * 8 + 2 * i_) * VROW + vpos * 2) = (vr0[i_] & 0xffffu) | (vr1[i_] << 16); \
                *(LAS unsigned*)(vb_ + (vec * 8 + 2 * i_ + 1) * VROW + vpos * 2) = (vr0[i_] >> 16) | (vr1[i_] & 0xffff0000u); } } while (0)
        ATT_WRITE(0);
        __syncthreads();
#pragma unroll 1
        for (int t = 0; t < SEQ / 64; ++t) {
            const bool more = (t + 1 < SEQ / 64);
            if (more) { const bf16_t* kg2 = kg + (size_t)(t + 1) * 64 * 512; const bf16_t* vg2 = vg + (size_t)(t + 1) * 64 * INW;
                kr0 = *(const u32x4*)kg2; kr1 = *(const u32x4*)(kg2 + 8); vr0 = *(const u32x4*)vg2; vr1 = *(const u32x4*)(vg2 + INW); }
            const LAS unsigned char* kb = lds + (t & 1) * ABUF; const LAS unsigned char* vb = kb + KBYTES;
#pragma unroll
            for (int kbk = 0; kbk < 2; ++kbk) {
                f32x16 s;
#pragma unroll
                for (int i = 0; i < 16; ++i) s[i] = 0.f;
#pragma unroll
                for (int kk = 0; kk < 4; ++kk) { const bf16x8 a = *(const LAS bf16x8*)(kb + (kbk * 32 + r) * KROW + hf * 128 + kk * 32 + h * 16); s = MFMA32(a, qf[kk], s); }
                float ls = 0.f;
#pragma unroll
                for (int i = 0; i < 16; ++i) { s[i] = __builtin_amdgcn_exp2f(s[i]); ls += s[i]; }
                lsum += ls;
                bf16x8 pf[2];
#pragma unroll
                for (int st = 0; st < 2; ++st) { u32x4 w; w.x = pk2(s[8 * st], s[8 * st + 1]); w.y = pk2(s[8 * st + 2], s[8 * st + 3]); w.z = pk2(s[8 * st + 4], s[8 * st + 5]); w.w = pk2(s[8 * st + 6], s[8 * st + 7]);
                    pf[st] = __builtin_bit_cast(bf16x8, w); }
#pragma unroll
                for (int st = 0; st < 2; ++st)
#pragma unroll
                    for (int eb = 0; eb < 4; ++eb) { const bf16x8 vf = *(const LAS bf16x8*)(vb + (eb * 32 + r) * VROW + (kbk * 2 + st) * 32 + h * 16);
                        o[eb] = MFMA32(vf, pf[st], o[eb]); }
            }
            if (more) ATT_WRITE((t + 1) & 1);
            __syncthreads();
        }
        const float lt = lsum + __shfl_xor(lsum, 32);
        if (hf == 1) {
            const float sc1 = lam / lt;
#pragma unroll
            for (int eb = 0; eb < 4; ++eb)
#pragma unroll
                for (int i = 0; i < 16; ++i) X[(eb * 32 + (i & 3) + 8 * (i >> 2) + 4 * h) * 32 + r] = o[eb][i] * sc1;
        }
        __syncthreads();
        if (hf == 0) {
            const float i0 = 1.0f / lt;
            float ss = 0.f;
#pragma unroll
            for (int eb = 0; eb < 4; ++eb)
#pragma unroll
                for (int i = 0; i < 16; ++i) { const float v = o[eb][i] * i0 - X[(eb * 32 + (i & 3) + 8 * (i >> 2) + 4 * h) * 32 + r]; o[eb][i] = v; ss += v * v; }
            ss += __shfl_xor(ss, 32);
            const float rn = rsqrtf(ss * (1.f / 128.f) + EPS) * oscale;
            bf16_t* orow = MIX + qtok * DM + 512 + head * 128;
#pragma unroll
            for (int eb = 0; eb < 4; ++eb)
#pragma unroll
                for (int g4 = 0; g4 < 4; ++g4) { const int e = eb * 32 + 8 * g4 + 4 * h;
                    const f32x4 gg = *(const f32x4*)(p.attn_norm_g + l * 128 + e);
                    u32x2 w; w.x = pk2(o[eb][4 * g4] * rn * gg[0], o[eb][4 * g4 + 1] * rn * gg[1]); w.y = pk2(o[eb][4 * g4 + 2] * rn * gg[2], o[eb][4 * g4 + 3] * rn * gg[3]);
                    *(u32x2*)(orow + e) = w; }
        }
        __syncthreads();
    }
#undef ATT_WRITE
}

#define XB_TMO      128
#define XB_XCNT(j)  (256  + 64 * (j))
#define XB_XSUB(j)  (1280 + 64 * (j))
#define XB_XGEN(j)  (2304 + 64 * (j))
#define XB_TOP      3328
#define XB_TOPGEN   3392
#define XCD_BAR_WORDS 3456
#define XB_SPIN_CAP (1u << 20)
DI unsigned xb_ld(unsigned* p)              { return __hip_atomic_load(p, __ATOMIC_RELAXED, __HIP_MEMORY_SCOPE_AGENT); }
DI unsigned xb_add(unsigned* p, unsigned v) { return __hip_atomic_fetch_add(p, v, __ATOMIC_RELAXED, __HIP_MEMORY_SCOPE_AGENT); }
DI unsigned xb_xcc_id() { return (unsigned)__builtin_amdgcn_s_getreg((3 << 11) | 20) & 0xFu; }
#define XB_SPIN(cond, bar) do { unsigned _sp = 0; while (cond) { __builtin_amdgcn_s_sleep(1); \
    if ((++_sp & 255u) == 0u) { if (xb_ld(&(bar)[XB_TMO])) break; if (_sp > XB_SPIN_CAP) { atomicAdd(&(bar)[XB_TMO], 1u); break; } } } } while (0)
struct XcdBarrier { unsigned* bar; unsigned x; volatile LAS unsigned* st; };
DI XcdBarrier xcd_barrier_post(unsigned* bar, volatile LAS unsigned* st) {
    XcdBarrier b; b.bar = bar; b.x = xb_xcc_id(); b.st = st;
    if (threadIdx.x == 0) (void)xb_add(&bar[XB_XCNT(b.x)], 1u);
    return b;
}
DI void xcd_barrier_complete(unsigned* bar, unsigned x, unsigned& nloc, unsigned& nx) {
    const unsigned G = gridDim.x * gridDim.y * gridDim.z;
    unsigned sum, cnt, mine, sp = 0u;
    for (;;) {
        sum = 0u; cnt = 0u; mine = 0u;
#pragma unroll
        for (unsigned j = 0; j < 16; ++j) { const unsigned c = xb_ld(&bar[XB_XCNT(j)]); sum += c; cnt += (c > 0u) ? 1u : 0u; mine = (j == x) ? c : mine; }
        if (sum == G) break;
        __builtin_amdgcn_s_sleep(1);
        if ((++sp & 255u) == 0u) { if (xb_ld(&bar[XB_TMO])) break; if (sp > XB_SPIN_CAP) { atomicAdd(&bar[XB_TMO], 1u); break; } }
    }
    nloc = mine > 0u ? mine : 1u; nx = cnt > 0u ? cnt : 1u;
}
DI void xcd_barrier(const XcdBarrier& b) {
    asm volatile("s_waitcnt vmcnt(0)" ::: "memory");
    __syncthreads();
    if (threadIdx.x == 0) {
        unsigned* bar = b.bar;
        __builtin_amdgcn_s_waitcnt(0);
        unsigned nloc = b.st[0], nx = b.st[1];
        if (nloc == 0u) { xcd_barrier_complete(bar, b.x, nloc, nx); b.st[0] = nloc; b.st[1] = nx; }
        const unsigned old = xb_add(&bar[XB_XSUB(b.x)], 1u);
        const unsigned gen = old / nloc;
        if (old + 1u == (gen + 1u) * nloc) {
            __builtin_amdgcn_fence(__ATOMIC_RELEASE, "agent");
            asm volatile("s_waitcnt vmcnt(0)" ::: "memory");
            const unsigned og = xb_add(&bar[XB_TOP], 1u);
            const unsigned tg = og / nx;
            if (og + 1u == (tg + 1u) * nx) xb_add(&bar[XB_TOPGEN], 1u);
            else XB_SPIN(xb_ld(&bar[XB_TOPGEN]) == tg, bar);
            __builtin_amdgcn_fence(__ATOMIC_ACQUIRE, "agent");
            xb_add(&bar[XB_XGEN(b.x)], 1u);
            asm volatile("s_waitcnt vmcnt(0)" ::: "memory");
        } else {
            XB_SPIN(xb_ld(&bar[XB_XGEN(b.x)]) == gen, bar);
            __builtin_amdgcn_fence(__ATOMIC_ACQUIRE, "agent");
            asm volatile("s_waitcnt vmcnt(0)" ::: "memory");
        }
    }
    __syncthreads();
}

__global__ void __launch_bounds__(512, 2) fwd_megakernel(Params p) {
    extern __shared__ __attribute__((aligned(16))) unsigned char shm[];
    LAS unsigned char* lds = (LAS unsigned char*)shm;
    cg::grid_group grid = cg::this_grid();
    const int G = gridDim.x, c = blockIdx.x;
    float* mod = (float*)(p.ws + WS_MOD);
    bf16_t* H = (bf16_t*)(p.ws + WS_H); bf16_t* Zb = (bf16_t*)(p.ws + WS_Z); bf16_t* MIX = (bf16_t*)(p.ws + WS_MIX);
    volatile LAS unsigned* bst = (volatile LAS unsigned*)(lds + 131072);
    if (threadIdx.x < 4) bst[threadIdx.x] = 0u;
    __syncthreads();
    const XcdBarrier xb = xcd_barrier_post((unsigned*)(p.ws + WS_BAR), bst);
    for (int ph = p.ph_lo; ph < p.ph_hi; ++ph) {
        if (ph > p.ph_lo) { if (ph == p.ph_lo + 1) grid.sync(); else xcd_barrier(xb); }
        if (ph == 0) { phase0(p, lds); continue; }
        const int l = (ph - 1) >> 3, sub = (ph - 1) & 7;
#ifdef PROBE_SUB
        for (int rep = 0; rep < ((sub == PROBE_SUB) ? 2 : 1); ++rep) { if (rep) xcd_barrier(xb);
#endif
        const float* modl = mod + (size_t)l * NB * MODW;
        const float* xcur = (l == 0) ? p.x : p.out;
        if (sub == 0) { phase_norm(xcur, p.norm1_g + l * DM, modl, 0, DM, H); }
        else if (sub == 1) { pg8::StaticOrder S; S.init(MTOK, INW, G, c); pg8::Gemm g{H, (const bf16_t*)(p.ws + WS_WT_IN) + (size_t)l * INW * DM, MTOK, INW, DM};
            pg8::EpiZ E{Zb, INW}; pg8::gemm_phase(lds, g, S, E); }
        else if (sub == 2) { phase_prep(p, l, lds); }
        else if (sub == 3) { const float lambda_init = 0.8f - 0.6f * expf(-0.3f * (float)l); phase_attn(p, l, lambda_init, lds); }
        else if (sub == 4 || sub == 7) {
            pg8::StaticOrder S; S.init(MTOK, DM, G, c);
            pg8::Gemm g; pg8::EpiRes E;
            if (sub == 4) { g = pg8::Gemm{MIX, (const bf16_t*)(p.ws + WS_WT_OUT) + (size_t)l * DM * DM, MTOK, DM, DM}; E = pg8::EpiRes{xcur, p.out, modl + 2 * DM}; }
            else { g = pg8::Gemm{Zb, (const bf16_t*)(p.ws + WS_WT_DN) + (size_t)l * DM * DFF, MTOK, DM, DFF}; E = pg8::EpiRes{p.out, p.out, modl + 5 * DM}; }
            pg8::gemm_phase(lds, g, S, E); }
        else if (sub == 5) { phase_norm(p.out, p.norm2_g + l * DM, modl, 3 * DM, 4 * DM, H); }
        else { pg8::StaticOrder S; S.init(MTOK, GU, G, c); pg8::Gemm g{H, (const bf16_t*)(p.ws + WS_WT_GU) + (size_t)l * GU * DM, MTOK, GU, DM};
            pg8::EpiSwiGLU E{Zb}; pg8::gemm_phase(lds, g, S, E); }
#ifdef PROBE_SUB
        }
#endif
    }
}

extern "C" void kernel_launch(void* const* d_in, const int* in_sizes, int n_in, void* d_out, int out_size, void* d_ws, size_t ws_size, hipStream_t stream) {
    static int grid = 0;
    if (grid == 0) {
        if (n_in != 23 || ws_size < WS_END) { fprintf(stderr, "kernel_launch: unexpected n_in %d or ws_size %zu < %zu\n", n_in, ws_size, (size_t)WS_END); grid = -1; return; }
        int dev = 0, cus = 0, per_cu = 0;
        if (hipGetDevice(&dev) != hipSuccess || hipDeviceGetAttribute(&cus, hipDeviceAttributeMultiprocessorCount, dev) != hipSuccess) { grid = -1; return; }
        if (hipFuncSetAttribute((const void*)fwd_megakernel, hipFuncAttributeMaxDynamicSharedMemorySize, LDS_BYTES) != hipSuccess) { fprintf(stderr, "kernel_launch: hipFuncSetAttribute failed\n"); grid = -1; return; }
        if (hipOccupancyMaxActiveBlocksPerMultiprocessor(&per_cu, (const void*)fwd_megakernel, 512, LDS_BYTES) != hipSuccess || per_cu < 1) { fprintf(stderr, "kernel_launch: occupancy query says %d\n", per_cu); per_cu = 1; }
        (void)hipGetLastError();
        grid = cus;
    }
    if (grid < 0) return;
    if (hipMemsetAsync((char*)d_ws + WS_BAR, 0, 16384, stream) != hipSuccess) { fprintf(stderr, "kernel_launch: memset of the barrier word failed\n"); return; }
    Params p{};
    p.x = (const float*)d_in[0]; p.c = (const float*)d_in[1]; p.pos = (const int*)d_in[2];
    p.norm1_g = (const float*)d_in[3]; p.norm2_g = (const float*)d_in[4]; p.w_ada = (const float*)d_in[5]; p.b_ada = (const float*)d_in[6];
    p.w_in = (const float*)d_in[7]; p.conv_a_w = (const float*)d_in[8]; p.conv_a_b = (const float*)d_in[9]; p.conv_a_norm_g = (const float*)d_in[10];
    p.conv_b_w = (const float*)d_in[11]; p.sc_norm_g = (const float*)d_in[12]; p.q_norm_g = (const float*)d_in[13]; p.k_norm_g = (const float*)d_in[14];
    p.lam_q1 = (const float*)d_in[15]; p.lam_k1 = (const float*)d_in[16]; p.lam_q2 = (const float*)d_in[17]; p.lam_k2 = (const float*)d_in[18];
    p.attn_norm_g = (const float*)d_in[19]; p.w_out = (const float*)d_in[20]; p.w_gate_up = (const float*)d_in[21]; p.w_down = (const float*)d_in[22];
    p.out = (float*)d_out; p.ws = (unsigned char*)d_ws;
#if MK_MULTI
    for (int ph = 0; ph < NPHASE; ++ph) {
        p.ph_lo = ph; p.ph_hi = ph + 1;
        hipLaunchKernelGGL(fwd_megakernel, dim3(grid), dim3(512), LDS_BYTES, stream, p);
    }
#else
    p.ph_lo = 0; p.ph_hi = NPHASE;
    void* args[] = {&p};
    hipError_t e = hipLaunchCooperativeKernel((const void*)fwd_megakernel, dim3(grid), dim3(512), args, LDS_BYTES, stream);
    if (e != hipSuccess) fprintf(stderr, "kernel_launch: cooperative launch failed: %s (grid %d)\n", hipGetErrorString(e), grid);
#endif
}
```

```cpp
#include <hip/hip_runtime.h>
#include <hip/hip_cooperative_groups.h>
#include <cstdio>
namespace cg = cooperative_groups;

#ifndef MK_MULTI
#define MK_MULTI 0
#endif

#define LAS __attribute__((address_space(3)))
#define DI __device__ __forceinline__
typedef unsigned short bf16_t;
typedef short bf16x8 __attribute__((ext_vector_type(8)));
typedef float f32x4 __attribute__((ext_vector_type(4)));
typedef float f32x2 __attribute__((ext_vector_type(2)));
typedef float f32x16 __attribute__((ext_vector_type(16)));
typedef unsigned u32x4 __attribute__((ext_vector_type(4)));
typedef unsigned u32x2 __attribute__((ext_vector_type(2)));
typedef __bf16 bf16x2n __attribute__((ext_vector_type(2)));
typedef _Float16 h16x8 __attribute__((ext_vector_type(8)));
typedef _Float16 h16x4 __attribute__((ext_vector_type(4)));
typedef float f32x8 __attribute__((ext_vector_type(8)));

constexpr int NB = 32, SEQ = 2048, DM = 1024, MTOK = NB * SEQ, NL = 4, INW = 2816, DFF = 2816, GU = 2 * DFF;
constexpr int MODW = 6 * DM;
constexpr float EPS = 1e-6f;
constexpr float LOG2E = 1.4426950408889634f;
constexpr int LDS_BYTES = 131072 + 16;
constexpr int NPHASE = 2 + 5 * NL;

constexpr size_t WS_WT_IN = 0;
constexpr size_t WS_WT_OUT = WS_WT_IN + (size_t)NL * INW * DM * 2;
constexpr size_t WS_WT_GU = WS_WT_OUT + (size_t)NL * DM * DM * 2;
constexpr size_t WS_WT_DN = WS_WT_GU + (size_t)NL * GU * DM * 2;
constexpr size_t WS_MOD = WS_WT_DN + (size_t)NL * DM * DFF * 2;
constexpr size_t WS_ROPE = WS_MOD + (size_t)NL * NB * MODW * 4;
constexpr size_t WS_H = WS_ROPE + (size_t)2 * SEQ * 32 * 4;
constexpr size_t WS_Z = WS_H + (size_t)MTOK * DM * 2;
constexpr size_t WS_QH = WS_Z + (size_t)MTOK * INW * 2;
constexpr size_t WS_KH = WS_QH + (size_t)MTOK * 512 * 2;
constexpr size_t WS_MIX = WS_KH + (size_t)MTOK * 512 * 2;
constexpr size_t WS_ROWSS = WS_MIX + (size_t)MTOK * DM * 2;
constexpr size_t WS_SHW_IN = WS_ROWSS + (size_t)NL * 2 * MTOK * 16 * 4;
constexpr size_t WS_SHW_GU = WS_SHW_IN + (size_t)NL * NB * INW * 4;
constexpr size_t WS_GM = WS_SHW_GU + (size_t)NL * NB * GU * 4;
constexpr size_t WS_X16 = WS_GM + (size_t)NL * 2 * NB * DM * 4;
constexpr size_t WS_BAR = WS_X16 + (size_t)MTOK * DM * 2;
constexpr size_t WS_END = WS_BAR + 16384;

struct Params {
    const float* x; const float* c; const int* pos;
    const float *norm1_g, *norm2_g, *w_ada, *b_ada, *w_in, *conv_a_w, *conv_a_b, *conv_a_norm_g, *conv_b_w, *sc_norm_g,
        *q_norm_g, *k_norm_g, *lam_q1, *lam_k1, *lam_q2, *lam_k2, *attn_norm_g, *w_out, *w_gate_up, *w_down;
    float* out; unsigned char* ws;
    int ph_lo, ph_hi;
};

DI unsigned pk2(float lo, float hi) { f32x2 v = {lo, hi}; return __builtin_bit_cast(unsigned, __builtin_convertvector(v, bf16x2n)); }
DI float bf_lo(unsigned u) { return __uint_as_float(u << 16); }
DI float bf_hi(unsigned u) { return __uint_as_float(u & 0xffff0000u); }
DI float wave_sum(float v) {
#pragma unroll
    for (int o = 1; o < 64; o <<= 1) v += __shfl_xor(v, o);
    return v;
}
DI float wave_max(float v) {
#pragma unroll
    for (int o = 1; o < 64; o <<= 1) v = fmaxf(v, __shfl_xor(v, o));
    return v;
}
DI int opq(int v) { asm volatile("" : "+v"(v)); return v; }
DI float sigmoidf_fast(float v) { return __builtin_amdgcn_rcpf(1.0f + __builtin_amdgcn_exp2f(-v * LOG2E)); }

namespace pg8 {
constexpr int BM = 256, BK = 64, HALF = 128, HTB = HALF * BK * 2, NXCD = 8, WGM = 8;
DI int lds_byte(int r, int c) { const int st = (r >> 4) * 2 + (c >> 5), rr = r & 15, cc = c & 31, ob = rr * 64 + cc * 2; return st * 1024 + (ob ^ (((ob >> 9) & 1) << 5)); }
DI void stage_rc(int b, int& R, int& C) { const int st = b / 1024, sb = b % 1024, swz = sb ^ (((sb >> 9) & 1) << 5); R = (st >> 1) * 16 + swz / 64; C = (st & 1) * 32 + (swz % 64) / 2; }
DI int perm32(int rho) { const int n = rho >> 4, i = rho & 15; return 8 * (i >> 2) + 4 * n + (i & 3); }
struct Unit { int pm, pn; };
struct Gemm { const bf16_t* A; const bf16_t* Bt; int M, N, K; };
struct StaticOrder {
    int nM, nN, nwg, G, c;
    DI void init(int M, int N, int G_, int c_) { nM = M / BM; nN = N / BM; nwg = nM * nN; G = G_; c = c_; }
    DI bool next(int i, Unit& u) const {
        const long L = (long)i * G + c; if (L >= nwg) return false;
        int wgid = (int)L; { const int q = nwg / NXCD, r = nwg % NXCD, xcd = wgid % NXCD, off = wgid / NXCD; wgid = (xcd < r ? xcd * (q + 1) : r * (q + 1) + (xcd - r) * q) + off; }
        const int nig = WGM * nN, gid = wgid / nig, fm = gid * WGM, gsz = (nM - fm) < WGM ? (nM - fm) : WGM;
        u.pm = fm + ((wgid % nig) % gsz); u.pn = (wgid % nig) / gsz; return true;
    }
};

DI void row_rstd8(const float* rowss, int row0, int fq, float (&rstd)[2][4]) {
    f32x4 pr[2][4];
#pragma unroll
    for (int ai = 0; ai < 2; ++ai)
#pragma unroll
        for (int m = 0; m < 4; ++m) pr[ai][m] = *(const f32x4*)(rowss + (size_t)(row0 + ai * HALF + m * 16) * 16 + 4 * fq);
#pragma unroll
    for (int ai = 0; ai < 2; ++ai)
#pragma unroll
        for (int m = 0; m < 4; ++m) { float t = (pr[ai][m][0] + pr[ai][m][1]) + (pr[ai][m][2] + pr[ai][m][3]);
            t += __shfl_xor(t, 16); t += __shfl_xor(t, 32);
            rstd[ai][m] = rsqrtf(t * (1.f / DM) + EPS); }
}
struct EpiZ {
    static constexpr bool PERM = true;
    bf16_t* O; int ldc; const float* rowss; const float* shw;
    bf16_t* QH; bf16_t* KH; const float* gq; const float* gk; const float* rc; const float* rs;
    DI void operator()(const f32x4 (&acc)[2][2][4][2], const Unit& u, int wr, int wc, int fr, int fq) const {
        const int row0 = u.pm * BM + wr * 64 + fr, col0 = u.pn * BM + wc * 32 + 8 * fq, b = (u.pm * BM) / SEQ;
        float rstd8[2][4]; row_rstd8(rowss, row0, fq, rstd8);
        const float* svp = shw + (size_t)b * ldc + col0;
        if (u.pn < 5 || u.pn > 8) {
            f32x4 sv[2][2];
#pragma unroll
            for (int bj = 0; bj < 2; ++bj)
#pragma unroll
                for (int n = 0; n < 2; ++n) sv[bj][n] = *(const f32x4*)(svp + bj * HALF + 4 * n);
#pragma unroll
            for (int ai = 0; ai < 2; ++ai)
#pragma unroll
                for (int m = 0; m < 4; ++m) { const int row = row0 + ai * HALF + m * 16; bf16_t* rowp = O + (size_t)row * ldc + col0;
                    const float rstd = rstd8[ai][m];
#pragma unroll
                    for (int bj = 0; bj < 2; ++bj) { const f32x4 v0 = acc[ai][bj][m][0] * rstd + sv[bj][0], v1 = acc[ai][bj][m][1] * rstd + sv[bj][1];
                        u32x4 w; w.x = pk2(v0[0], v0[1]); w.y = pk2(v0[2], v0[3]); w.z = pk2(v1[0], v1[1]); w.w = pk2(v1[2], v1[3]);
                        *(u32x4*)(rowp + bj * HALF) = w; } }
        } else {
            const int gi = (u.pn - 5) * 4 + wc, isk = gi >> 3, hd = (gi >> 1) & 3, hfh = gi & 1;
            const float* gg = isk ? gk : gq; bf16_t* dst = (isk ? KH : QH) + hd * 128 + hfh * 64 + 4 * fq;
            const float qs = isk ? 1.0f : LOG2E * 0.125f;
#pragma unroll
            for (int ai = 0; ai < 2; ++ai)
#pragma unroll
                for (int m = 0; m < 4; ++m) { const int row = row0 + ai * HALF + m * 16, spos = row & (SEQ - 1);
                    const float rstd = rstd8[ai][m];
                    f32x4 lo[2], hi[2]; float ss = 0.f;
#pragma unroll
                    for (int bj = 0; bj < 2; ++bj) { const f32x4 v0 = acc[ai][bj][m][0] * rstd + *(const f32x4*)(svp + bj * HALF), v1 = acc[ai][bj][m][1] * rstd + *(const f32x4*)(svp + bj * HALF + 4);
                        lo[bj] = (f32x4){v0[0], v0[2], v1[0], v1[2]}; hi[bj] = (f32x4){v0[1], v0[3], v1[1], v1[3]};
                        ss += ((v0[0] * v0[0] + v0[1] * v0[1]) + (v0[2] * v0[2] + v0[3] * v0[3])) + ((v1[0] * v1[0] + v1[1] * v1[1]) + (v1[2] * v1[2] + v1[3] * v1[3])); }
                    ss += __shfl_xor(ss, 16); ss += __shfl_xor(ss, 32);
                    const float rg = rsqrtf(ss * (1.f / 64.f) + EPS) * qs;
#pragma unroll
                    for (int bj = 0; bj < 2; ++bj) {
                        const f32x4 glo = *(const f32x4*)(gg + bj * 16 + fq * 4), ghi = *(const f32x4*)(gg + 32 + bj * 16 + fq * 4);
                        const f32x4 c4 = *(const f32x4*)(rc + spos * 32 + bj * 16 + fq * 4), s4 = *(const f32x4*)(rs + spos * 32 + bj * 16 + fq * 4);
                        const f32x4 a = lo[bj] * rg * glo, bb = hi[bj] * rg * ghi;
                        const f32x4 olo = a * c4 - bb * s4, ohi = bb * c4 + a * s4;
                        u32x2 w0, w1; w0.x = pk2(olo[0], olo[1]); w0.y = pk2(olo[2], olo[3]); w1.x = pk2(ohi[0], ohi[1]); w1.y = pk2(ohi[2], ohi[3]);
                        *(u32x2*)(dst + (size_t)row * 512 + bj * 16) = w0; *(u32x2*)(dst + (size_t)row * 512 + 32 + bj * 16) = w1; }
                    asm volatile("" ::: "memory"); }
        }
    }
};
struct EpiRes {
    static constexpr bool PERM = true;
    const _Float16* xin; _Float16* xout; float* xout32; const float* gate; const float* gm; bf16_t* Hout; float* rowss_out;
    DI void operator()(const f32x4 (&acc)[2][2][4][2], const Unit& u, int wr, int wc, int fr, int fq) const {
        const int row0 = u.pm * BM + wr * 64 + fr, col0 = u.pn * BM + wc * 32 + 8 * fq, b = (u.pm * BM) / SEQ;
        const bool nxt = gm != nullptr, o32 = xout32 != nullptr;
        f32x4 gv[2][2], gmv[2][2];
#pragma unroll
        for (int bj = 0; bj < 2; ++bj)
#pragma unroll
            for (int n = 0; n < 2; ++n) { gv[bj][n] = *(const f32x4*)(gate + (size_t)b * MODW + col0 + bj * HALF + 4 * n);
                gmv[bj][n] = nxt ? *(const f32x4*)(gm + (size_t)b * DM + col0 + bj * HALF + 4 * n) : (f32x4){0.f, 0.f, 0.f, 0.f}; }
        h16x8 xv[2][2];
#define ER_LOAD(rnd) do { const size_t off_ = (size_t)(row0 + ((rnd) >> 2) * HALF + ((rnd) & 3) * 16) * DM + col0; \
            _Pragma("unroll") for (int bj = 0; bj < 2; ++bj) xv[(rnd) & 1][bj] = *(const h16x8*)(xin + off_ + bj * HALF); } while (0)
        ER_LOAD(0); ER_LOAD(1);
        float ssum[4] = {0.f, 0.f, 0.f, 0.f};
#pragma unroll
        for (int rnd = 0; rnd < 8; ++rnd) {
            const int ai = rnd >> 2, m = rnd & 3;
            const size_t off = (size_t)(row0 + ai * HALF + m * 16) * DM + col0;
            f32x4 x0[2], x1[2];
#pragma unroll
            for (int bj = 0; bj < 2; ++bj) { const f32x8 xf = __builtin_convertvector(xv[rnd & 1][bj], f32x8);
                x0[bj] = (f32x4){xf[0], xf[1], xf[2], xf[3]} + gv[bj][0] * acc[ai][bj][m][0]; x1[bj] = (f32x4){xf[4], xf[5], xf[6], xf[7]} + gv[bj][1] * acc[ai][bj][m][1]; }
            if (rnd + 2 < 8) ER_LOAD(rnd + 2);
#pragma unroll
            for (int bj = 0; bj < 2; ++bj) {
                if (o32) { *(f32x4*)(xout32 + off + bj * HALF) = x0[bj]; *(f32x4*)(xout32 + off + bj * HALF + 4) = x1[bj]; }
                else { const f32x8 xf = {x0[bj][0], x0[bj][1], x0[bj][2], x0[bj][3], x1[bj][0], x1[bj][1], x1[bj][2], x1[bj][3]};
                    *(h16x8*)(xout + off + bj * HALF) = __builtin_convertvector(xf, h16x8); }
                if (nxt) {
                    ssum[m] += ((x0[bj][0] * x0[bj][0] + x0[bj][1] * x0[bj][1]) + (x0[bj][2] * x0[bj][2] + x0[bj][3] * x0[bj][3])) + ((x1[bj][0] * x1[bj][0] + x1[bj][1] * x1[bj][1]) + (x1[bj][2] * x1[bj][2] + x1[bj][3] * x1[bj][3]));
                    const f32x4 h0 = x0[bj] * gmv[bj][0], h1 = x1[bj] * gmv[bj][1];
                    u32x4 w; w.x = pk2(h0[0], h0[1]); w.y = pk2(h0[2], h0[3]); w.z = pk2(h1[0], h1[1]); w.w = pk2(h1[2], h1[3]);
                    *(u32x4*)(Hout + off + bj * HALF) = w; } }
            asm volatile("" ::: "memory");
            if (nxt && m == 3) {
                const bool hi2 = (fq & 2) != 0, hi1 = (fq & 1) != 0;
                const float t0 = hi2 ? ssum[0] : ssum[2], t1 = hi2 ? ssum[1] : ssum[3], k0 = hi2 ? ssum[2] : ssum[0], k1 = hi2 ? ssum[3] : ssum[1];
                const float a0 = k0 + __shfl_xor(t0, 32), a1 = k1 + __shfl_xor(t1, 32);
                const float t = hi1 ? a0 : a1, k = hi1 ? a1 : a0;
                const float rsum = k + __shfl_xor(t, 16);
                rowss_out[(size_t)(u.pm * BM + ai * HALF + wr * 64 + fq * 16 + fr) * 16 + u.pn * 4 + wc] = rsum;
#pragma unroll
                for (int i = 0; i < 4; ++i) ssum[i] = 0.f;
            }
        }
#undef ER_LOAD
    }
};
struct EpiSwiGLU {
    static constexpr bool PERM = true;
    bf16_t* O; const float* rowss; const float* shw;
    DI void operator()(const f32x4 (&acc)[2][2][4][2], const Unit& u, int wr, int wc, int fr, int fq) const {
        const int row0 = u.pm * BM + wr * 64 + fr, colh = u.pn * 128 + wc * 16 + 4 * fq, b = (u.pm * BM) / SEQ;
        f32x4 sv[2][2];
#pragma unroll
        for (int bj = 0; bj < 2; ++bj)
#pragma unroll
            for (int n = 0; n < 2; ++n) sv[bj][n] = *(const f32x4*)(shw + (size_t)b * GU + 2 * colh + bj * HALF + 4 * n);
        float rstd8[2][4]; row_rstd8(rowss, row0, fq, rstd8);
#pragma unroll
        for (int ai = 0; ai < 2; ++ai)
#pragma unroll
            for (int m = 0; m < 4; ++m) { const int row = row0 + ai * HALF + m * 16; bf16_t* rowp = O + (size_t)row * DFF + colh;
                const float rstd = rstd8[ai][m];
#pragma unroll
                for (int bj = 0; bj < 2; ++bj) { const f32x4 g = acc[ai][bj][m][0] * rstd + sv[bj][0], uu = acc[ai][bj][m][1] * rstd + sv[bj][1];
                    float a[4];
#pragma unroll
                    for (int i = 0; i < 4; ++i) a[i] = g[i] * sigmoidf_fast(g[i]) * uu[i];
                    u32x2 w; w.x = pk2(a[0], a[1]); w.y = pk2(a[2], a[3]);
                    *(u32x2*)(rowp + bj * 64) = w; } }
    }
};

template <class Epi, class Sched>
DI void gemm_phase(LAS unsigned char* lds, const Gemm g, const Sched& S, const Epi& E) {
    const int tid = opq(threadIdx.x), wid = __builtin_amdgcn_readfirstlane(tid >> 6), lane = tid & 63, wr = wid >> 2, wc = wid & 3, fr = lane & 15, fq = lane >> 4;
    const int K = g.K, nt = K / BK;
    unsigned voffA[2], voffB[2];
#pragma unroll
    for (int i = 0; i < 2; ++i) { int R, C; stage_rc(tid * 16 + i * 8192, R, C); const int Rb = Epi::PERM ? ((R & ~31) + perm32(R & 31)) : R;
        voffA[i] = (unsigned)(R * K + C) * 2u; voffB[i] = (unsigned)(Rb * K + C) * 2u; }
    const size_t kstep = (size_t)(BK * 2);
    const size_t hstep = (size_t)HALF * K * 2;
    const size_t tstep = 2 * hstep;
    const unsigned ldsw = (unsigned)wid * 1024u;
    const int aoff = lds_byte(wr * 64 + fr, fq * 8), boff = lds_byte(wc * 32 + fr, fq * 8);
#define PG8_SA(b, h) (((b) * 2 + (h)) * HTB)
#define PG8_SB(b, h) ((4 + (b) * 2 + (h)) * HTB)
#define PG8_STAGE(bufoff, gbase, voff) do { _Pragma("unroll") for (int _i = 0; _i < 2; ++_i) \
        __builtin_amdgcn_global_load_lds((const unsigned*)((const char*)(gbase) + (voff)[_i]), (LAS unsigned*)(lds + (bufoff) + ldsw + _i * 8192), 16, 0, 0); } while (0)
#define PG8_LDA(dst, b, h) do { _Pragma("unroll") for (int m = 0; m < 4; ++m) _Pragma("unroll") for (int k = 0; k < 2; ++k) dst[m][k] = *(const LAS bf16x8*)(lds + PG8_SA(b, h) + aoff + m * 2048 + k * 1024); } while (0)
#define PG8_LDB(dst, b, h) do { _Pragma("unroll") for (int n = 0; n < 2; ++n) _Pragma("unroll") for (int k = 0; k < 2; ++k) dst[n][k] = *(const LAS bf16x8*)(lds + PG8_SB(b, h) + boff + n * 2048 + k * 1024); } while (0)
#define PG8_MMA(ai, bj, At, Bt) do { __builtin_amdgcn_s_setprio(1); _Pragma("unroll") for (int m = 0; m < 4; ++m) _Pragma("unroll") for (int n = 0; n < 2; ++n) _Pragma("unroll") for (int k = 0; k < 2; ++k) \
        acc[ai][bj][m][n] = __builtin_amdgcn_mfma_f32_16x16x32_bf16(Bt[n][k], At[m][k], acc[ai][bj][m][n], 0, 0, 0); __builtin_amdgcn_s_setprio(0); } while (0)
#define PG8_WAIT_V(n) asm volatile("s_waitcnt vmcnt(" #n ")" ::: "memory")
#define PG8_WAIT_L(n) asm volatile("s_waitcnt lgkmcnt(" #n ")" ::: "memory")
#define PG8_BAR __builtin_amdgcn_s_barrier()
#define PG8_SCHED __builtin_amdgcn_sched_barrier(0)
    Unit cur, nxt; int ui = 0;
    if (!S.next(0, cur)) return;
    f32x4 acc[2][2][4][2];
#pragma unroll
    for (int a = 0; a < 2; ++a)
#pragma unroll
        for (int b = 0; b < 2; ++b)
#pragma unroll
            for (int m = 0; m < 4; ++m)
#pragma unroll
                for (int n = 0; n < 2; ++n) acc[a][b][m][n] = (f32x4){0.f, 0.f, 0.f, 0.f};
    bf16x8 At[4][2], B0[2][2], B1[2][2];
    const char* cA = (const char*)g.A + (size_t)cur.pm * tstep; const char* cB = (const char*)g.Bt + (size_t)cur.pn * tstep;
    PG8_STAGE(PG8_SB(0, 0), cB, voffB); PG8_STAGE(PG8_SA(0, 0), cA, voffA); PG8_STAGE(PG8_SB(0, 1), cB + hstep, voffB); PG8_STAGE(PG8_SA(0, 1), cA + hstep, voffA);
    if (wr == 1) PG8_BAR;
    PG8_WAIT_V(4); PG8_BAR;
    PG8_STAGE(PG8_SB(1, 0), cB + kstep, voffB); PG8_STAGE(PG8_SA(1, 0), cA + kstep, voffA); PG8_STAGE(PG8_SB(1, 1), cB + hstep + kstep, voffB);
    PG8_WAIT_V(6); PG8_BAR;
    for (;;) {
        const bool has_next = S.next(ui + 1, nxt);
        const char* nA = has_next ? (const char*)g.A + (size_t)nxt.pm * tstep : cA; const char* nB = has_next ? (const char*)g.Bt + (size_t)nxt.pn * tstep : cB;
        for (int t = 0; t < nt; t += 2) {
            const bool last = (t == nt - 2);
            const char* a1 = cA + (size_t)(t + 1) * kstep;
            const char* a2 = last ? nA : cA + (size_t)(t + 2) * kstep; const char* b2 = last ? nB : cB + (size_t)(t + 2) * kstep;
            const char* a3 = a2 + kstep; const char* b3 = b2 + kstep;
            PG8_LDB(B0, 0, 0); PG8_SCHED; PG8_LDA(At, 0, 0); PG8_STAGE(PG8_SA(1, 1), a1 + hstep, voffA);
            PG8_WAIT_L(8); PG8_BAR; PG8_WAIT_L(0); PG8_MMA(0, 0, At, B0); PG8_BAR; PG8_SCHED;
            PG8_LDB(B1, 0, 1); PG8_STAGE(PG8_SB(0, 0), b2, voffB);
            PG8_BAR; PG8_WAIT_L(0); PG8_MMA(0, 1, At, B1); PG8_BAR;
            PG8_LDA(At, 0, 1); PG8_STAGE(PG8_SA(0, 0), a2, voffA);
            PG8_BAR; PG8_WAIT_L(0); PG8_MMA(1, 0, At, B0); PG8_BAR; PG8_SCHED;
            PG8_STAGE(PG8_SB(0, 1), b2 + hstep, voffB);
            PG8_WAIT_V(6); PG8_BAR; PG8_MMA(1, 1, At, B1); PG8_BAR;
            PG8_LDB(B0, 1, 0); PG8_SCHED; PG8_LDA(At, 1, 0); PG8_STAGE(PG8_SA(0, 1), a2 + hstep, voffA);
            PG8_WAIT_L(8); PG8_BAR; PG8_WAIT_L(0); PG8_MMA(0, 0, At, B0); PG8_BAR; PG8_SCHED;
            PG8_LDB(B1, 1, 1); PG8_STAGE(PG8_SB(1, 0), b3, voffB);
            PG8_BAR; PG8_WAIT_L(0); PG8_MMA(0, 1, At, B1); PG8_BAR;
            PG8_LDA(At, 1, 1); PG8_STAGE(PG8_SA(1, 0), a3, voffA);
            PG8_BAR; PG8_WAIT_L(0); PG8_MMA(1, 0, At, B0); PG8_BAR; PG8_SCHED;
            PG8_STAGE(PG8_SB(1, 1), b3 + hstep, voffB);
            PG8_WAIT_V(6); PG8_BAR; PG8_MMA(1, 1, At, B1); PG8_BAR;
        }
        E(acc, cur, wr, wc, fr, fq);
        if (!has_next) break;
#pragma unroll
        for (int a = 0; a < 2; ++a)
#pragma unroll
            for (int b = 0; b < 2; ++b)
#pragma unroll
                for (int m = 0; m < 4; ++m)
#pragma unroll
                    for (int n = 0; n < 2; ++n) acc[a][b][m][n] = (f32x4){0.f, 0.f, 0.f, 0.f};
        cur = nxt; cA = nA; cB = nB; ++ui;
    }
    PG8_WAIT_V(0);
    if (wr == 0) PG8_BAR;
    PG8_BAR;
#undef PG8_SA
#undef PG8_SB
#undef PG8_STAGE
#undef PG8_LDA
#undef PG8_LDB
#undef PG8_MMA
#undef PG8_WAIT_V
#undef PG8_WAIT_L
#undef PG8_BAR
#undef PG8_SCHED
}
}

template <int MODE>
DI int wrow_map(int n) {
    if (MODE == 0) return n;
    if (MODE == 2) { if (n < 1280 || n >= 2304) return n;
        const int gi = (n - 1280) >> 6, d = (n - 1280) & 63, hi = d >> 5, f = d & 31, bj = f >> 4, fq = (f >> 2) & 3, jj = f & 3;
        return 256 * (5 + (gi >> 2)) + 128 * bj + 32 * (gi & 3) + 8 * fq + 2 * jj + hi; }
    const int isu = n >= DFF ? 1 : 0, j = n - isu * DFF; return 8 * (j >> 2) + 4 * isu + (j & 3); }
template <int MODE>
DI void p0_transpose_item(const float* W, int K, int N, bf16_t* WT, LAS float* scr, int item, int lane) {
    const int nblk = N / 32, kb = item / nblk, nb = item % nblk, k0 = 64 * kb, n0 = 32 * nb;
    float wv[32];
#pragma unroll
    for (int i = 0; i < 32; ++i) wv[i] = W[(size_t)(k0 + 2 * i + (lane >> 5)) * N + n0 + (lane & 31)];
#pragma unroll
    for (int i = 0; i < 32; ++i) scr[(2 * i + (lane >> 5)) * 33 + (lane & 31)] = wv[i];
    asm volatile("s_waitcnt lgkmcnt(0)" ::: "memory");
    const int c = lane & 7;
#pragma unroll
    for (int j = 0; j < 4; ++j) { const int n = (lane >> 3) + 8 * j; const LAS float* s = scr + (8 * c) * 33 + n;
        u32x4 o; o.x = pk2(s[0 * 33], s[1 * 33]); o.y = pk2(s[2 * 33], s[3 * 33]); o.z = pk2(s[4 * 33], s[5 * 33]); o.w = pk2(s[6 * 33], s[7 * 33]);
        *(u32x4*)(WT + (size_t)wrow_map<MODE>(n0 + n) * K + k0 + 8 * c) = o; }
    asm volatile("s_waitcnt lgkmcnt(0)" ::: "memory");
}

DI void phase0(const Params& p, LAS unsigned char* lds) {
    const int tid = opq(threadIdx.x), lane = tid & 63, wave = tid >> 6, G = gridDim.x;
    {
        LAS float* cact = (LAS float*)lds;
        float* mod = (float*)(p.ws + WS_MOD);
        constexpr int NITEM = NL * (MODW / 64);
        for (int it = blockIdx.x; it < NITEM; it += G) {
            const int l = it / (MODW / 64), n0 = (it % (MODW / 64)) * 64;
            for (int idx = tid; idx < NB * DM; idx += 512) { const int k = idx >> 5, b = idx & 31; const float v = p.c[b * DM + k]; cact[idx] = v * sigmoidf_fast(v); }
            __syncthreads();
            float acc[32];
#pragma unroll
            for (int b = 0; b < 32; ++b) acc[b] = 0.f;
            const float* wp = p.w_ada + ((size_t)l * DM + 128 * wave) * MODW + n0 + lane;
            const LAS f32x4* cp = (const LAS f32x4*)(cact + (128 * wave) * 32);
#pragma unroll 1
            for (int kk0 = 0; kk0 < 128; kk0 += 32) {
                float wv[32];
#pragma unroll
                for (int i = 0; i < 32; ++i) wv[i] = wp[(size_t)(kk0 + i) * MODW];
#pragma unroll
                for (int i = 0; i < 32; ++i) {
#pragma unroll
                    for (int q = 0; q < 8; ++q) { const f32x4 cv = cp[(kk0 + i) * 8 + q]; acc[4 * q] += cv[0] * wv[i]; acc[4 * q + 1] += cv[1] * wv[i]; acc[4 * q + 2] += cv[2] * wv[i]; acc[4 * q + 3] += cv[3] * wv[i]; }
                }
            }
            __syncthreads();
            LAS float* red = (LAS float*)lds;
#pragma unroll
            for (int b = 0; b < 32; ++b) red[(wave * 32 + b) * 64 + lane] = acc[b];
            __syncthreads();
#pragma unroll
            for (int j = 0; j < 4; ++j) { const int o = tid + 512 * j, b = o >> 6, n = o & 63; float s = p.b_ada[l * MODW + n0 + n];
#pragma unroll
                for (int w = 0; w < 8; ++w) s += red[(w * 32 + b) * 64 + n];
                mod[((size_t)l * NB + b) * MODW + n0 + n] = s; }
            __syncthreads();
        }
    }
    {
        LAS float* scr = (LAS float*)(lds + wave * 16384);
        const int gw = blockIdx.x * 8 + wave, NGW = G * 8;
        constexpr int I_IN = (DM / 64) * (INW / 32), I_OUT = (DM / 64) * (DM / 32), I_GU = (DM / 64) * (GU / 32), I_DN = (DFF / 64) * (DM / 32);
        constexpr int PER_L = I_IN + I_OUT + I_GU + I_DN;
        for (int it = gw; it < NL * PER_L; it += NGW) {
            const int l = it / PER_L; int r = it % PER_L;
            if (r < I_IN) { p0_transpose_item<2>(p.w_in + (size_t)l * DM * INW, DM, INW, (bf16_t*)(p.ws + WS_WT_IN) + (size_t)l * INW * DM, scr, r, lane); continue; } r -= I_IN;
            if (r < I_OUT) { p0_transpose_item<0>(p.w_out + (size_t)l * DM * DM, DM, DM, (bf16_t*)(p.ws + WS_WT_OUT) + (size_t)l * DM * DM, scr, r, lane); continue; } r -= I_OUT;
            if (r < I_GU) { p0_transpose_item<1>(p.w_gate_up + (size_t)l * DM * GU, DM, GU, (bf16_t*)(p.ws + WS_WT_GU) + (size_t)l * GU * DM, scr, r, lane); continue; } r -= I_GU;
            p0_transpose_item<0>(p.w_down + (size_t)l * DFF * DM, DFF, DM, (bf16_t*)(p.ws + WS_WT_DN) + (size_t)l * DM * DFF, scr, r, lane);
        }
    }
    {
        float* rc = (float*)(p.ws + WS_ROPE); float* rs = rc + SEQ * 32;
        for (int idx = blockIdx.x * 512 + tid; idx < SEQ * 32; idx += G * 512) {
            const int s = idx >> 5, i = idx & 31;
            double inv = 1.0, bpow = 0.7498942093324559;
#pragma unroll
            for (int bit = 0; bit < 5; ++bit) { if ((i >> bit) & 1) inv *= bpow; bpow *= bpow; }
            const double rev = (double)p.pos[s] * inv * 0.15915494309189535;
            const float fr = (float)(rev - floor(rev));
            rc[idx] = __builtin_amdgcn_cosf(fr); rs[idx] = __builtin_amdgcn_sinf(fr);
        }
    }
}

DI void phase_pre(const Params& p) {
    const int tid = opq(threadIdx.x), lane = tid & 63, wave = tid >> 6, G = gridDim.x, NGW = G * 8, gw = blockIdx.x * 8 + wave;
    const float* mod = (const float*)(p.ws + WS_MOD);
    {
        const int r = lane & 31, h = lane >> 5;
        constexpr int NBLK_IN = INW / 32, NBLK_GU = GU / 32, PER_L = NBLK_IN + NBLK_GU;
        for (int it = gw; it < NL * PER_L; it += NGW) {
            const int l = it / PER_L, q = it % PER_L; const bool isgu = q >= NBLK_IN; const int nb = isgu ? q - NBLK_IN : q;
            const bf16_t* W = isgu ? (const bf16_t*)(p.ws + WS_WT_GU) + ((size_t)l * GU + nb * 32 + r) * DM : (const bf16_t*)(p.ws + WS_WT_IN) + ((size_t)l * INW + nb * 32 + r) * DM;
            const float* sh = mod + ((size_t)l * NB + r) * MODW + (isgu ? 3 * DM : 0);
            f32x16 acc;
#pragma unroll
            for (int i = 0; i < 16; ++i) acc[i] = 0.f;
#pragma unroll 8
            for (int ks = 0; ks < DM / 16; ++ks) {
                const int k0 = ks * 16 + h * 8;
                const bf16x8 bfrag = *(const bf16x8*)(W + k0);
                const f32x4 s0 = *(const f32x4*)(sh + k0), s1 = *(const f32x4*)(sh + k0 + 4);
                u32x4 a; a.x = pk2(s0[0], s0[1]); a.y = pk2(s0[2], s0[3]); a.z = pk2(s1[0], s1[1]); a.w = pk2(s1[2], s1[3]);
                acc = __builtin_amdgcn_mfma_f32_32x32x16_bf16(__builtin_bit_cast(bf16x8, a), bfrag, acc, 0, 0, 0);
            }
            float* o = isgu ? (float*)(p.ws + WS_SHW_GU) + (size_t)l * NB * GU : (float*)(p.ws + WS_SHW_IN) + (size_t)l * NB * INW;
            const int ld = isgu ? GU : INW;
#pragma unroll
            for (int i = 0; i < 16; ++i) o[(size_t)((i & 3) + 8 * (i >> 2) + 4 * h) * ld + nb * 32 + r] = acc[i];
        }
    }
    {
        float* gm = (float*)(p.ws + WS_GM);
        for (int idx = blockIdx.x * 512 + tid; idx < NL * 2 * NB * DM; idx += G * 512) {
            const int k = idx & 1023, b = (idx >> 10) & 31, sx = (idx >> 15) & 1, l = idx >> 16;
            const float g = (sx ? p.norm2_g : p.norm1_g)[l * DM + k], sc = mod[((size_t)l * NB + b) * MODW + (sx ? 4 : 1) * DM + k];
            gm[idx] = g * (1.0f + sc);
        }
    }
    {
        bf16_t* H = (bf16_t*)(p.ws + WS_H); float* rowss = (float*)(p.ws + WS_ROWSS);
        for (int rb = gw; rb < MTOK / 32; rb += NGW) {
            const int b = (rb * 32) / SEQ;
            f32x4 gs[4];
#pragma unroll
            for (int j = 0; j < 4; ++j) { const int col = 4 * lane + 256 * j;
                const f32x4 gg = *(const f32x4*)(p.norm1_g + col), sc = *(const f32x4*)(mod + (size_t)b * MODW + DM + col);
                gs[j] = gg * (sc + 1.0f); }
            for (int r = 0; r < 32; r += 4) {
                const size_t row = (size_t)rb * 32 + r;
                const f32x4* xr = (const f32x4*)(p.x + row * DM) + lane;
                f32x4 v[4][4];
#pragma unroll
                for (int q = 0; q < 4; ++q)
#pragma unroll
                    for (int j = 0; j < 4; ++j) v[q][j] = xr[256 * q + 64 * j];
#pragma unroll
                for (int q = 0; q < 4; ++q) { float sq = 0.f;
#pragma unroll
                    for (int j = 0; j < 4; ++j) sq += (v[q][j][0] * v[q][j][0] + v[q][j][1] * v[q][j][1]) + (v[q][j][2] * v[q][j][2] + v[q][j][3] * v[q][j][3]);
                    sq = wave_sum(sq);
                    if (lane < 16) rowss[(row + q) * 16 + lane] = (lane == 0) ? sq : 0.f;
                    u32x2* o8 = (u32x2*)(H + (row + q) * DM) + lane; h16x4* x8 = (h16x4*)((_Float16*)(p.ws + WS_X16) + (row + q) * DM) + lane;
#pragma unroll
                    for (int j = 0; j < 4; ++j) { const f32x4 y = v[q][j] * gs[j]; u32x2 w; w.x = pk2(y[0], y[1]); w.y = pk2(y[2], y[3]); o8[64 * j] = w; x8[64 * j] = __builtin_convertvector(v[q][j], h16x4); } }
            }
        }
    }
}

DI void phase_prep(const Params& p, int l, LAS unsigned char* lds) {
    const int tid = opq(threadIdx.x), lane = tid & 63, wave = tid >> 6, G = gridDim.x;
    const bf16_t* Z = (const bf16_t*)(p.ws + WS_Z);
    bf16_t* MIX = (bf16_t*)(p.ws + WS_MIX);
    LAS float* U = (LAS float*)lds;
    LAS float* CV = (LAS float*)(lds + 65536);
    const int cch = tid & 255, th = tid >> 8;
    float cw[31];
#pragma unroll
    for (int j = 0; j < 31; ++j) cw[j] = p.conv_a_w[((size_t)l * 31 + j) * 256 + cch];
    const float cbias = p.conv_a_b[l * 256 + cch];
    const f32x4 ga = *(const f32x4*)(p.conv_a_norm_g + l * 256 + 4 * lane);
    const f32x4 gb = *(const f32x4*)(p.sc_norm_g + l * 256 + 4 * lane);
    f32x4 wb[3];
#pragma unroll
    for (int j = 0; j < 3; ++j) wb[j] = *(const f32x4*)(p.conv_b_w + ((size_t)l * 3 + j) * 256 + 4 * lane);

    for (int it = blockIdx.x; it < MTOK / 32; it += G) {
        const int b = it >> 6, t0 = (it & 63) * 32;
        const size_t tokbase = (size_t)b * SEQ;
        u32x4 av[4], ag[4];
#pragma unroll
        for (int k4 = 0; k4 < 4; ++k4) { const int ci = tid + 512 * k4, row = ci >> 5, ch8 = ci & 31, tok = t0 - 15 + row;
            av[k4] = (u32x4){0u, 0u, 0u, 0u}; ag[k4] = av[k4];
            if (ci < 62 * 32 && tok >= 0 && tok < SEQ) { const bf16_t* zp = Z + (tokbase + tok) * INW + ch8 * 8; av[k4] = *(const u32x4*)zp; ag[k4] = *(const u32x4*)(zp + 256); } }
        const int tw = t0 + wave * 4;
        u32x2 bcg[6], bhv[6], bbg[4];
#pragma unroll
        for (int r = 0; r < 6; ++r) { const int tok = tw - 1 + r; bcg[r] = (u32x2){0u, 0u}; bhv[r] = bcg[r];
            if (tok >= 0 && tok < SEQ) { const bf16_t* zp = Z + (tokbase + tok) * INW + 512 + 4 * lane; bcg[r] = *(const u32x2*)(zp + 256); bhv[r] = *(const u32x2*)(zp + 512);
                if (r >= 1 && r <= 4) bbg[r - 1] = *(const u32x2*)zp; } }
#pragma unroll
        for (int k4 = 0; k4 < 4; ++k4) { const int ci = tid + 512 * k4, row = ci >> 5, ch8 = ci & 31;
            if (ci < 62 * 32) { const u32x4 v = av[k4], gt = ag[k4]; f32x4 o0, o1;
                o0[0] = bf_lo(v.x) * sigmoidf_fast(bf_lo(gt.x)); o0[1] = bf_hi(v.x) * sigmoidf_fast(bf_hi(gt.x));
                o0[2] = bf_lo(v.y) * sigmoidf_fast(bf_lo(gt.y)); o0[3] = bf_hi(v.y) * sigmoidf_fast(bf_hi(gt.y));
                o1[0] = bf_lo(v.z) * sigmoidf_fast(bf_lo(gt.z)); o1[1] = bf_hi(v.z) * sigmoidf_fast(bf_hi(gt.z));
                o1[2] = bf_lo(v.w) * sigmoidf_fast(bf_lo(gt.w)); o1[3] = bf_hi(v.w) * sigmoidf_fast(bf_hi(gt.w));
                *(LAS f32x4*)(U + row * 256 + ch8 * 8) = o0; *(LAS f32x4*)(U + row * 256 + ch8 * 8 + 4) = o1; } }
        __syncthreads();
#pragma unroll 1
        for (int chunk = 0; chunk < 2; ++chunk) {
            const int tb = th * 16 + chunk * 8;
            float uu[38];
#pragma unroll
            for (int i = 0; i < 38; ++i) uu[i] = U[(tb + i) * 256 + cch];
#pragma unroll
            for (int t = 0; t < 8; ++t) { float a = cbias;
#pragma unroll
                for (int j = 0; j < 31; ++j) a += cw[j] * uu[t + j];
                CV[(tb + t) * 256 + cch] = a; }
        }
        __syncthreads();
#pragma unroll
        for (int q = 0; q < 4; ++q) { const int t = wave * 4 + q;
            const f32x4 v = *(const LAS f32x4*)(CV + t * 256 + 4 * lane);
            const float ss = wave_sum((v[0] * v[0] + v[1] * v[1]) + (v[2] * v[2] + v[3] * v[3]));
            const f32x4 y = v * rsqrtf(ss * (1.f / 256.f) + EPS) * ga;
            f32x4 o;
#pragma unroll
            for (int i = 0; i < 4; ++i) o[i] = y[i] * sigmoidf_fast(y[i]);
            u32x2 w; w.x = pk2(o[0], o[1]); w.y = pk2(o[2], o[3]);
            *(u32x2*)(MIX + (tokbase + t0 + t) * DM + 4 * lane) = w; }
        {
            f32x4 mrow[6], bgv[4];
#pragma unroll
            for (int r = 0; r < 6; ++r) { mrow[r][0] = bf_lo(bcg[r].x) * bf_lo(bhv[r].x); mrow[r][1] = bf_hi(bcg[r].x) * bf_hi(bhv[r].x); mrow[r][2] = bf_lo(bcg[r].y) * bf_lo(bhv[r].y); mrow[r][3] = bf_hi(bcg[r].y) * bf_hi(bhv[r].y); }
#pragma unroll
            for (int q = 0; q < 4; ++q) { bgv[q][0] = bf_lo(bbg[q].x); bgv[q][1] = bf_hi(bbg[q].x); bgv[q][2] = bf_lo(bbg[q].y); bgv[q][3] = bf_hi(bbg[q].y); }
#pragma unroll
            for (int q = 0; q < 4; ++q) {
                const f32x4 y = bgv[q] * (wb[0] * mrow[q] + wb[1] * mrow[q + 1] + wb[2] * mrow[q + 2]);
                const float ss = wave_sum((y[0] * y[0] + y[1] * y[1]) + (y[2] * y[2] + y[3] * y[3]));
                const f32x4 o = y * rsqrtf(ss * (1.f / 256.f) + EPS) * gb;
                u32x2 w; w.x = pk2(o[0], o[1]); w.y = pk2(o[2], o[3]);
                *(u32x2*)(MIX + (tokbase + tw + q) * DM + 256 + 4 * lane) = w; }
        }
        __syncthreads();
    }
}

constexpr int KROW = 272, VROW = 320, KBYTES = 64 * KROW, VBYTES = 64 * VROW, ABUF = KBYTES + VBYTES;
typedef short s16x4 __attribute__((ext_vector_type(4)));
#define MFMA32(a, b, c) __builtin_amdgcn_mfma_f32_32x32x16_bf16((a), (b), (c), 0, 0, 0)

DI void phase_attn(const Params& p, int l, float lambda_init, LAS unsigned char* lds) {
    const int tid = opq(threadIdx.x), lane = tid & 63, wave = tid >> 6, G = gridDim.x, r = lane & 31, h = lane >> 5;
    const int rg = wave >> 1, hf = wave & 1;
    const bf16_t* Z = (const bf16_t*)(p.ws + WS_Z);
    const bf16_t* QH = (const bf16_t*)(p.ws + WS_QH); const bf16_t* KH = (const bf16_t*)(p.ws + WS_KH);
    bf16_t* MIX = (bf16_t*)(p.ws + WS_MIX);
    const float sa = wave_sum(p.lam_q1[l * 64 + lane] * p.lam_k1[l * 64 + lane]), sb = wave_sum(p.lam_q2[l * 64 + lane] * p.lam_k2[l * 64 + lane]);
    const float lam = expf(sa) - expf(sb) + lambda_init;
    const float oscale = 1.0f - lambda_init;
    const int kkey = tid >> 3, kch = tid & 7;
    const int vtr = (4 * (lane >> 5) + ((lane >> 2) & 3)) * VROW + (16 * ((lane >> 4) & 1) + 4 * (lane & 3)) * 2;
    const int vcu = (G % 8 == 0) ? ((blockIdx.x & 7) * (G >> 3) + (blockIdx.x >> 3)) : blockIdx.x;
    LAS float* X = (LAS float*)lds + rg * (128 * 32);

    bf16x8 qf[4]; u32x4 krA[2], vrA[2], krB[2], vrB[2];
#define ATT_ITEM_PTRS(it_) const int qblk = (it_) & 15, head = ((it_) >> 4) & 3, b = (it_) >> 6; const size_t tokb = (size_t)b * SEQ; \
        const size_t qtok = tokb + qblk * 128 + rg * 32 + r; \
        const bf16_t* kg = KH + (tokb + kkey) * 512 + head * 128 + kch * 16; const bf16_t* vg = Z + (tokb + kkey) * INW + 2304 + head * 128 + kch * 16;
#define ATT_LOAD(KR, VR, t_) do { const bf16_t* kg2_ = kg + (size_t)(t_) * 64 * 512; const bf16_t* vg2_ = vg + (size_t)(t_) * 64 * INW; \
            KR[0] = *(const u32x4*)kg2_; KR[1] = *(const u32x4*)(kg2_ + 8); VR[0] = *(const u32x4*)vg2_; VR[1] = *(const u32x4*)(vg2_ + 8); } while (0)
#define ATT_ITEM_PREFETCH() do { ATT_LOAD(krA, vrA, 0); ATT_LOAD(krB, vrB, 1); \
            _Pragma("unroll") for (int kk = 0; kk < 4; ++kk) qf[kk] = *(const bf16x8*)(QH + qtok * 512 + head * 128 + hf * 64 + kk * 16 + h * 8); } while (0)
    if (vcu < NB * 4 * 16) { ATT_ITEM_PTRS(vcu); ATT_ITEM_PREFETCH(); }
    for (int it = vcu; it < NB * 4 * 16; it += G) {
        ATT_ITEM_PTRS(it);
        f32x16 o[4];
#pragma unroll
        for (int eb = 0; eb < 4; ++eb)
#pragma unroll
            for (int i = 0; i < 16; ++i) o[eb][i] = 0.f;
        float lsum = 0.f;
#define ATT_WRITE(KR, VR, buf) do { LAS unsigned char* kb_ = lds + (buf) * ABUF; LAS unsigned char* vb_ = kb_ + KBYTES; \
            *(LAS u32x4*)(kb_ + kkey * KROW + kch * 32) = KR[0]; *(LAS u32x4*)(kb_ + kkey * KROW + kch * 32 + 16) = KR[1]; \
            *(LAS u32x4*)(vb_ + kkey * VROW + kch * 32) = VR[0]; *(LAS u32x4*)(vb_ + kkey * VROW + kch * 32 + 16) = VR[1]; } while (0)
#define ATT_COMPUTE(buf) do { const LAS unsigned char* kb = lds + (buf) * ABUF; LAS unsigned char* vb = lds + (buf) * ABUF + KBYTES; \
            _Pragma("unroll") for (int kbk = 0; kbk < 2; ++kbk) { \
                f32x16 s; \
                _Pragma("unroll") for (int i = 0; i < 16; ++i) s[i] = 0.f; \
                _Pragma("unroll") for (int kk = 0; kk < 4; ++kk) { const bf16x8 a = *(const LAS bf16x8*)(kb + (kbk * 32 + r) * KROW + hf * 128 + kk * 32 + h * 16); s = MFMA32(a, qf[kk], s); } \
                float ls = 0.f; \
                _Pragma("unroll") for (int i = 0; i < 16; ++i) { s[i] = __builtin_amdgcn_exp2f(s[i]); ls += s[i]; } \
                lsum += ls; \
                bf16x8 pf[2]; \
                _Pragma("unroll") for (int st = 0; st < 2; ++st) { u32x4 w; w.x = pk2(s[8 * st], s[8 * st + 1]); w.y = pk2(s[8 * st + 2], s[8 * st + 3]); w.z = pk2(s[8 * st + 4], s[8 * st + 5]); w.w = pk2(s[8 * st + 6], s[8 * st + 7]); \
                    pf[st] = __builtin_bit_cast(bf16x8, w); } \
                _Pragma("unroll") for (int st = 0; st < 2; ++st) \
                    _Pragma("unroll") for (int eb = 0; eb < 4; ++eb) { \
                        const s16x4 vlo = __builtin_amdgcn_ds_read_tr16_b64_v4i16((LAS s16x4*)(vb + vtr + (kbk * 32 + st * 16) * VROW + eb * 64)); \
                        const s16x4 vhi = __builtin_amdgcn_ds_read_tr16_b64_v4i16((LAS s16x4*)(vb + vtr + (kbk * 32 + st * 16 + 8) * VROW + eb * 64)); \
                        const bf16x8 vf = __builtin_shufflevector(vlo, vhi, 0, 1, 2, 3, 4, 5, 6, 7); \
                        o[eb] = MFMA32(vf, pf[st], o[eb]); } \
            } } while (0)
        ATT_WRITE(krA, vrA, 0);
        ATT_LOAD(krA, vrA, 2);
        __syncthreads();
#pragma unroll 1
        for (int t = 0; t < SEQ / 64; t += 2) {
            ATT_COMPUTE(0);
            ATT_WRITE(krB, vrB, 1);
            if (t + 3 < SEQ / 64) ATT_LOAD(krB, vrB, t + 3);
            __syncthreads();
            ATT_COMPUTE(1);
            if (t + 2 < SEQ / 64) { ATT_WRITE(krA, vrA, 0);
                if (t + 4 < SEQ / 64) ATT_LOAD(krA, vrA, t + 4); }
            __syncthreads();
        }
#undef ATT_COMPUTE
        bf16_t* orow = MIX + qtok * DM + 512 + head * 128;
        if (it + G < NB * 4 * 16) { ATT_ITEM_PTRS(it + G); ATT_ITEM_PREFETCH(); }
        const float lt = lsum + __shfl_xor(lsum, 32);
        if (hf == 1) {
            const float sc1 = lam / lt;
#pragma unroll
            for (int eb = 0; eb < 4; ++eb)
#pragma unroll
                for (int i = 0; i < 16; ++i) X[(eb * 32 + (i & 3) + 8 * (i >> 2) + 4 * h) * 32 + r] = o[eb][i] * sc1;
        }
        __syncthreads();
        if (hf == 0) {
            const float i0 = 1.0f / lt;
            float ss = 0.f;
#pragma unroll
            for (int eb = 0; eb < 4; ++eb)
#pragma unroll
                for (int i = 0; i < 16; ++i) { const float v = o[eb][i] * i0 - X[(eb * 32 + (i & 3) + 8 * (i >> 2) + 4 * h) * 32 + r]; o[eb][i] = v; ss += v * v; }
            ss += __shfl_xor(ss, 32);
            const float rn = rsqrtf(ss * (1.f / 128.f) + EPS) * oscale;
#pragma unroll
            for (int eb = 0; eb < 4; ++eb)
#pragma unroll
                for (int g4 = 0; g4 < 4; ++g4) { const int e = eb * 32 + 8 * g4 + 4 * h;
                    const f32x4 gg = *(const f32x4*)(p.attn_norm_g + l * 128 + e);
                    u32x2 w; w.x = pk2(o[eb][4 * g4] * rn * gg[0], o[eb][4 * g4 + 1] * rn * gg[1]); w.y = pk2(o[eb][4 * g4 + 2] * rn * gg[2], o[eb][4 * g4 + 3] * rn * gg[3]);
                    *(u32x2*)(orow + e) = w; }
        }
        __syncthreads();
    }
#undef ATT_WRITE
#undef ATT_LOAD
#undef ATT_ITEM_PTRS
#undef ATT_ITEM_PREFETCH
}

#define XB_TMO      128
#define XB_XCNT(j)  (256  + 64 * (j))
#define XB_XSUB(j)  (1280 + 64 * (j))
#define XB_XGEN(j)  (2304 + 64 * (j))
#define XB_TOP      3328
#define XB_TOPGEN   3392
#define XCD_BAR_WORDS 3456
#define XB_SPIN_CAP (1u << 20)
DI unsigned xb_ld(unsigned* p)              { return __hip_atomic_load(p, __ATOMIC_RELAXED, __HIP_MEMORY_SCOPE_AGENT); }
DI unsigned xb_add(unsigned* p, unsigned v) { return __hip_atomic_fetch_add(p, v, __ATOMIC_RELAXED, __HIP_MEMORY_SCOPE_AGENT); }
DI unsigned xb_xcc_id() { return (unsigned)__builtin_amdgcn_s_getreg((3 << 11) | 20) & 0xFu; }
#define XB_SPIN(cond, bar) do { unsigned _sp = 0; while (cond) { __builtin_amdgcn_s_sleep(1); \
    if ((++_sp & 255u) == 0u) { if (xb_ld(&(bar)[XB_TMO])) break; if (_sp > XB_SPIN_CAP) { atomicAdd(&(bar)[XB_TMO], 1u); break; } } } } while (0)
struct XcdBarrier { unsigned* bar; unsigned x; volatile LAS unsigned* st; };
DI XcdBarrier xcd_barrier_post(unsigned* bar, volatile LAS unsigned* st) {
    XcdBarrier b; b.bar = bar; b.x = xb_xcc_id(); b.st = st;
    if (threadIdx.x == 0) (void)xb_add(&bar[XB_XCNT(b.x)], 1u);
    return b;
}
DI void xcd_barrier_complete(unsigned* bar, unsigned x, unsigned& nloc, unsigned& nx) {
    const unsigned G = gridDim.x * gridDim.y * gridDim.z;
    unsigned sum, cnt, mine, sp = 0u;
    for (;;) {
        sum = 0u; cnt = 0u; mine = 0u;
#pragma unroll
        for (unsigned j = 0; j < 16; ++j) { const unsigned c = xb_ld(&bar[XB_XCNT(j)]); sum += c; cnt += (c > 0u) ? 1u : 0u; mine = (j == x) ? c : mine; }
        if (sum == G) break;
        __builtin_amdgcn_s_sleep(1);
        if ((++sp & 255u) == 0u) { if (xb_ld(&bar[XB_TMO])) break; if (sp > XB_SPIN_CAP) { atomicAdd(&bar[XB_TMO], 1u); break; } }
    }
    nloc = mine > 0u ? mine : 1u; nx = cnt > 0u ? cnt : 1u;
}
DI void xcd_barrier(const XcdBarrier& b) {
    asm volatile("s_waitcnt vmcnt(0)" ::: "memory");
    __syncthreads();
    if (threadIdx.x == 0) {
        unsigned* bar = b.bar;
        __builtin_amdgcn_s_waitcnt(0);
        unsigned nloc = b.st[0], nx = b.st[1];
        if (nloc == 0u) { xcd_barrier_complete(bar, b.x, nloc, nx); b.st[0] = nloc; b.st[1] = nx; }
        const unsigned old = xb_add(&bar[XB_XSUB(b.x)], 1u);
        const unsigned gen = old / nloc;
        if (old + 1u == (gen + 1u) * nloc) {
            __builtin_amdgcn_fence(__ATOMIC_RELEASE, "agent");
            asm volatile("s_waitcnt vmcnt(0)" ::: "memory");
            const unsigned og = xb_add(&bar[XB_TOP], 1u);
            const unsigned tg = og / nx;
            if (og + 1u == (tg + 1u) * nx) xb_add(&bar[XB_TOPGEN], 1u);
            else XB_SPIN(xb_ld(&bar[XB_TOPGEN]) == tg, bar);
            __builtin_amdgcn_fence(__ATOMIC_ACQUIRE, "agent");
            xb_add(&bar[XB_XGEN(b.x)], 1u);
            asm volatile("s_waitcnt vmcnt(0)" ::: "memory");
        } else {
            XB_SPIN(xb_ld(&bar[XB_XGEN(b.x)]) == gen, bar);
            __builtin_amdgcn_fence(__ATOMIC_ACQUIRE, "agent");
            asm volatile("s_waitcnt vmcnt(0)" ::: "memory");
        }
    }
    __syncthreads();
}

__global__ void __launch_bounds__(512, 2) fwd_megakernel(Params p) {
    extern __shared__ __attribute__((aligned(16))) unsigned char shm[];
    LAS unsigned char* lds = (LAS unsigned char*)shm;
    cg::grid_group grid = cg::this_grid();
    const int G = gridDim.x, c = blockIdx.x;
    float* mod = (float*)(p.ws + WS_MOD);
    bf16_t* H = (bf16_t*)(p.ws + WS_H); bf16_t* Zb = (bf16_t*)(p.ws + WS_Z); bf16_t* MIX = (bf16_t*)(p.ws + WS_MIX);
    volatile LAS unsigned* bst = (volatile LAS unsigned*)(lds + 131072);
    if (threadIdx.x < 4) bst[threadIdx.x] = 0u;
    __syncthreads();
    const XcdBarrier xb = xcd_barrier_post((unsigned*)(p.ws + WS_BAR), bst);
    float* rowss = (float*)(p.ws + WS_ROWSS);
    if (p.ph_hi < 0) grid.sync();
    for (int ph = p.ph_lo; ph < p.ph_hi; ++ph) {
        if (ph > p.ph_lo) xcd_barrier(xb);
        if (ph == 0) { phase0(p, lds); continue; }
        if (ph == 1) { phase_pre(p); continue; }
        const int l = (ph - 2) / 5, s5 = (ph - 2) % 5, sub = s5 + (s5 >= 2 ? 1 : 0);
        const float* modl = mod + (size_t)l * NB * MODW;
        float* rs1 = rowss + (size_t)(2 * l) * MTOK * 16; float* rs2 = rs1 + (size_t)MTOK * 16;
        const float* gml = (const float*)(p.ws + WS_GM) + (size_t)l * 2 * NB * DM;
        if (sub == 0) { pg8::StaticOrder S; S.init(MTOK, INW, G, c); pg8::Gemm g{H, (const bf16_t*)(p.ws + WS_WT_IN) + (size_t)l * INW * DM, MTOK, INW, DM};
            pg8::EpiZ E{Zb, INW, rs1, (const float*)(p.ws + WS_SHW_IN) + (size_t)l * NB * INW, (bf16_t*)(p.ws + WS_QH), (bf16_t*)(p.ws + WS_KH), p.q_norm_g + l * 64, p.k_norm_g + l * 64, (const float*)(p.ws + WS_ROPE), (const float*)(p.ws + WS_ROPE) + SEQ * 32}; pg8::gemm_phase(lds, g, S, E); }
        else if (sub == 1) { phase_prep(p, l, lds); const float lambda_init = 0.8f - 0.6f * expf(-0.3f * (float)l); phase_attn(p, l, lambda_init, lds); }
        else if (sub == 3 || sub == 5) {
            pg8::StaticOrder S; S.init(MTOK, DM, G, c);
            pg8::Gemm g; pg8::EpiRes E;
            _Float16* X16 = (_Float16*)(p.ws + WS_X16);
            if (sub == 3) { g = pg8::Gemm{MIX, (const bf16_t*)(p.ws + WS_WT_OUT) + (size_t)l * DM * DM, MTOK, DM, DM}; E = pg8::EpiRes{X16, X16, nullptr, modl + 2 * DM, gml + NB * DM, H, rs2}; }
            else { const bool lastl = (l == NL - 1);
                g = pg8::Gemm{Zb, (const bf16_t*)(p.ws + WS_WT_DN) + (size_t)l * DM * DFF, MTOK, DM, DFF};
                E = pg8::EpiRes{X16, X16, lastl ? p.out : nullptr, modl + 5 * DM, lastl ? nullptr : gml + 2 * NB * DM, H, lastl ? nullptr : rs1 + (size_t)2 * MTOK * 16}; }
            pg8::gemm_phase(lds, g, S, E); }
        else { pg8::StaticOrder S; S.init(MTOK, GU, G, c); pg8::Gemm g{H, (const bf16_t*)(p.ws + WS_WT_GU) + (size_t)l * GU * DM, MTOK, GU, DM};
            pg8::EpiSwiGLU E{Zb, rs2, (const float*)(p.ws + WS_SHW_GU) + (size_t)l * NB * GU}; pg8::gemm_phase(lds, g, S, E); }
    }
}

extern "C" void kernel_launch(void* const* d_in, const int* in_sizes, int n_in, void* d_out, int out_size, void* d_ws, size_t ws_size, hipStream_t stream) {
    static int grid = 0;
    if (grid == 0) {
        if (n_in != 23 || ws_size < WS_END) { fprintf(stderr, "kernel_launch: unexpected n_in %d or ws_size %zu < %zu\n", n_in, ws_size, (size_t)WS_END); grid = -1; return; }
        int dev = 0, cus = 0, per_cu = 0;
        if (hipGetDevice(&dev) != hipSuccess || hipDeviceGetAttribute(&cus, hipDeviceAttributeMultiprocessorCount, dev) != hipSuccess) { grid = -1; return; }
        if (hipFuncSetAttribute((const void*)fwd_megakernel, hipFuncAttributeMaxDynamicSharedMemorySize, LDS_BYTES) != hipSuccess) { fprintf(stderr, "kernel_launch: hipFuncSetAttribute failed\n"); grid = -1; return; }
        if (hipOccupancyMaxActiveBlocksPerMultiprocessor(&per_cu, (const void*)fwd_megakernel, 512, LDS_BYTES) != hipSuccess || per_cu < 1) { fprintf(stderr, "kernel_launch: occupancy query says %d\n", per_cu); per_cu = 1; }
        (void)hipGetLastError();
        grid = cus;
    }
    if (grid < 0) return;
    if (hipMemsetAsync((char*)d_ws + WS_BAR, 0, 16384, stream) != hipSuccess) { fprintf(stderr, "kernel_launch: memset of the barrier word failed\n"); return; }
    Params p{};
    p.x = (const float*)d_in[0]; p.c = (const float*)d_in[1]; p.pos = (const int*)d_in[2];
    p.norm1_g = (const float*)d_in[3]; p.norm2_g = (const float*)d_in[4]; p.w_ada = (const float*)d_in[5]; p.b_ada = (const float*)d_in[6];
    p.w_in = (const float*)d_in[7]; p.conv_a_w = (const float*)d_in[8]; p.conv_a_b = (const float*)d_in[9]; p.conv_a_norm_g = (const float*)d_in[10];
    p.conv_b_w = (const float*)d_in[11]; p.sc_norm_g = (const float*)d_in[12]; p.q_norm_g = (const float*)d_in[13]; p.k_norm_g = (const float*)d_in[14];
    p.lam_q1 = (const float*)d_in[15]; p.lam_k1 = (const float*)d_in[16]; p.lam_q2 = (const float*)d_in[17]; p.lam_k2 = (const float*)d_in[18];
    p.attn_norm_g = (const float*)d_in[19]; p.w_out = (const float*)d_in[20]; p.w_gate_up = (const float*)d_in[21]; p.w_down = (const float*)d_in[22];
    p.out = (float*)d_out; p.ws = (unsigned char*)d_ws;
#if MK_MULTI
    for (int ph = 0; ph < NPHASE; ++ph) {
        p.ph_lo = ph; p.ph_hi = ph + 1;
        hipLaunchKernelGGL(fwd_megakernel, dim3(grid), dim3(512), LDS_BYTES, stream, p);
    }
#else
    p.ph_lo = 0; p.ph_hi = NPHASE;
    void* args[] = {&p};
    hipError_t e = hipLaunchCooperativeKernel((const void*)fwd_megakernel, dim3(grid), dim3(512), args, LDS_BYTES, stream);
    if (e != hipSuccess) fprintf(stderr, "kernel_launch: cooperative launch failed: %s (grid %d)\n", hipGetErrorString(e), grid);
#endif
}
```

```cpp
#include <hip/hip_runtime.h>
#include <hip/hip_cooperative_groups.h>
#include <cstdio>
namespace cg = cooperative_groups;

#ifndef MK_MULTI
#define MK_MULTI 0
#endif

#define LAS __attribute__((address_space(3)))
#define DI __device__ __forceinline__
typedef unsigned short bf16_t;
typedef short bf16x8 __attribute__((ext_vector_type(8)));
typedef float f32x4 __attribute__((ext_vector_type(4)));
typedef float f32x2 __attribute__((ext_vector_type(2)));
typedef float f32x16 __attribute__((ext_vector_type(16)));
typedef unsigned u32x4 __attribute__((ext_vector_type(4)));
typedef unsigned u32x2 __attribute__((ext_vector_type(2)));
typedef __bf16 bf16x2n __attribute__((ext_vector_type(2)));
typedef _Float16 h16x8 __attribute__((ext_vector_type(8)));
typedef _Float16 h16x4 __attribute__((ext_vector_type(4)));
typedef float f32x8 __attribute__((ext_vector_type(8)));

constexpr int NB = 32, SEQ = 2048, DM = 1024, MTOK = NB * SEQ, NL = 4, INW = 2816, DFF = 2816, GU = 2 * DFF;
constexpr int MODW = 6 * DM;
constexpr float EPS = 1e-6f;
constexpr float LOG2E = 1.4426950408889634f;
constexpr int LDS_BYTES = 131072 + 16;
constexpr int NPHASE = 2 + 5 * NL;

constexpr size_t WS_WT_IN = 0;
constexpr size_t WS_WT_OUT = WS_WT_IN + (size_t)NL * INW * DM * 2;
constexpr size_t WS_WT_GU = WS_WT_OUT + (size_t)NL * DM * DM * 2;
constexpr size_t WS_WT_DN = WS_WT_GU + (size_t)NL * GU * DM * 2;
constexpr size_t WS_MOD = WS_WT_DN + (size_t)NL * DM * DFF * 2;
constexpr size_t WS_ROPE = WS_MOD + (size_t)NL * NB * MODW * 4;
constexpr size_t WS_H = WS_ROPE + (size_t)2 * SEQ * 32 * 4;
constexpr size_t WS_Z = WS_H + (size_t)MTOK * DM * 2;
constexpr size_t WS_QH = WS_Z + (size_t)MTOK * INW * 2;
constexpr size_t WS_KH = WS_QH + (size_t)MTOK * 512 * 2;
constexpr size_t WS_MIX = WS_KH + (size_t)MTOK * 512 * 2;
constexpr size_t WS_ROWSS = WS_MIX + (size_t)MTOK * DM * 2;
constexpr size_t WS_SHW_IN = WS_ROWSS + (size_t)NL * 2 * MTOK * 16 * 4;
constexpr size_t WS_SHW_GU = WS_SHW_IN + (size_t)NL * NB * INW * 4;
constexpr size_t WS_GM = WS_SHW_GU + (size_t)NL * NB * GU * 4;
constexpr size_t WS_X16 = WS_GM + (size_t)NL * 2 * NB * DM * 4;
constexpr size_t WS_BAR = WS_X16 + (size_t)MTOK * DM * 2;
constexpr size_t WS_END = WS_BAR + 16384;

struct Params {
    const float* x; const float* c; const int* pos;
    const float *norm1_g, *norm2_g, *w_ada, *b_ada, *w_in, *conv_a_w, *conv_a_b, *conv_a_norm_g, *conv_b_w, *sc_norm_g,
        *q_norm_g, *k_norm_g, *lam_q1, *lam_k1, *lam_q2, *lam_k2, *attn_norm_g, *w_out, *w_gate_up, *w_down;
    float* out; unsigned char* ws;
    int ph_lo, ph_hi;
};

DI unsigned pk2(float lo, float hi) { f32x2 v = {lo, hi}; return __builtin_bit_cast(unsigned, __builtin_convertvector(v, bf16x2n)); }
DI float bf_lo(unsigned u) { return __uint_as_float(u << 16); }
DI float bf_hi(unsigned u) { return __uint_as_float(u & 0xffff0000u); }
DI float wave_sum(float v) {
#pragma unroll
    for (int o = 1; o < 64; o <<= 1) v += __shfl_xor(v, o);
    return v;
}
DI float wave_max(float v) {
#pragma unroll
    for (int o = 1; o < 64; o <<= 1) v = fmaxf(v, __shfl_xor(v, o));
    return v;
}
DI int opq(int v) { asm volatile("" : "+v"(v)); return v; }
DI float sigmoidf_fast(float v) { return __builtin_amdgcn_rcpf(1.0f + __builtin_amdgcn_exp2f(-v * LOG2E)); }

namespace pg8 {
constexpr int BM = 256, BK = 64, HALF = 128, HTB = HALF * BK * 2, NXCD = 8, WGM = 8;
DI int lds_byte(int r, int c) { const int st = (r >> 4) * 2 + (c >> 5), rr = r & 15, cc = c & 31, ob = rr * 64 + cc * 2; return st * 1024 + (ob ^ (((ob >> 9) & 1) << 5)); }
DI void stage_rc(int b, int& R, int& C) { const int st = b / 1024, sb = b % 1024, swz = sb ^ (((sb >> 9) & 1) << 5); R = (st >> 1) * 16 + swz / 64; C = (st & 1) * 32 + (swz % 64) / 2; }
DI int perm32(int rho) { const int n = rho >> 4, i = rho & 15; return 8 * (i >> 2) + 4 * n + (i & 3); }
struct Unit { int pm, pn; };
struct Gemm { const bf16_t* A; const bf16_t* Bt; int M, N, K; };
struct StaticOrder {
    int nM, nN, nwg, G, c;
    DI void init(int M, int N, int G_, int c_) { nM = M / BM; nN = N / BM; nwg = nM * nN; G = G_; c = c_; }
    DI bool next(int i, Unit& u) const {
        const long L = (long)i * G + c; if (L >= nwg) return false;
        int wgid = (int)L; { const int q = nwg / NXCD, r = nwg % NXCD, xcd = wgid % NXCD, off = wgid / NXCD; wgid = (xcd < r ? xcd * (q + 1) : r * (q + 1) + (xcd - r) * q) + off; }
        const int nig = WGM * nN, gid = wgid / nig, fm = gid * WGM, gsz = (nM - fm) < WGM ? (nM - fm) : WGM;
        u.pm = fm + ((wgid % nig) % gsz); u.pn = (wgid % nig) / gsz; return true;
    }
};

DI void row_rstd8(const float* rowss, int row0, int fq, float (&rstd)[2][4]) {
    f32x4 pr[2][4];
#pragma unroll
    for (int ai = 0; ai < 2; ++ai)
#pragma unroll
        for (int m = 0; m < 4; ++m) pr[ai][m] = *(const f32x4*)(rowss + (size_t)(row0 + ai * HALF + m * 16) * 16 + 4 * fq);
#pragma unroll
    for (int ai = 0; ai < 2; ++ai)
#pragma unroll
        for (int m = 0; m < 4; ++m) { float t = (pr[ai][m][0] + pr[ai][m][1]) + (pr[ai][m][2] + pr[ai][m][3]);
            t += __shfl_xor(t, 16); t += __shfl_xor(t, 32);
            rstd[ai][m] = rsqrtf(t * (1.f / DM) + EPS); }
}
struct EpiZ {
    static constexpr bool PERM = true;
    bf16_t* O; int ldc; const float* rowss; const float* shw;
    bf16_t* QH; bf16_t* KH; const float* gq; const float* gk; const float* rc; const float* rs;
    DI void operator()(const f32x4 (&acc)[2][2][4][2], const Unit& u, int wr, int wc, int fr, int fq) const {
        const int row0 = u.pm * BM + wr * 64 + fr, col0 = u.pn * BM + wc * 32 + 8 * fq, b = (u.pm * BM) / SEQ;
        float rstd8[2][4]; row_rstd8(rowss, row0, fq, rstd8);
        const float* svp = shw + (size_t)b * ldc + col0;
        if (u.pn < 5 || u.pn > 8) {
            f32x4 sv[2][2];
#pragma unroll
            for (int bj = 0; bj < 2; ++bj)
#pragma unroll
                for (int n = 0; n < 2; ++n) sv[bj][n] = *(const f32x4*)(svp + bj * HALF + 4 * n);
#pragma unroll
            for (int ai = 0; ai < 2; ++ai)
#pragma unroll
                for (int m = 0; m < 4; ++m) { const int row = row0 + ai * HALF + m * 16; bf16_t* rowp = O + (size_t)row * ldc + col0;
                    const float rstd = rstd8[ai][m];
#pragma unroll
                    for (int bj = 0; bj < 2; ++bj) { const f32x4 v0 = acc[ai][bj][m][0] * rstd + sv[bj][0], v1 = acc[ai][bj][m][1] * rstd + sv[bj][1];
                        u32x4 w; w.x = pk2(v0[0], v0[1]); w.y = pk2(v0[2], v0[3]); w.z = pk2(v1[0], v1[1]); w.w = pk2(v1[2], v1[3]);
                        *(u32x4*)(rowp + bj * HALF) = w; } }
        } else {
            const int gi = (u.pn - 5) * 4 + wc, isk = gi >> 3, hd = (gi >> 1) & 3, hfh = gi & 1;
            const float* gg = isk ? gk : gq; bf16_t* dst = (isk ? KH : QH) + hd * 128 + hfh * 64 + 4 * fq;
            const float qs = isk ? 1.0f : LOG2E * 0.125f;
#pragma unroll
            for (int ai = 0; ai < 2; ++ai)
#pragma unroll
                for (int m = 0; m < 4; ++m) { const int row = row0 + ai * HALF + m * 16, spos = row & (SEQ - 1);
                    const float rstd = rstd8[ai][m];
                    f32x4 lo[2], hi[2]; float ss = 0.f;
#pragma unroll
                    for (int bj = 0; bj < 2; ++bj) { const f32x4 v0 = acc[ai][bj][m][0] * rstd + *(const f32x4*)(svp + bj * HALF), v1 = acc[ai][bj][m][1] * rstd + *(const f32x4*)(svp + bj * HALF + 4);
                        lo[bj] = (f32x4){v0[0], v0[2], v1[0], v1[2]}; hi[bj] = (f32x4){v0[1], v0[3], v1[1], v1[3]};
                        ss += ((v0[0] * v0[0] + v0[1] * v0[1]) + (v0[2] * v0[2] + v0[3] * v0[3])) + ((v1[0] * v1[0] + v1[1] * v1[1]) + (v1[2] * v1[2] + v1[3] * v1[3])); }
                    ss += __shfl_xor(ss, 16); ss += __shfl_xor(ss, 32);
                    const float rg = rsqrtf(ss * (1.f / 64.f) + EPS) * qs;
#pragma unroll
                    for (int bj = 0; bj < 2; ++bj) {
                        const f32x4 glo = *(const f32x4*)(gg + bj * 16 + fq * 4), ghi = *(const f32x4*)(gg + 32 + bj * 16 + fq * 4);
                        const f32x4 c4 = *(const f32x4*)(rc + spos * 32 + bj * 16 + fq * 4), s4 = *(const f32x4*)(rs + spos * 32 + bj * 16 + fq * 4);
                        const f32x4 a = lo[bj] * rg * glo, bb = hi[bj] * rg * ghi;
                        const f32x4 olo = a * c4 - bb * s4, ohi = bb * c4 + a * s4;
                        u32x2 w0, w1; w0.x = pk2(olo[0], olo[1]); w0.y = pk2(olo[2], olo[3]); w1.x = pk2(ohi[0], ohi[1]); w1.y = pk2(ohi[2], ohi[3]);
                        *(u32x2*)(dst + (size_t)row * 512 + bj * 16) = w0; *(u32x2*)(dst + (size_t)row * 512 + 32 + bj * 16) = w1; }
                    asm volatile("" ::: "memory"); }
        }
    }
};
struct EpiRes {
    static constexpr bool PERM = true;
    const _Float16* xin; _Float16* xout; float* xout32; const float* gate; const float* gm; bf16_t* Hout; float* rowss_out;
    DI void operator()(const f32x4 (&acc)[2][2][4][2], const Unit& u, int wr, int wc, int fr, int fq) const {
        const int row0 = u.pm * BM + wr * 64 + fr, col0 = u.pn * BM + wc * 32 + 8 * fq, b = (u.pm * BM) / SEQ;
        const bool nxt = gm != nullptr, o32 = xout32 != nullptr;
        f32x4 gv[2][2], gmv[2][2];
#pragma unroll
        for (int bj = 0; bj < 2; ++bj)
#pragma unroll
            for (int n = 0; n < 2; ++n) { gv[bj][n] = *(const f32x4*)(gate + (size_t)b * MODW + col0 + bj * HALF + 4 * n);
                gmv[bj][n] = nxt ? *(const f32x4*)(gm + (size_t)b * DM + col0 + bj * HALF + 4 * n) : (f32x4){0.f, 0.f, 0.f, 0.f}; }
        h16x8 xv[2][2];
#define ER_LOAD(rnd) do { const size_t off_ = (size_t)(row0 + ((rnd) >> 2) * HALF + ((rnd) & 3) * 16) * DM + col0; \
            _Pragma("unroll") for (int bj = 0; bj < 2; ++bj) xv[(rnd) & 1][bj] = *(const h16x8*)(xin + off_ + bj * HALF); } while (0)
        ER_LOAD(0); ER_LOAD(1);
        float ssum[4] = {0.f, 0.f, 0.f, 0.f};
#pragma unroll
        for (int rnd = 0; rnd < 8; ++rnd) {
            const int ai = rnd >> 2, m = rnd & 3;
            const size_t off = (size_t)(row0 + ai * HALF + m * 16) * DM + col0;
            f32x4 x0[2], x1[2];
#pragma unroll
            for (int bj = 0; bj < 2; ++bj) { const f32x8 xf = __builtin_convertvector(xv[rnd & 1][bj], f32x8);
                x0[bj] = (f32x4){xf[0], xf[1], xf[2], xf[3]} + gv[bj][0] * acc[ai][bj][m][0]; x1[bj] = (f32x4){xf[4], xf[5], xf[6], xf[7]} + gv[bj][1] * acc[ai][bj][m][1]; }
            if (rnd + 2 < 8) ER_LOAD(rnd + 2);
#pragma unroll
            for (int bj = 0; bj < 2; ++bj) {
                if (o32) { *(f32x4*)(xout32 + off + bj * HALF) = x0[bj]; *(f32x4*)(xout32 + off + bj * HALF + 4) = x1[bj]; }
                else { const f32x8 xf = {x0[bj][0], x0[bj][1], x0[bj][2], x0[bj][3], x1[bj][0], x1[bj][1], x1[bj][2], x1[bj][3]};
                    *(h16x8*)(xout + off + bj * HALF) = __builtin_convertvector(xf, h16x8); }
                if (nxt) {
                    ssum[m] += ((x0[bj][0] * x0[bj][0] + x0[bj][1] * x0[bj][1]) + (x0[bj][2] * x0[bj][2] + x0[bj][3] * x0[bj][3])) + ((x1[bj][0] * x1[bj][0] + x1[bj][1] * x1[bj][1]) + (x1[bj][2] * x1[bj][2] + x1[bj][3] * x1[bj][3]));
                    const f32x4 h0 = x0[bj] * gmv[bj][0], h1 = x1[bj] * gmv[bj][1];
                    u32x4 w; w.x = pk2(h0[0], h0[1]); w.y = pk2(h0[2], h0[3]); w.z = pk2(h1[0], h1[1]); w.w = pk2(h1[2], h1[3]);
                    *(u32x4*)(Hout + off + bj * HALF) = w; } }
            asm volatile("" ::: "memory");
            if (nxt && m == 3) {
                const bool hi2 = (fq & 2) != 0, hi1 = (fq & 1) != 0;
                const float t0 = hi2 ? ssum[0] : ssum[2], t1 = hi2 ? ssum[1] : ssum[3], k0 = hi2 ? ssum[2] : ssum[0], k1 = hi2 ? ssum[3] : ssum[1];
                const float a0 = k0 + __shfl_xor(t0, 32), a1 = k1 + __shfl_xor(t1, 32);
                const float t = hi1 ? a0 : a1, k = hi1 ? a1 : a0;
                const float rsum = k + __shfl_xor(t, 16);
                rowss_out[(size_t)(u.pm * BM + ai * HALF + wr * 64 + fq * 16 + fr) * 16 + u.pn * 4 + wc] = rsum;
#pragma unroll
                for (int i = 0; i < 4; ++i) ssum[i] = 0.f;
            }
        }
#undef ER_LOAD
    }
};
struct EpiSwiGLU {
    static constexpr bool PERM = true;
    bf16_t* O; const float* rowss; const float* shw;
    DI void operator()(const f32x4 (&acc)[2][2][4][2], const Unit& u, int wr, int wc, int fr, int fq) const {
        const int row0 = u.pm * BM + wr * 64 + fr, colh = u.pn * 128 + wc * 16 + 4 * fq, b = (u.pm * BM) / SEQ;
        f32x4 sv[2][2];
#pragma unroll
        for (int bj = 0; bj < 2; ++bj)
#pragma unroll
            for (int n = 0; n < 2; ++n) sv[bj][n] = *(const f32x4*)(shw + (size_t)b * GU + 2 * colh + bj * HALF + 4 * n);
        float rstd8[2][4]; row_rstd8(rowss, row0, fq, rstd8);
#pragma unroll
        for (int ai = 0; ai < 2; ++ai)
#pragma unroll
            for (int m = 0; m < 4; ++m) { const int row = row0 + ai * HALF + m * 16; bf16_t* rowp = O + (size_t)row * DFF + colh;
                const float rstd = rstd8[ai][m];
#pragma unroll
                for (int bj = 0; bj < 2; ++bj) { const f32x4 g = acc[ai][bj][m][0] * rstd + sv[bj][0], uu = acc[ai][bj][m][1] * rstd + sv[bj][1];
                    float a[4];
#pragma unroll
                    for (int i = 0; i < 4; ++i) a[i] = g[i] * sigmoidf_fast(g[i]) * uu[i];
                    u32x2 w; w.x = pk2(a[0], a[1]); w.y = pk2(a[2], a[3]);
                    *(u32x2*)(rowp + bj * 64) = w; } }
    }
};

template <class Epi, class Sched>
DI void gemm_phase(LAS unsigned char* lds, const Gemm g, const Sched& S, const Epi& E) {
    const int tid = opq(threadIdx.x), wid = __builtin_amdgcn_readfirstlane(tid >> 6), lane = tid & 63, wr = wid >> 2, wc = wid & 3, fr = lane & 15, fq = lane >> 4;
    const int K = g.K, nt = K / BK;
    unsigned voffA[2], voffB[2];
#pragma unroll
    for (int i = 0; i < 2; ++i) { int R, C; stage_rc(tid * 16 + i * 8192, R, C); const int Rb = Epi::PERM ? ((R & ~31) + perm32(R & 31)) : R;
        voffA[i] = (unsigned)(R * K + C) * 2u; voffB[i] = (unsigned)(Rb * K + C) * 2u; }
    const size_t kstep = (size_t)(BK * 2);
    const size_t hstep = (size_t)HALF * K * 2;
    const size_t tstep = 2 * hstep;
    const unsigned ldsw = (unsigned)wid * 1024u;
    const int aoff = lds_byte(wr * 64 + fr, fq * 8), boff = lds_byte(wc * 32 + fr, fq * 8);
#define PG8_SA(b, h) (((b) * 2 + (h)) * HTB)
#define PG8_SB(b, h) ((4 + (b) * 2 + (h)) * HTB)
#define PG8_STAGE(bufoff, gbase, voff) do { _Pragma("unroll") for (int _i = 0; _i < 2; ++_i) \
        __builtin_amdgcn_global_load_lds((const unsigned*)((const char*)(gbase) + (voff)[_i]), (LAS unsigned*)(lds + (bufoff) + ldsw + _i * 8192), 16, 0, 0); } while (0)
#define PG8_LDA(dst, b, h) do { _Pragma("unroll") for (int m = 0; m < 4; ++m) _Pragma("unroll") for (int k = 0; k < 2; ++k) dst[m][k] = *(const LAS bf16x8*)(lds + PG8_SA(b, h) + aoff + m * 2048 + k * 1024); } while (0)
#define PG8_LDB(dst, b, h) do { _Pragma("unroll") for (int n = 0; n < 2; ++n) _Pragma("unroll") for (int k = 0; k < 2; ++k) dst[n][k] = *(const LAS bf16x8*)(lds + PG8_SB(b, h) + boff + n * 2048 + k * 1024); } while (0)
#define PG8_MMA(ai, bj, At, Bt) do { __builtin_amdgcn_s_setprio(1); _Pragma("unroll") for (int m = 0; m < 4; ++m) _Pragma("unroll") for (int n = 0; n < 2; ++n) _Pragma("unroll") for (int k = 0; k < 2; ++k) \
        acc[ai][bj][m][n] = __builtin_amdgcn_mfma_f32_16x16x32_bf16(Bt[n][k], At[m][k], acc[ai][bj][m][n], 0, 0, 0); __builtin_amdgcn_s_setprio(0); } while (0)
#define PG8_WAIT_V(n) asm volatile("s_waitcnt vmcnt(" #n ")" ::: "memory")
#define PG8_WAIT_L(n) asm volatile("s_waitcnt lgkmcnt(" #n ")" ::: "memory")
#define PG8_BAR __builtin_amdgcn_s_barrier()
#define PG8_SCHED __builtin_amdgcn_sched_barrier(0)
    Unit cur, nxt; int ui = 0;
    if (!S.next(0, cur)) return;
    f32x4 acc[2][2][4][2];
#pragma unroll
    for (int a = 0; a < 2; ++a)
#pragma unroll
        for (int b = 0; b < 2; ++b)
#pragma unroll
            for (int m = 0; m < 4; ++m)
#pragma unroll
                for (int n = 0; n < 2; ++n) acc[a][b][m][n] = (f32x4){0.f, 0.f, 0.f, 0.f};
    bf16x8 At[4][2], B0[2][2], B1[2][2];
    const char* cA = (const char*)g.A + (size_t)cur.pm * tstep; const char* cB = (const char*)g.Bt + (size_t)cur.pn * tstep;
    PG8_STAGE(PG8_SB(0, 0), cB, voffB); PG8_STAGE(PG8_SA(0, 0), cA, voffA); PG8_STAGE(PG8_SB(0, 1), cB + hstep, voffB); PG8_STAGE(PG8_SA(0, 1), cA + hstep, voffA);
    if (wr == 1) PG8_BAR;
    PG8_WAIT_V(4); PG8_BAR;
    PG8_STAGE(PG8_SB(1, 0), cB + kstep, voffB); PG8_STAGE(PG8_SA(1, 0), cA + kstep, voffA); PG8_STAGE(PG8_SB(1, 1), cB + hstep + kstep, voffB);
    PG8_WAIT_V(6); PG8_BAR;
    for (;;) {
        const bool has_next = S.next(ui + 1, nxt);
        const char* nA = has_next ? (const char*)g.A + (size_t)nxt.pm * tstep : cA; const char* nB = has_next ? (const char*)g.Bt + (size_t)nxt.pn * tstep : cB;
        for (int t = 0; t < nt; t += 2) {
            const bool last = (t == nt - 2);
            const char* a1 = cA + (size_t)(t + 1) * kstep;
            const char* a2 = last ? nA : cA + (size_t)(t + 2) * kstep; const char* b2 = last ? nB : cB + (size_t)(t + 2) * kstep;
            const char* a3 = a2 + kstep; const char* b3 = b2 + kstep;
            PG8_LDB(B0, 0, 0); PG8_SCHED; PG8_LDA(At, 0, 0); PG8_STAGE(PG8_SA(1, 1), a1 + hstep, voffA);
            PG8_WAIT_L(8); PG8_BAR; PG8_WAIT_L(0); PG8_MMA(0, 0, At, B0); PG8_BAR; PG8_SCHED;
            PG8_LDB(B1, 0, 1); PG8_STAGE(PG8_SB(0, 0), b2, voffB);
            PG8_BAR; PG8_WAIT_L(0); PG8_MMA(0, 1, At, B1); PG8_BAR;
            PG8_LDA(At, 0, 1); PG8_STAGE(PG8_SA(0, 0), a2, voffA);
            PG8_BAR; PG8_WAIT_L(0); PG8_MMA(1, 0, At, B0); PG8_BAR; PG8_SCHED;
            PG8_STAGE(PG8_SB(0, 1), b2 + hstep, voffB);
            PG8_WAIT_V(6); PG8_BAR; PG8_MMA(1, 1, At, B1); PG8_BAR;
            PG8_LDB(B0, 1, 0); PG8_SCHED; PG8_LDA(At, 1, 0); PG8_STAGE(PG8_SA(0, 1), a2 + hstep, voffA);
            PG8_WAIT_L(8); PG8_BAR; PG8_WAIT_L(0); PG8_MMA(0, 0, At, B0); PG8_BAR; PG8_SCHED;
            PG8_LDB(B1, 1, 1); PG8_STAGE(PG8_SB(1, 0), b3, voffB);
            PG8_BAR; PG8_WAIT_L(0); PG8_MMA(0, 1, At, B1); PG8_BAR;
            PG8_LDA(At, 1, 1); PG8_STAGE(PG8_SA(1, 0), a3, voffA);
            PG8_BAR; PG8_WAIT_L(0); PG8_MMA(1, 0, At, B0); PG8_BAR; PG8_SCHED;
            PG8_STAGE(PG8_SB(1, 1), b3 + hstep, voffB);
            PG8_WAIT_V(6); PG8_BAR; PG8_MMA(1, 1, At, B1); PG8_BAR;
        }
        E(acc, cur, wr, wc, fr, fq);
        if (!has_next) break;
#pragma unroll
        for (int a = 0; a < 2; ++a)
#pragma unroll
            for (int b = 0; b < 2; ++b)
#pragma unroll
                for (int m = 0; m < 4; ++m)
#pragma unroll
                    for (int n = 0; n < 2; ++n) acc[a][b][m][n] = (f32x4){0.f, 0.f, 0.f, 0.f};
        cur = nxt; cA = nA; cB = nB; ++ui;
    }
    PG8_WAIT_V(0);
    if (wr == 0) PG8_BAR;
    PG8_BAR;
#undef PG8_SA
#undef PG8_SB
#undef PG8_STAGE
#undef PG8_LDA
#undef PG8_LDB
#undef PG8_MMA
#undef PG8_WAIT_V
#undef PG8_WAIT_L
#undef PG8_BAR
#undef PG8_SCHED
}
}

template <int MODE>
DI int wrow_map(int n) {
    if (MODE == 0) return n;
    if (MODE == 2) { if (n < 1280 || n >= 2304) return n;
        const int gi = (n - 1280) >> 6, d = (n - 1280) & 63, hi = d >> 5, f = d & 31, bj = f >> 4, fq = (f >> 2) & 3, jj = f & 3;
        return 256 * (5 + (gi >> 2)) + 128 * bj + 32 * (gi & 3) + 8 * fq + 2 * jj + hi; }
    const int isu = n >= DFF ? 1 : 0, j = n - isu * DFF; return 8 * (j >> 2) + 4 * isu + (j & 3); }
template <int MODE>
DI void p0_transpose_item(const float* W, int K, int N, bf16_t* WT, LAS float* scr, int item, int lane) {
    const int nblk = N / 32, kb = item / nblk, nb = item % nblk, k0 = 64 * kb, n0 = 32 * nb;
    float wv[32];
#pragma unroll
    for (int i = 0; i < 32; ++i) wv[i] = W[(size_t)(k0 + 2 * i + (lane >> 5)) * N + n0 + (lane & 31)];
#pragma unroll
    for (int i = 0; i < 32; ++i) scr[(2 * i + (lane >> 5)) * 33 + (lane & 31)] = wv[i];
    asm volatile("s_waitcnt lgkmcnt(0)" ::: "memory");
    const int c = lane & 7;
#pragma unroll
    for (int j = 0; j < 4; ++j) { const int n = (lane >> 3) + 8 * j; const LAS float* s = scr + (8 * c) * 33 + n;
        u32x4 o; o.x = pk2(s[0 * 33], s[1 * 33]); o.y = pk2(s[2 * 33], s[3 * 33]); o.z = pk2(s[4 * 33], s[5 * 33]); o.w = pk2(s[6 * 33], s[7 * 33]);
        *(u32x4*)(WT + (size_t)wrow_map<MODE>(n0 + n) * K + k0 + 8 * c) = o; }
    asm volatile("s_waitcnt lgkmcnt(0)" ::: "memory");
}

DI void phase0(const Params& p, LAS unsigned char* lds) {
    const int tid = opq(threadIdx.x), lane = tid & 63, wave = tid >> 6, G = gridDim.x;
    {
        LAS float* cact = (LAS float*)lds;
        float* mod = (float*)(p.ws + WS_MOD);
        constexpr int NITEM = NL * (MODW / 64);
        for (int it = blockIdx.x; it < NITEM; it += G) {
            const int l = it / (MODW / 64), n0 = (it % (MODW / 64)) * 64;
            for (int idx = tid; idx < NB * DM; idx += 512) { const int k = idx >> 5, b = idx & 31; const float v = p.c[b * DM + k]; cact[idx] = v * sigmoidf_fast(v); }
            __syncthreads();
            float acc[32];
#pragma unroll
            for (int b = 0; b < 32; ++b) acc[b] = 0.f;
            const float* wp = p.w_ada + ((size_t)l * DM + 128 * wave) * MODW + n0 + lane;
            const LAS f32x4* cp = (const LAS f32x4*)(cact + (128 * wave) * 32);
#pragma unroll 1
            for (int kk0 = 0; kk0 < 128; kk0 += 32) {
                float wv[32];
#pragma unroll
                for (int i = 0; i < 32; ++i) wv[i] = wp[(size_t)(kk0 + i) * MODW];
#pragma unroll
                for (int i = 0; i < 32; ++i) {
#pragma unroll
                    for (int q = 0; q < 8; ++q) { const f32x4 cv = cp[(kk0 + i) * 8 + q]; acc[4 * q] += cv[0] * wv[i]; acc[4 * q + 1] += cv[1] * wv[i]; acc[4 * q + 2] += cv[2] * wv[i]; acc[4 * q + 3] += cv[3] * wv[i]; }
                }
            }
            __syncthreads();
            LAS float* red = (LAS float*)lds;
#pragma unroll
            for (int b = 0; b < 32; ++b) red[(wave * 32 + b) * 64 + lane] = acc[b];
            __syncthreads();
#pragma unroll
            for (int j = 0; j < 4; ++j) { const int o = tid + 512 * j, b = o >> 6, n = o & 63; float s = p.b_ada[l * MODW + n0 + n];
#pragma unroll
                for (int w = 0; w < 8; ++w) s += red[(w * 32 + b) * 64 + n];
                mod[((size_t)l * NB + b) * MODW + n0 + n] = s; }
            __syncthreads();
        }
    }
    {
        LAS float* scr = (LAS float*)(lds + wave * 16384);
        const int gw = blockIdx.x * 8 + wave, NGW = G * 8;
        constexpr int I_IN = (DM / 64) * (INW / 32), I_OUT = (DM / 64) * (DM / 32), I_GU = (DM / 64) * (GU / 32), I_DN = (DFF / 64) * (DM / 32);
        constexpr int PER_L = I_IN + I_OUT + I_GU + I_DN;
        for (int it = gw; it < NL * PER_L; it += NGW) {
            const int l = it / PER_L; int r = it % PER_L;
            if (r < I_IN) { p0_transpose_item<2>(p.w_in + (size_t)l * DM * INW, DM, INW, (bf16_t*)(p.ws + WS_WT_IN) + (size_t)l * INW * DM, scr, r, lane); continue; } r -= I_IN;
            if (r < I_OUT) { p0_transpose_item<0>(p.w_out + (size_t)l * DM * DM, DM, DM, (bf16_t*)(p.ws + WS_WT_OUT) + (size_t)l * DM * DM, scr, r, lane); continue; } r -= I_OUT;
            if (r < I_GU) { p0_transpose_item<1>(p.w_gate_up + (size_t)l * DM * GU, DM, GU, (bf16_t*)(p.ws + WS_WT_GU) + (size_t)l * GU * DM, scr, r, lane); continue; } r -= I_GU;
            p0_transpose_item<0>(p.w_down + (size_t)l * DFF * DM, DFF, DM, (bf16_t*)(p.ws + WS_WT_DN) + (size_t)l * DM * DFF, scr, r, lane);
        }
    }
    {
        float* rc = (float*)(p.ws + WS_ROPE); float* rs = rc + SEQ * 32;
        for (int idx = blockIdx.x * 512 + tid; idx < SEQ * 32; idx += G * 512) {
            const int s = idx >> 5, i = idx & 31;
            double inv = 1.0, bpow = 0.7498942093324559;
#pragma unroll
            for (int bit = 0; bit < 5; ++bit) { if ((i >> bit) & 1) inv *= bpow; bpow *= bpow; }
            const double rev = (double)p.pos[s] * inv * 0.15915494309189535;
            const float fr = (float)(rev - floor(rev));
            rc[idx] = __builtin_amdgcn_cosf(fr); rs[idx] = __builtin_amdgcn_sinf(fr);
        }
    }
}

DI void phase_pre(const Params& p) {
    const int tid = opq(threadIdx.x), lane = tid & 63, wave = tid >> 6, G = gridDim.x, NGW = G * 8, gw = blockIdx.x * 8 + wave;
    const float* mod = (const float*)(p.ws + WS_MOD);
    {
        const int r = lane & 31, h = lane >> 5;
        constexpr int NBLK_IN = INW / 32, NBLK_GU = GU / 32, PER_L = NBLK_IN + NBLK_GU;
        for (int it = gw; it < NL * PER_L; it += NGW) {
            const int l = it / PER_L, q = it % PER_L; const bool isgu = q >= NBLK_IN; const int nb = isgu ? q - NBLK_IN : q;
            const bf16_t* W = isgu ? (const bf16_t*)(p.ws + WS_WT_GU) + ((size_t)l * GU + nb * 32 + r) * DM : (const bf16_t*)(p.ws + WS_WT_IN) + ((size_t)l * INW + nb * 32 + r) * DM;
            const float* sh = mod + ((size_t)l * NB + r) * MODW + (isgu ? 3 * DM : 0);
            f32x16 acc;
#pragma unroll
            for (int i = 0; i < 16; ++i) acc[i] = 0.f;
#pragma unroll 8
            for (int ks = 0; ks < DM / 16; ++ks) {
                const int k0 = ks * 16 + h * 8;
                const bf16x8 bfrag = *(const bf16x8*)(W + k0);
                const f32x4 s0 = *(const f32x4*)(sh + k0), s1 = *(const f32x4*)(sh + k0 + 4);
                u32x4 a; a.x = pk2(s0[0], s0[1]); a.y = pk2(s0[2], s0[3]); a.z = pk2(s1[0], s1[1]); a.w = pk2(s1[2], s1[3]);
                acc = __builtin_amdgcn_mfma_f32_32x32x16_bf16(__builtin_bit_cast(bf16x8, a), bfrag, acc, 0, 0, 0);
            }
            float* o = isgu ? (float*)(p.ws + WS_SHW_GU) + (size_t)l * NB * GU : (float*)(p.ws + WS_SHW_IN) + (size_t)l * NB * INW;
            const int ld = isgu ? GU : INW;
#pragma unroll
            for (int i = 0; i < 16; ++i) o[(size_t)((i & 3) + 8 * (i >> 2) + 4 * h) * ld + nb * 32 + r] = acc[i];
        }
    }
    {
        float* gm = (float*)(p.ws + WS_GM);
        for (int idx = blockIdx.x * 512 + tid; idx < NL * 2 * NB * DM; idx += G * 512) {
            const int k = idx & 1023, b = (idx >> 10) & 31, sx = (idx >> 15) & 1, l = idx >> 16;
            const float g = (sx ? p.norm2_g : p.norm1_g)[l * DM + k], sc = mod[((size_t)l * NB + b) * MODW + (sx ? 4 : 1) * DM + k];
            gm[idx] = g * (1.0f + sc);
        }
    }
    {
        bf16_t* H = (bf16_t*)(p.ws + WS_H); float* rowss = (float*)(p.ws + WS_ROWSS);
        for (int rb = gw; rb < MTOK / 32; rb += NGW) {
            const int b = (rb * 32) / SEQ;
            f32x4 gs[4];
#pragma unroll
            for (int j = 0; j < 4; ++j) { const int col = 4 * lane + 256 * j;
                const f32x4 gg = *(const f32x4*)(p.norm1_g + col), sc = *(const f32x4*)(mod + (size_t)b * MODW + DM + col);
                gs[j] = gg * (sc + 1.0f); }
            for (int r = 0; r < 32; r += 4) {
                const size_t row = (size_t)rb * 32 + r;
                const f32x4* xr = (const f32x4*)(p.x + row * DM) + lane;
                f32x4 v[4][4];
#pragma unroll
                for (int q = 0; q < 4; ++q)
#pragma unroll
                    for (int j = 0; j < 4; ++j) v[q][j] = xr[256 * q + 64 * j];
#pragma unroll
                for (int q = 0; q < 4; ++q) { float sq = 0.f;
#pragma unroll
                    for (int j = 0; j < 4; ++j) sq += (v[q][j][0] * v[q][j][0] + v[q][j][1] * v[q][j][1]) + (v[q][j][2] * v[q][j][2] + v[q][j][3] * v[q][j][3]);
                    sq = wave_sum(sq);
                    if (lane < 16) rowss[(row + q) * 16 + lane] = (lane == 0) ? sq : 0.f;
                    u32x2* o8 = (u32x2*)(H + (row + q) * DM) + lane; h16x4* x8 = (h16x4*)((_Float16*)(p.ws + WS_X16) + (row + q) * DM) + lane;
#pragma unroll
                    for (int j = 0; j < 4; ++j) { const f32x4 y = v[q][j] * gs[j]; u32x2 w; w.x = pk2(y[0], y[1]); w.y = pk2(y[2], y[3]); o8[64 * j] = w; x8[64 * j] = __builtin_convertvector(v[q][j], h16x4); } }
            }
        }
    }
}

DI void phase_prep(const Params& p, int l, LAS unsigned char* lds) {
    const int tid = opq(threadIdx.x), lane = tid & 63, wave = tid >> 6, G = gridDim.x;
    const bf16_t* Z = (const bf16_t*)(p.ws + WS_Z);
    bf16_t* MIX = (bf16_t*)(p.ws + WS_MIX);
    LAS float* U = (LAS float*)lds;
    LAS float* CV = (LAS float*)(lds + 65536);
    const int cch = tid & 255, th = tid >> 8;
    float cw[31];
#pragma unroll
    for (int j = 0; j < 31; ++j) cw[j] = p.conv_a_w[((size_t)l * 31 + j) * 256 + cch];
    const float cbias = p.conv_a_b[l * 256 + cch];
    const f32x4 ga = *(const f32x4*)(p.conv_a_norm_g + l * 256 + 4 * lane);
    const f32x4 gb = *(const f32x4*)(p.sc_norm_g + l * 256 + 4 * lane);
    f32x4 wb[3];
#pragma unroll
    for (int j = 0; j < 3; ++j) wb[j] = *(const f32x4*)(p.conv_b_w + ((size_t)l * 3 + j) * 256 + 4 * lane);

    const int pvcu = (G % 8 == 0) ? ((blockIdx.x & 7) * (G >> 3) + (blockIdx.x >> 3)) : blockIdx.x;
    for (int it = pvcu; it < MTOK / 32; it += G) {
        const int b = it >> 6, t0 = (it & 63) * 32;
        const size_t tokbase = (size_t)b * SEQ;
        u32x4 av[4], ag[4];
#pragma unroll
        for (int k4 = 0; k4 < 4; ++k4) { const int ci = tid + 512 * k4, row = ci >> 5, ch8 = ci & 31, tok = t0 - 15 + row;
            av[k4] = (u32x4){0u, 0u, 0u, 0u}; ag[k4] = av[k4];
            if (ci < 62 * 32 && tok >= 0 && tok < SEQ) { const bf16_t* zp = Z + (tokbase + tok) * INW + ch8 * 8; av[k4] = *(const u32x4*)zp; ag[k4] = *(const u32x4*)(zp + 256); } }
        const int tw = t0 + wave * 4;
        u32x2 bcg[6], bhv[6], bbg[4];
#pragma unroll
        for (int r = 0; r < 6; ++r) { const int tok = tw - 1 + r; bcg[r] = (u32x2){0u, 0u}; bhv[r] = bcg[r];
            if (tok >= 0 && tok < SEQ) { const bf16_t* zp = Z + (tokbase + tok) * INW + 512 + 4 * lane; bcg[r] = *(const u32x2*)(zp + 256); bhv[r] = *(const u32x2*)(zp + 512);
                if (r >= 1 && r <= 4) bbg[r - 1] = *(const u32x2*)zp; } }
#pragma unroll
        for (int k4 = 0; k4 < 4; ++k4) { const int ci = tid + 512 * k4, row = ci >> 5, ch8 = ci & 31;
            if (ci < 62 * 32) { const u32x4 v = av[k4], gt = ag[k4]; f32x4 o0, o1;
                o0[0] = bf_lo(v.x) * sigmoidf_fast(bf_lo(gt.x)); o0[1] = bf_hi(v.x) * sigmoidf_fast(bf_hi(gt.x));
                o0[2] = bf_lo(v.y) * sigmoidf_fast(bf_lo(gt.y)); o0[3] = bf_hi(v.y) * sigmoidf_fast(bf_hi(gt.y));
                o1[0] = bf_lo(v.z) * sigmoidf_fast(bf_lo(gt.z)); o1[1] = bf_hi(v.z) * sigmoidf_fast(bf_hi(gt.z));
                o1[2] = bf_lo(v.w) * sigmoidf_fast(bf_lo(gt.w)); o1[3] = bf_hi(v.w) * sigmoidf_fast(bf_hi(gt.w));
                *(LAS f32x4*)(U + row * 256 + ch8 * 8) = o0; *(LAS f32x4*)(U + row * 256 + ch8 * 8 + 4) = o1; } }
        __syncthreads();
#pragma unroll 1
        for (int chunk = 0; chunk < 2; ++chunk) {
            const int tb = th * 16 + chunk * 8;
            float uu[38];
#pragma unroll
            for (int i = 0; i < 38; ++i) uu[i] = U[(tb + i) * 256 + cch];
#pragma unroll
            for (int t = 0; t < 8; ++t) { float a = cbias;
#pragma unroll
                for (int j = 0; j < 31; ++j) a += cw[j] * uu[t + j];
                CV[(tb + t) * 256 + cch] = a; }
        }
        __syncthreads();
#pragma unroll
        for (int q = 0; q < 4; ++q) { const int t = wave * 4 + q;
            const f32x4 v = *(const LAS f32x4*)(CV + t * 256 + 4 * lane);
            const float ss = wave_sum((v[0] * v[0] + v[1] * v[1]) + (v[2] * v[2] + v[3] * v[3]));
            const f32x4 y = v * rsqrtf(ss * (1.f / 256.f) + EPS) * ga;
            f32x4 o;
#pragma unroll
            for (int i = 0; i < 4; ++i) o[i] = y[i] * sigmoidf_fast(y[i]);
            u32x2 w; w.x = pk2(o[0], o[1]); w.y = pk2(o[2], o[3]);
            *(u32x2*)(MIX + (tokbase + t0 + t) * DM + 4 * lane) = w; }
        {
            f32x4 mrow[6], bgv[4];
#pragma unroll
            for (int r = 0; r < 6; ++r) { mrow[r][0] = bf_lo(bcg[r].x) * bf_lo(bhv[r].x); mrow[r][1] = bf_hi(bcg[r].x) * bf_hi(bhv[r].x); mrow[r][2] = bf_lo(bcg[r].y) * bf_lo(bhv[r].y); mrow[r][3] = bf_hi(bcg[r].y) * bf_hi(bhv[r].y); }
#pragma unroll
            for (int q = 0; q < 4; ++q) { bgv[q][0] = bf_lo(bbg[q].x); bgv[q][1] = bf_hi(bbg[q].x); bgv[q][2] = bf_lo(bbg[q].y); bgv[q][3] = bf_hi(bbg[q].y); }
#pragma unroll
            for (int q = 0; q < 4; ++q) {
                const f32x4 y = bgv[q] * (wb[0] * mrow[q] + wb[1] * mrow[q + 1] + wb[2] * mrow[q + 2]);
                const float ss = wave_sum((y[0] * y[0] + y[1] * y[1]) + (y[2] * y[2] + y[3] * y[3]));
                const f32x4 o = y * rsqrtf(ss * (1.f / 256.f) + EPS) * gb;
                u32x2 w; w.x = pk2(o[0], o[1]); w.y = pk2(o[2], o[3]);
                *(u32x2*)(MIX + (tokbase + tw + q) * DM + 256 + 4 * lane) = w; }
        }
        __syncthreads();
    }
}

constexpr int KROW = 272, VROW = 320, KBYTES = 64 * KROW, VBYTES = 64 * VROW, ABUF = KBYTES + VBYTES;
typedef short s16x4 __attribute__((ext_vector_type(4)));
#define MFMA32(a, b, c) __builtin_amdgcn_mfma_f32_32x32x16_bf16((a), (b), (c), 0, 0, 0)

DI void phase_attn(const Params& p, int l, float lambda_init, LAS unsigned char* lds) {
    const int tid = opq(threadIdx.x), lane = tid & 63, wave = tid >> 6, G = gridDim.x, r = lane & 31, h = lane >> 5;
    const int rg = wave >> 1, hf = wave & 1;
    const bf16_t* Z = (const bf16_t*)(p.ws + WS_Z);
    const bf16_t* QH = (const bf16_t*)(p.ws + WS_QH); const bf16_t* KH = (const bf16_t*)(p.ws + WS_KH);
    bf16_t* MIX = (bf16_t*)(p.ws + WS_MIX);
    const float sa = wave_sum(p.lam_q1[l * 64 + lane] * p.lam_k1[l * 64 + lane]), sb = wave_sum(p.lam_q2[l * 64 + lane] * p.lam_k2[l * 64 + lane]);
    const float lam = expf(sa) - expf(sb) + lambda_init;
    const float oscale = 1.0f - lambda_init;
    const int kkey = tid >> 3, kch = tid & 7;
    const int vtr = (4 * (lane >> 5) + ((lane >> 2) & 3)) * VROW + (16 * ((lane >> 4) & 1) + 4 * (lane & 3)) * 2;
    const int vcu = (G % 8 == 0) ? ((blockIdx.x & 7) * (G >> 3) + (blockIdx.x >> 3)) : blockIdx.x;
    LAS float* X = (LAS float*)lds + rg * (128 * 32);

    bf16x8 qf[4]; u32x4 krA[2], vrA[2], krB[2], vrB[2];
#define ATT_ITEM_PTRS(it_) const int qblk = (it_) & 15, head = ((it_) >> 4) & 3, b = (it_) >> 6; const size_t tokb = (size_t)b * SEQ; \
        const size_t qtok = tokb + qblk * 128 + rg * 32 + r; \
        const bf16_t* kg = KH + (tokb + kkey) * 512 + head * 128 + kch * 8; const bf16_t* vg = Z + (tokb + kkey) * INW + 2304 + head * 128 + kch * 8;
#define ATT_LOAD(KR, VR, t_) do { const bf16_t* kg2_ = kg + (size_t)(t_) * 64 * 512; const bf16_t* vg2_ = vg + (size_t)(t_) * 64 * INW; \
            KR[0] = *(const u32x4*)kg2_; KR[1] = *(const u32x4*)(kg2_ + 64); VR[0] = *(const u32x4*)vg2_; VR[1] = *(const u32x4*)(vg2_ + 64); } while (0)
#define ATT_ITEM_PREFETCH() do { ATT_LOAD(krA, vrA, 0); ATT_LOAD(krB, vrB, 1); \
            _Pragma("unroll") for (int kk = 0; kk < 4; ++kk) qf[kk] = *(const bf16x8*)(QH + qtok * 512 + head * 128 + hf * 64 + kk * 16 + h * 8); } while (0)
    if (vcu < NB * 4 * 16) { ATT_ITEM_PTRS(vcu); ATT_ITEM_PREFETCH(); }
    for (int it = vcu; it < NB * 4 * 16; it += G) {
        ATT_ITEM_PTRS(it);
        f32x16 o[4];
#pragma unroll
        for (int eb = 0; eb < 4; ++eb)
#pragma unroll
            for (int i = 0; i < 16; ++i) o[eb][i] = 0.f;
        float lsum = 0.f;
#define ATT_WRITE(KR, VR, buf) do { LAS unsigned char* kb_ = lds + (buf) * ABUF; LAS unsigned char* vb_ = kb_ + KBYTES; \
            *(LAS u32x4*)(kb_ + kkey * KROW + kch * 16) = KR[0]; *(LAS u32x4*)(kb_ + kkey * KROW + kch * 16 + 128) = KR[1]; \
            *(LAS u32x4*)(vb_ + kkey * VROW + kch * 16) = VR[0]; *(LAS u32x4*)(vb_ + kkey * VROW + kch * 16 + 128) = VR[1]; } while (0)
#define ATT_COMPUTE(buf) do { const LAS unsigned char* kb = lds + (buf) * ABUF; LAS unsigned char* vb = lds + (buf) * ABUF + KBYTES; \
            _Pragma("unroll") for (int kbk = 0; kbk < 2; ++kbk) { \
                f32x16 s; \
                _Pragma("unroll") for (int i = 0; i < 16; ++i) s[i] = 0.f; \
                _Pragma("unroll") for (int kk = 0; kk < 4; ++kk) { const bf16x8 a = *(const LAS bf16x8*)(kb + (kbk * 32 + r) * KROW + hf * 128 + kk * 32 + h * 16); s = MFMA32(a, qf[kk], s); } \
                float ls = 0.f; \
                _Pragma("unroll") for (int i = 0; i < 16; ++i) { s[i] = __builtin_amdgcn_exp2f(s[i]); ls += s[i]; } \
                lsum += ls; \
                bf16x8 pf[2]; \
                _Pragma("unroll") for (int st = 0; st < 2; ++st) { u32x4 w; w.x = pk2(s[8 * st], s[8 * st + 1]); w.y = pk2(s[8 * st + 2], s[8 * st + 3]); w.z = pk2(s[8 * st + 4], s[8 * st + 5]); w.w = pk2(s[8 * st + 6], s[8 * st + 7]); \
                    pf[st] = __builtin_bit_cast(bf16x8, w); } \
                _Pragma("unroll") for (int st = 0; st < 2; ++st) \
                    _Pragma("unroll") for (int eb = 0; eb < 4; ++eb) { \
                        const s16x4 vlo = __builtin_amdgcn_ds_read_tr16_b64_v4i16((LAS s16x4*)(vb + vtr + (kbk * 32 + st * 16) * VROW + eb * 64)); \
                        const s16x4 vhi = __builtin_amdgcn_ds_read_tr16_b64_v4i16((LAS s16x4*)(vb + vtr + (kbk * 32 + st * 16 + 8) * VROW + eb * 64)); \
                        const bf16x8 vf = __builtin_shufflevector(vlo, vhi, 0, 1, 2, 3, 4, 5, 6, 7); \
                        o[eb] = MFMA32(vf, pf[st], o[eb]); } \
            } } while (0)
        ATT_WRITE(krA, vrA, 0);
        ATT_LOAD(krA, vrA, 2);
        __syncthreads();
#pragma unroll 1
        for (int t = 0; t < SEQ / 64; t += 2) {
            ATT_COMPUTE(0);
            ATT_WRITE(krB, vrB, 1);
            if (t + 3 < SEQ / 64) ATT_LOAD(krB, vrB, t + 3);
            __syncthreads();
            ATT_COMPUTE(1);
            if (t + 2 < SEQ / 64) { ATT_WRITE(krA, vrA, 0);
                if (t + 4 < SEQ / 64) ATT_LOAD(krA, vrA, t + 4); }
            __syncthreads();
        }
#undef ATT_COMPUTE
        bf16_t* orow = MIX + qtok * DM + 512 + head * 128;
        if (it + G < NB * 4 * 16) { ATT_ITEM_PTRS(it + G); ATT_ITEM_PREFETCH(); }
        const float lt = lsum + __shfl_xor(lsum, 32);
        if (hf == 1) {
            const float sc1 = lam / lt;
#pragma unroll
            for (int eb = 0; eb < 4; ++eb)
#pragma unroll
                for (int i = 0; i < 16; ++i) X[(eb * 32 + (i & 3) + 8 * (i >> 2) + 4 * h) * 32 + r] = o[eb][i] * sc1;
        }
        __syncthreads();
        if (hf == 0) {
            const float i0 = 1.0f / lt;
            float ss = 0.f;
#pragma unroll
            for (int eb = 0; eb < 4; ++eb)
#pragma unroll
                for (int i = 0; i < 16; ++i) { const float v = o[eb][i] * i0 - X[(eb * 32 + (i & 3) + 8 * (i >> 2) + 4 * h) * 32 + r]; o[eb][i] = v; ss += v * v; }
            ss += __shfl_xor(ss, 32);
            const float rn = rsqrtf(ss * (1.f / 128.f) + EPS) * oscale;
#pragma unroll
            for (int eb = 0; eb < 4; ++eb)
#pragma unroll
                for (int g4 = 0; g4 < 4; ++g4) { const int e = eb * 32 + 8 * g4 + 4 * h;
                    const f32x4 gg = *(const f32x4*)(p.attn_norm_g + l * 128 + e);
                    u32x2 w; w.x = pk2(o[eb][4 * g4] * rn * gg[0], o[eb][4 * g4 + 1] * rn * gg[1]); w.y = pk2(o[eb][4 * g4 + 2] * rn * gg[2], o[eb][4 * g4 + 3] * rn * gg[3]);
                    *(u32x2*)(orow + e) = w; }
        }
        __syncthreads();
    }
#undef ATT_WRITE
#undef ATT_LOAD
#undef ATT_ITEM_PTRS
#undef ATT_ITEM_PREFETCH
}

#define XB_TMO      128
#define XB_XCNT(j)  (256  + 64 * (j))
#define XB_XSUB(j)  (1280 + 64 * (j))
#define XB_XGEN(j)  (2304 + 64 * (j))
#define XB_TOP      3328
#define XB_TOPGEN   3392
#define XCD_BAR_WORDS 3456
#define XB_SPIN_CAP (1u << 20)
DI unsigned xb_ld(unsigned* p)              { return __hip_atomic_load(p, __ATOMIC_RELAXED, __HIP_MEMORY_SCOPE_AGENT); }
DI unsigned xb_add(unsigned* p, unsigned v) { return __hip_atomic_fetch_add(p, v, __ATOMIC_RELAXED, __HIP_MEMORY_SCOPE_AGENT); }
DI unsigned xb_xcc_id() { return (unsigned)__builtin_amdgcn_s_getreg((3 << 11) | 20) & 0xFu; }
#define XB_SPIN(cond, bar) do { unsigned _sp = 0; while (cond) { __builtin_amdgcn_s_sleep(1); \
    if ((++_sp & 255u) == 0u) { if (xb_ld(&(bar)[XB_TMO])) break; if (_sp > XB_SPIN_CAP) { atomicAdd(&(bar)[XB_TMO], 1u); break; } } } } while (0)
struct XcdBarrier { unsigned* bar; unsigned x; volatile LAS unsigned* st; };
DI XcdBarrier xcd_barrier_post(unsigned* bar, volatile LAS unsigned* st) {
    XcdBarrier b; b.bar = bar; b.x = xb_xcc_id(); b.st = st;
    if (threadIdx.x == 0) (void)xb_add(&bar[XB_XCNT(b.x)], 1u);
    return b;
}
DI void xcd_barrier_complete(unsigned* bar, unsigned x, unsigned& nloc, unsigned& nx) {
    const unsigned G = gridDim.x * gridDim.y * gridDim.z;
    unsigned sum, cnt, mine, sp = 0u;
    for (;;) {
        sum = 0u; cnt = 0u; mine = 0u;
#pragma unroll
        for (unsigned j = 0; j < 16; ++j) { const unsigned c = xb_ld(&bar[XB_XCNT(j)]); sum += c; cnt += (c > 0u) ? 1u : 0u; mine = (j == x) ? c : mine; }
        if (sum == G) break;
        __builtin_amdgcn_s_sleep(1);
        if ((++sp & 255u) == 0u) { if (xb_ld(&bar[XB_TMO])) break; if (sp > XB_SPIN_CAP) { atomicAdd(&bar[XB_TMO], 1u); break; } }
    }
    nloc = mine > 0u ? mine : 1u; nx = cnt > 0u ? cnt : 1u;
}
DI void xcd_barrier(const XcdBarrier& b) {
    asm volatile("s_waitcnt vmcnt(0)" ::: "memory");
    __syncthreads();
    if (threadIdx.x == 0) {
        unsigned* bar = b.bar;
        __builtin_amdgcn_s_waitcnt(0);
        unsigned nloc = b.st[0], nx = b.st[1];
        if (nloc == 0u) { xcd_barrier_complete(bar, b.x, nloc, nx); b.st[0] = nloc; b.st[1] = nx; }
        const unsigned old = xb_add(&bar[XB_XSUB(b.x)], 1u);
        const unsigned gen = old / nloc;
        if (old + 1u == (gen + 1u) * nloc) {
            __builtin_amdgcn_fence(__ATOMIC_RELEASE, "agent");
            asm volatile("s_waitcnt vmcnt(0)" ::: "memory");
            const unsigned og = xb_add(&bar[XB_TOP], 1u);
            const unsigned tg = og / nx;
            if (og + 1u == (tg + 1u) * nx) xb_add(&bar[XB_TOPGEN], 1u);
            else XB_SPIN(xb_ld(&bar[XB_TOPGEN]) == tg, bar);
            __builtin_amdgcn_fence(__ATOMIC_ACQUIRE, "agent");
            xb_add(&bar[XB_XGEN(b.x)], 1u);
            asm volatile("s_waitcnt vmcnt(0)" ::: "memory");
        } else {
            XB_SPIN(xb_ld(&bar[XB_XGEN(b.x)]) == gen, bar);
            __builtin_amdgcn_fence(__ATOMIC_ACQUIRE, "agent");
            asm volatile("s_waitcnt vmcnt(0)" ::: "memory");
        }
    }
    __syncthreads();
}

__global__ void __launch_bounds__(512, 2) fwd_megakernel(Params p) {
    extern __shared__ __attribute__((aligned(16))) unsigned char shm[];
    LAS unsigned char* lds = (LAS unsigned char*)shm;
    cg::grid_group grid = cg::this_grid();
    const int G = gridDim.x, c = blockIdx.x;
    float* mod = (float*)(p.ws + WS_MOD);
    bf16_t* H = (bf16_t*)(p.ws + WS_H); bf16_t* Zb = (bf16_t*)(p.ws + WS_Z); bf16_t* MIX = (bf16_t*)(p.ws + WS_MIX);
    volatile LAS unsigned* bst = (volatile LAS unsigned*)(lds + 131072);
    if (threadIdx.x < 4) bst[threadIdx.x] = 0u;
    __syncthreads();
    const XcdBarrier xb = xcd_barrier_post((unsigned*)(p.ws + WS_BAR), bst);
    float* rowss = (float*)(p.ws + WS_ROWSS);
    for (int ph = p.ph_lo; ph < p.ph_hi; ++ph) {
        if (ph > p.ph_lo) { if (ph == p.ph_lo + 1) grid.sync(); else xcd_barrier(xb); }
        if (ph == 0) { phase0(p, lds); continue; }
        if (ph == 1) { phase_pre(p); continue; }
        const int l = (ph - 2) / 5, s5 = (ph - 2) % 5, sub = s5 + (s5 >= 2 ? 1 : 0);
        const float* modl = mod + (size_t)l * NB * MODW;
        float* rs1 = rowss + (size_t)(2 * l) * MTOK * 16; float* rs2 = rs1 + (size_t)MTOK * 16;
        const float* gml = (const float*)(p.ws + WS_GM) + (size_t)l * 2 * NB * DM;
        if (sub == 0) { pg8::StaticOrder S; S.init(MTOK, INW, G, c); pg8::Gemm g{H, (const bf16_t*)(p.ws + WS_WT_IN) + (size_t)l * INW * DM, MTOK, INW, DM};
            pg8::EpiZ E{Zb, INW, rs1, (const float*)(p.ws + WS_SHW_IN) + (size_t)l * NB * INW, (bf16_t*)(p.ws + WS_QH), (bf16_t*)(p.ws + WS_KH), p.q_norm_g + l * 64, p.k_norm_g + l * 64, (const float*)(p.ws + WS_ROPE), (const float*)(p.ws + WS_ROPE) + SEQ * 32}; pg8::gemm_phase(lds, g, S, E); }
        else if (sub == 1) { phase_prep(p, l, lds); const float lambda_init = 0.8f - 0.6f * expf(-0.3f * (float)l); phase_attn(p, l, lambda_init, lds); }
        else if (sub == 3 || sub == 5) {
            pg8::StaticOrder S; S.init(MTOK, DM, G, c);
            pg8::Gemm g; pg8::EpiRes E;
            _Float16* X16 = (_Float16*)(p.ws + WS_X16);
            if (sub == 3) { g = pg8::Gemm{MIX, (const bf16_t*)(p.ws + WS_WT_OUT) + (size_t)l * DM * DM, MTOK, DM, DM}; E = pg8::EpiRes{X16, X16, nullptr, modl + 2 * DM, gml + NB * DM, H, rs2}; }
            else { const bool lastl = (l == NL - 1);
                g = pg8::Gemm{Zb, (const bf16_t*)(p.ws + WS_WT_DN) + (size_t)l * DM * DFF, MTOK, DM, DFF};
                E = pg8::EpiRes{X16, X16, lastl ? p.out : nullptr, modl + 5 * DM, lastl ? nullptr : gml + 2 * NB * DM, H, lastl ? nullptr : rs1 + (size_t)2 * MTOK * 16}; }
            pg8::gemm_phase(lds, g, S, E); }
        else { pg8::StaticOrder S; S.init(MTOK, GU, G, c); pg8::Gemm g{H, (const bf16_t*)(p.ws + WS_WT_GU) + (size_t)l * GU * DM, MTOK, GU, DM};
            pg8::EpiSwiGLU E{Zb, rs2, (const float*)(p.ws + WS_SHW_GU) + (size_t)l * NB * GU}; pg8::gemm_phase(lds, g, S, E); }
    }
}

extern "C" void kernel_launch(void* const* d_in, const int* in_sizes, int n_in, void* d_out, int out_size, void* d_ws, size_t ws_size, hipStream_t stream) {
    static int grid = 0;
    if (grid == 0) {
        if (n_in != 23 || ws_size < WS_END) { fprintf(stderr, "kernel_launch: unexpected n_in %d or ws_size %zu < %zu\n", n_in, ws_size, (size_t)WS_END); grid = -1; return; }
        int dev = 0, cus = 0, per_cu = 0;
        if (hipGetDevice(&dev) != hipSuccess || hipDeviceGetAttribute(&cus, hipDeviceAttributeMultiprocessorCount, dev) != hipSuccess) { grid = -1; return; }
        if (hipFuncSetAttribute((const void*)fwd_megakernel, hipFuncAttributeMaxDynamicSharedMemorySize, LDS_BYTES) != hipSuccess) { fprintf(stderr, "kernel_launch: hipFuncSetAttribute failed\n"); grid = -1; return; }
        if (hipOccupancyMaxActiveBlocksPerMultiprocessor(&per_cu, (const void*)fwd_megakernel, 512, LDS_BYTES) != hipSuccess || per_cu < 1) { fprintf(stderr, "kernel_launch: occupancy query says %d\n", per_cu); per_cu = 1; }
        (void)hipGetLastError();
        grid = cus;
    }
    if (grid < 0) return;
    if (hipMemsetAsync((char*)d_ws + WS_BAR, 0, 16384, stream) != hipSuccess) { fprintf(stderr, "kernel_launch: memset of the barrier word failed\n"); return; }
    Params p{};
    p.x = (const float*)d_in[0]; p.c = (const float*)d_in[1]; p.pos = (const int*)d_in[2];
    p.norm1_g = (const float*)d_in[3]; p.norm2_g = (const float*)d_in[4]; p.w_ada = (const float*)d_in[5]; p.b_ada = (const float*)d_in[6];
    p.w_in = (const float*)d_in[7]; p.conv_a_w = (const float*)d_in[8]; p.conv_a_b = (const float*)d_in[9]; p.conv_a_norm_g = (const float*)d_in[10];
    p.conv_b_w = (const float*)d_in[11]; p.sc_norm_g = (const float*)d_in[12]; p.q_norm_g = (const float*)d_in[13]; p.k_norm_g = (const float*)d_in[14];
    p.lam_q1 = (const float*)d_in[15]; p.lam_k1 = (const float*)d_in[16]; p.lam_q2 = (const float*)d_in[17]; p.lam_k2 = (const float*)d_in[18];
    p.attn_norm_g = (const float*)d_in[19]; p.w_out = (const float*)d_in[20]; p.w_gate_up = (const float*)d_in[21]; p.w_down = (const float*)d_in[22];
    p.out = (float*)d_out; p.ws = (unsigned char*)d_ws;
#if MK_MULTI
    for (int ph = 0; ph < NPHASE; ++ph) {
        p.ph_lo = ph; p.ph_hi = ph + 1;
        hipLaunchKernelGGL(fwd_megakernel, dim3(grid), dim3(512), LDS_BYTES, stream, p);
    }
#else
    p.ph_lo = 0; p.ph_hi = NPHASE;
    void* args[] = {&p};
    hipError_t e = hipLaunchCooperativeKernel((const void*)fwd_megakernel, dim3(grid), dim3(512), args, LDS_BYTES, stream);
    if (e != hipSuccess) fprintf(stderr, "kernel_launch: cooperative launch failed: %s (grid %d)\n", hipGetErrorString(e), grid);
#endif
}
```

```cpp
#include <hip/hip_runtime.h>
#include <hip/hip_cooperative_groups.h>
#include <cstdio>
namespace cg = cooperative_groups;

#ifndef MK_MULTI
#define MK_MULTI 0
#endif

#define LAS __attribute__((address_space(3)))
#define DI __device__ __forceinline__
typedef unsigned short bf16_t;
typedef short bf16x8 __attribute__((ext_vector_type(8)));
typedef float f32x4 __attribute__((ext_vector_type(4)));
typedef float f32x2 __attribute__((ext_vector_type(2)));
typedef float f32x16 __attribute__((ext_vector_type(16)));
typedef unsigned u32x4 __attribute__((ext_vector_type(4)));
typedef unsigned u32x2 __attribute__((ext_vector_type(2)));
typedef __bf16 bf16x2n __attribute__((ext_vector_type(2)));
typedef _Float16 h16x8 __attribute__((ext_vector_type(8)));
typedef _Float16 h16x4 __attribute__((ext_vector_type(4)));
typedef float f32x8 __attribute__((ext_vector_type(8)));

constexpr int NB = 32, SEQ = 2048, DM = 1024, MTOK = NB * SEQ, NL = 4, INW = 2816, DFF = 2816, GU = 2 * DFF;
constexpr int MODW = 6 * DM;
constexpr float EPS = 1e-6f;
constexpr float LOG2E = 1.4426950408889634f;
constexpr int LDS_BYTES = 131072 + 16;
constexpr int NPHASE = 2 + 5 * NL;

constexpr size_t WS_WT_IN = 0;
constexpr size_t WS_WT_OUT = WS_WT_IN + (size_t)NL * INW * DM * 2;
constexpr size_t WS_WT_GU = WS_WT_OUT + (size_t)NL * DM * DM * 2;
constexpr size_t WS_WT_DN = WS_WT_GU + (size_t)NL * GU * DM * 2;
constexpr size_t WS_MOD = WS_WT_DN + (size_t)NL * DM * DFF * 2;
constexpr size_t WS_ROPE = WS_MOD + (size_t)NL * NB * MODW * 4;
constexpr size_t WS_H = WS_ROPE + (size_t)2 * SEQ * 32 * 4;
constexpr size_t WS_Z = WS_H + (size_t)MTOK * DM * 2;
constexpr size_t WS_QH = WS_Z + (size_t)MTOK * INW * 2;
constexpr size_t WS_KH = WS_QH + (size_t)MTOK * 512 * 2;
constexpr size_t WS_MIX = WS_KH + (size_t)MTOK * 512 * 2;
constexpr size_t WS_ROWSS = WS_MIX + (size_t)MTOK * DM * 2;
constexpr size_t WS_SHW_IN = WS_ROWSS + (size_t)NL * 2 * MTOK * 16 * 4;
constexpr size_t WS_SHW_GU = WS_SHW_IN + (size_t)NL * NB * INW * 4;
constexpr size_t WS_GM = WS_SHW_GU + (size_t)NL * NB * GU * 4;
constexpr size_t WS_X16 = WS_GM + (size_t)NL * 2 * NB * DM * 4;
constexpr size_t WS_BAR = WS_X16 + (size_t)MTOK * DM * 2;
constexpr size_t WS_END = WS_BAR + 16384;

struct Params {
    const float* x; const float* c; const int* pos;
    const float *norm1_g, *norm2_g, *w_ada, *b_ada, *w_in, *conv_a_w, *conv_a_b, *conv_a_norm_g, *conv_b_w, *sc_norm_g,
        *q_norm_g, *k_norm_g, *lam_q1, *lam_k1, *lam_q2, *lam_k2, *attn_norm_g, *w_out, *w_gate_up, *w_down;
    float* out; unsigned char* ws;
    int ph_lo, ph_hi;
};

DI unsigned pk2(float lo, float hi) { f32x2 v = {lo, hi}; return __builtin_bit_cast(unsigned, __builtin_convertvector(v, bf16x2n)); }
DI float bf_lo(unsigned u) { return __uint_as_float(u << 16); }
DI float bf_hi(unsigned u) { return __uint_as_float(u & 0xffff0000u); }
DI float wave_sum(float v) {
#pragma unroll
    for (int o = 1; o < 64; o <<= 1) v += __shfl_xor(v, o);
    return v;
}
DI float wave_max(float v) {
#pragma unroll
    for (int o = 1; o < 64; o <<= 1) v = fmaxf(v, __shfl_xor(v, o));
    return v;
}
DI int opq(int v) { asm volatile("" : "+v"(v)); return v; }
DI float sigmoidf_fast(float v) { return __builtin_amdgcn_rcpf(1.0f + __builtin_amdgcn_exp2f(-v * LOG2E)); }

namespace pg8 {
constexpr int BM = 256, BK = 64, HALF = 128, HTB = HALF * BK * 2, NXCD = 8, WGM = 8;
DI int lds_byte(int r, int c) { const int st = (r >> 4) * 2 + (c >> 5), rr = r & 15, cc = c & 31, ob = rr * 64 + cc * 2; return st * 1024 + (ob ^ (((ob >> 9) & 1) << 5)); }
DI void stage_rc(int b, int& R, int& C) { const int st = b / 1024, sb = b % 1024, swz = sb ^ (((sb >> 9) & 1) << 5); R = (st >> 1) * 16 + swz / 64; C = (st & 1) * 32 + (swz % 64) / 2; }
DI int perm32(int rho) { const int n = rho >> 4, i = rho & 15; return 8 * (i >> 2) + 4 * n + (i & 3); }
struct Unit { int pm, pn; };
struct Gemm { const bf16_t* A; const bf16_t* Bt; int M, N, K; };
struct StaticOrder {
    int nM, nN, nwg, G, c;
    DI void init(int M, int N, int G_, int c_) { nM = M / BM; nN = N / BM; nwg = nM * nN; G = G_; c = c_; }
    DI bool next(int i, Unit& u) const {
        const long L = (long)i * G + c; if (L >= nwg) return false;
        int wgid = (int)L; { const int q = nwg / NXCD, r = nwg % NXCD, xcd = wgid % NXCD, off = wgid / NXCD; wgid = (xcd < r ? xcd * (q + 1) : r * (q + 1) + (xcd - r) * q) + off; }
        const int nig = WGM * nN, gid = wgid / nig, fm = gid * WGM, gsz = (nM - fm) < WGM ? (nM - fm) : WGM;
        u.pm = fm + ((wgid % nig) % gsz); u.pn = (wgid % nig) / gsz; return true;
    }
};

DI void row_rstd8(const float* rowss, int row0, int fq, float (&rstd)[2][4]) {
    f32x4 pr[2][4];
#pragma unroll
    for (int ai = 0; ai < 2; ++ai)
#pragma unroll
        for (int m = 0; m < 4; ++m) pr[ai][m] = *(const f32x4*)(rowss + (size_t)(row0 + ai * HALF + m * 16) * 16 + 4 * fq);
#pragma unroll
    for (int ai = 0; ai < 2; ++ai)
#pragma unroll
        for (int m = 0; m < 4; ++m) { float t = (pr[ai][m][0] + pr[ai][m][1]) + (pr[ai][m][2] + pr[ai][m][3]);
            t += __shfl_xor(t, 16); t += __shfl_xor(t, 32);
            rstd[ai][m] = rsqrtf(t * (1.f / DM) + EPS); }
}
struct EpiZ {
    static constexpr bool PERM = true;
    bf16_t* O; int ldc; const float* rowss; const float* shw;
    bf16_t* QH; bf16_t* KH; const float* gq; const float* gk; const float* rc; const float* rs;
    DI void operator()(const f32x4 (&acc)[2][2][4][2], const Unit& u, int wr, int wc, int fr, int fq) const {
        const int row0 = u.pm * BM + wr * 64 + fr, col0 = u.pn * BM + wc * 32 + 8 * fq, b = (u.pm * BM) / SEQ;
        float rstd8[2][4]; row_rstd8(rowss, row0, fq, rstd8);
        const float* svp = shw + (size_t)b * ldc + col0;
        if (u.pn < 5 || u.pn > 8) {
            f32x4 sv[2][2];
#pragma unroll
            for (int bj = 0; bj < 2; ++bj)
#pragma unroll
                for (int n = 0; n < 2; ++n) sv[bj][n] = *(const f32x4*)(svp + bj * HALF + 4 * n);
#pragma unroll
            for (int ai = 0; ai < 2; ++ai)
#pragma unroll
                for (int m = 0; m < 4; ++m) { const int row = row0 + ai * HALF + m * 16; bf16_t* rowp = O + (size_t)row * ldc + col0;
                    const float rstd = rstd8[ai][m];
#pragma unroll
                    for (int bj = 0; bj < 2; ++bj) { const f32x4 v0 = acc[ai][bj][m][0] * rstd + sv[bj][0], v1 = acc[ai][bj][m][1] * rstd + sv[bj][1];
                        u32x4 w; w.x = pk2(v0[0], v0[1]); w.y = pk2(v0[2], v0[3]); w.z = pk2(v1[0], v1[1]); w.w = pk2(v1[2], v1[3]);
                        *(u32x4*)(rowp + bj * HALF) = w; } }
        } else {
            const int gi = (u.pn - 5) * 4 + wc, isk = gi >> 3, hd = (gi >> 1) & 3, hfh = gi & 1;
            const float* gg = isk ? gk : gq; bf16_t* dst = (isk ? KH : QH) + hd * 128 + hfh * 64 + 4 * fq;
            const float qs = isk ? 1.0f : LOG2E * 0.125f;
#pragma unroll
            for (int ai = 0; ai < 2; ++ai)
#pragma unroll
                for (int m = 0; m < 4; ++m) { const int row = row0 + ai * HALF + m * 16, spos = row & (SEQ - 1);
                    const float rstd = rstd8[ai][m];
                    f32x4 lo[2], hi[2]; float ss = 0.f;
#pragma unroll
                    for (int bj = 0; bj < 2; ++bj) { const f32x4 v0 = acc[ai][bj][m][0] * rstd + *(const f32x4*)(svp + bj * HALF), v1 = acc[ai][bj][m][1] * rstd + *(const f32x4*)(svp + bj * HALF + 4);
                        lo[bj] = (f32x4){v0[0], v0[2], v1[0], v1[2]}; hi[bj] = (f32x4){v0[1], v0[3], v1[1], v1[3]};
                        ss += ((v0[0] * v0[0] + v0[1] * v0[1]) + (v0[2] * v0[2] + v0[3] * v0[3])) + ((v1[0] * v1[0] + v1[1] * v1[1]) + (v1[2] * v1[2] + v1[3] * v1[3])); }
                    ss += __shfl_xor(ss, 16); ss += __shfl_xor(ss, 32);
                    const float rg = rsqrtf(ss * (1.f / 64.f) + EPS) * qs;
#pragma unroll
                    for (int bj = 0; bj < 2; ++bj) {
                        const f32x4 glo = *(const f32x4*)(gg + bj * 16 + fq * 4), ghi = *(const f32x4*)(gg + 32 + bj * 16 + fq * 4);
                        const f32x4 c4 = *(const f32x4*)(rc + spos * 32 + bj * 16 + fq * 4), s4 = *(const f32x4*)(rs + spos * 32 + bj * 16 + fq * 4);
                        const f32x4 a = lo[bj] * rg * glo, bb = hi[bj] * rg * ghi;
                        const f32x4 olo = a * c4 - bb * s4, ohi = bb * c4 + a * s4;
                        u32x2 w0, w1; w0.x = pk2(olo[0], olo[1]); w0.y = pk2(olo[2], olo[3]); w1.x = pk2(ohi[0], ohi[1]); w1.y = pk2(ohi[2], ohi[3]);
                        *(u32x2*)(dst + (size_t)row * 512 + bj * 16) = w0; *(u32x2*)(dst + (size_t)row * 512 + 32 + bj * 16) = w1; }
                    asm volatile("" ::: "memory"); }
        }
    }
};
struct EpiRes {
    static constexpr bool PERM = true;
    const _Float16* xin; _Float16* xout; float* xout32; const float* gate; const float* gm; bf16_t* Hout; float* rowss_out;
    DI void operator()(const f32x4 (&acc)[2][2][4][2], const Unit& u, int wr, int wc, int fr, int fq) const {
        const int row0 = u.pm * BM + wr * 64 + fr, col0 = u.pn * BM + wc * 32 + 8 * fq, b = (u.pm * BM) / SEQ;
        const bool nxt = gm != nullptr, o32 = xout32 != nullptr;
        f32x4 gv[2][2], gmv[2][2];
#pragma unroll
        for (int bj = 0; bj < 2; ++bj)
#pragma unroll
            for (int n = 0; n < 2; ++n) { gv[bj][n] = *(const f32x4*)(gate + (size_t)b * MODW + col0 + bj * HALF + 4 * n);
                gmv[bj][n] = nxt ? *(const f32x4*)(gm + (size_t)b * DM + col0 + bj * HALF + 4 * n) : (f32x4){0.f, 0.f, 0.f, 0.f}; }
        h16x8 xv[4][2];
#define ER_LOAD(rnd) do { const size_t off_ = (size_t)(row0 + ((rnd) >> 2) * HALF + ((rnd) & 3) * 16) * DM + col0; \
            _Pragma("unroll") for (int bj = 0; bj < 2; ++bj) xv[(rnd) & 3][bj] = *(const h16x8*)(xin + off_ + bj * HALF); } while (0)
        ER_LOAD(0); ER_LOAD(1); ER_LOAD(2);
        float ssum[4] = {0.f, 0.f, 0.f, 0.f};
#pragma unroll
        for (int rnd = 0; rnd < 8; ++rnd) {
            const int ai = rnd >> 2, m = rnd & 3;
            const size_t off = (size_t)(row0 + ai * HALF + m * 16) * DM + col0;
            f32x4 x0[2], x1[2];
#pragma unroll
            for (int bj = 0; bj < 2; ++bj) { const f32x8 xf = __builtin_convertvector(xv[rnd & 3][bj], f32x8);
                x0[bj] = (f32x4){xf[0], xf[1], xf[2], xf[3]} + gv[bj][0] * acc[ai][bj][m][0]; x1[bj] = (f32x4){xf[4], xf[5], xf[6], xf[7]} + gv[bj][1] * acc[ai][bj][m][1]; }
            if (rnd + 3 < 8) ER_LOAD(rnd + 3);
#pragma unroll
            for (int bj = 0; bj < 2; ++bj) {
                if (o32) { *(f32x4*)(xout32 + off + bj * HALF) = x0[bj]; *(f32x4*)(xout32 + off + bj * HALF + 4) = x1[bj]; }
                else { const f32x8 xf = {x0[bj][0], x0[bj][1], x0[bj][2], x0[bj][3], x1[bj][0], x1[bj][1], x1[bj][2], x1[bj][3]};
                    *(h16x8*)(xout + off + bj * HALF) = __builtin_convertvector(xf, h16x8); }
                if (nxt) {
                    ssum[m] += ((x0[bj][0] * x0[bj][0] + x0[bj][1] * x0[bj][1]) + (x0[bj][2] * x0[bj][2] + x0[bj][3] * x0[bj][3])) + ((x1[bj][0] * x1[bj][0] + x1[bj][1] * x1[bj][1]) + (x1[bj][2] * x1[bj][2] + x1[bj][3] * x1[bj][3]));
                    const f32x4 h0 = x0[bj] * gmv[bj][0], h1 = x1[bj] * gmv[bj][1];
                    u32x4 w; w.x = pk2(h0[0], h0[1]); w.y = pk2(h0[2], h0[3]); w.z = pk2(h1[0], h1[1]); w.w = pk2(h1[2], h1[3]);
                    *(u32x4*)(Hout + off + bj * HALF) = w; } }
            asm volatile("" ::: "memory");
            if (nxt && m == 3) {
                const bool hi2 = (fq & 2) != 0, hi1 = (fq & 1) != 0;
                const float t0 = hi2 ? ssum[0] : ssum[2], t1 = hi2 ? ssum[1] : ssum[3], k0 = hi2 ? ssum[2] : ssum[0], k1 = hi2 ? ssum[3] : ssum[1];
                const float a0 = k0 + __shfl_xor(t0, 32), a1 = k1 + __shfl_xor(t1, 32);
                const float t = hi1 ? a0 : a1, k = hi1 ? a1 : a0;
                const float rsum = k + __shfl_xor(t, 16);
                rowss_out[(size_t)(u.pm * BM + ai * HALF + wr * 64 + fq * 16 + fr) * 16 + u.pn * 4 + wc] = rsum;
#pragma unroll
                for (int i = 0; i < 4; ++i) ssum[i] = 0.f;
            }
        }
#undef ER_LOAD
    }
};
struct EpiSwiGLU {
    static constexpr bool PERM = true;
    bf16_t* O; const float* rowss; const float* shw;
    DI void operator()(const f32x4 (&acc)[2][2][4][2], const Unit& u, int wr, int wc, int fr, int fq) const {
        const int row0 = u.pm * BM + wr * 64 + fr, colh = u.pn * 128 + wc * 16 + 4 * fq, b = (u.pm * BM) / SEQ;
        f32x4 sv[2][2];
#pragma unroll
        for (int bj = 0; bj < 2; ++bj)
#pragma unroll
            for (int n = 0; n < 2; ++n) sv[bj][n] = *(const f32x4*)(shw + (size_t)b * GU + 2 * colh + bj * HALF + 4 * n);
        float rstd8[2][4]; row_rstd8(rowss, row0, fq, rstd8);
#pragma unroll
        for (int ai = 0; ai < 2; ++ai)
#pragma unroll
            for (int m = 0; m < 4; ++m) { const int row = row0 + ai * HALF + m * 16; bf16_t* rowp = O + (size_t)row * DFF + colh;
                const float rstd = rstd8[ai][m];
#pragma unroll
                for (int bj = 0; bj < 2; ++bj) { const f32x4 g = acc[ai][bj][m][0] * rstd + sv[bj][0], uu = acc[ai][bj][m][1] * rstd + sv[bj][1];
                    float a[4];
#pragma unroll
                    for (int i = 0; i < 4; ++i) a[i] = g[i] * sigmoidf_fast(g[i]) * uu[i];
                    u32x2 w; w.x = pk2(a[0], a[1]); w.y = pk2(a[2], a[3]);
                    *(u32x2*)(rowp + bj * 64) = w; } }
    }
};

template <class Epi, class Sched>
DI void gemm_phase(LAS unsigned char* lds, const Gemm g, const Sched& S, const Epi& E) {
    const int tid = opq(threadIdx.x), wid = __builtin_amdgcn_readfirstlane(tid >> 6), lane = tid & 63, wr = wid >> 2, wc = wid & 3, fr = lane & 15, fq = lane >> 4;
    const int K = g.K, nt = K / BK;
    unsigned voffA[2], voffB[2];
#pragma unroll
    for (int i = 0; i < 2; ++i) { int R, C; stage_rc(tid * 16 + i * 8192, R, C); const int Rb = Epi::PERM ? ((R & ~31) + perm32(R & 31)) : R;
        voffA[i] = (unsigned)(R * K + C) * 2u; voffB[i] = (unsigned)(Rb * K + C) * 2u; }
    const size_t kstep = (size_t)(BK * 2);
    const size_t hstep = (size_t)HALF * K * 2;
    const size_t tstep = 2 * hstep;
    const unsigned ldsw = (unsigned)wid * 1024u;
    const int aoff = lds_byte(wr * 64 + fr, fq * 8), boff = lds_byte(wc * 32 + fr, fq * 8);
#define PG8_SA(b, h) (((b) * 2 + (h)) * HTB)
#define PG8_SB(b, h) ((4 + (b) * 2 + (h)) * HTB)
#define PG8_STAGE(bufoff, gbase, voff) do { _Pragma("unroll") for (int _i = 0; _i < 2; ++_i) \
        __builtin_amdgcn_global_load_lds((const unsigned*)((const char*)(gbase) + (voff)[_i]), (LAS unsigned*)(lds + (bufoff) + ldsw + _i * 8192), 16, 0, 0); } while (0)
#define PG8_LDA(dst, b, h) do { _Pragma("unroll") for (int m = 0; m < 4; ++m) _Pragma("unroll") for (int k = 0; k < 2; ++k) dst[m][k] = *(const LAS bf16x8*)(lds + PG8_SA(b, h) + aoff + m * 2048 + k * 1024); } while (0)
#define PG8_LDB(dst, b, h) do { _Pragma("unroll") for (int n = 0; n < 2; ++n) _Pragma("unroll") for (int k = 0; k < 2; ++k) dst[n][k] = *(const LAS bf16x8*)(lds + PG8_SB(b, h) + boff + n * 2048 + k * 1024); } while (0)
#define PG8_MMA(ai, bj, At, Bt) do { __builtin_amdgcn_s_setprio(1); _Pragma("unroll") for (int m = 0; m < 4; ++m) _Pragma("unroll") for (int n = 0; n < 2; ++n) _Pragma("unroll") for (int k = 0; k < 2; ++k) \
        acc[ai][bj][m][n] = __builtin_amdgcn_mfma_f32_16x16x32_bf16(Bt[n][k], At[m][k], acc[ai][bj][m][n], 0, 0, 0); __builtin_amdgcn_s_setprio(0); } while (0)
#define PG8_WAIT_V(n) asm volatile("s_waitcnt vmcnt(" #n ")" ::: "memory")
#define PG8_WAIT_L(n) asm volatile("s_waitcnt lgkmcnt(" #n ")" ::: "memory")
#define PG8_BAR __builtin_amdgcn_s_barrier()
#define PG8_SCHED __builtin_amdgcn_sched_barrier(0)
    Unit cur, nxt; int ui = 0;
    if (!S.next(0, cur)) return;
    f32x4 acc[2][2][4][2];
#pragma unroll
    for (int a = 0; a < 2; ++a)
#pragma unroll
        for (int b = 0; b < 2; ++b)
#pragma unroll
            for (int m = 0; m < 4; ++m)
#pragma unroll
                for (int n = 0; n < 2; ++n) acc[a][b][m][n] = (f32x4){0.f, 0.f, 0.f, 0.f};
    bf16x8 At[4][2], B0[2][2], B1[2][2];
    const char* cA = (const char*)g.A + (size_t)cur.pm * tstep; const char* cB = (const char*)g.Bt + (size_t)cur.pn * tstep;
    PG8_STAGE(PG8_SB(0, 0), cB, voffB); PG8_STAGE(PG8_SA(0, 0), cA, voffA); PG8_STAGE(PG8_SB(0, 1), cB + hstep, voffB); PG8_STAGE(PG8_SA(0, 1), cA + hstep, voffA);
    if (wr == 1) PG8_BAR;
    PG8_WAIT_V(4); PG8_BAR;
    PG8_STAGE(PG8_SB(1, 0), cB + kstep, voffB); PG8_STAGE(PG8_SA(1, 0), cA + kstep, voffA); PG8_STAGE(PG8_SB(1, 1), cB + hstep + kstep, voffB);
    PG8_WAIT_V(6); PG8_BAR;
    for (;;) {
        const bool has_next = S.next(ui + 1, nxt);
        const char* nA = has_next ? (const char*)g.A + (size_t)nxt.pm * tstep : cA; const char* nB = has_next ? (const char*)g.Bt + (size_t)nxt.pn * tstep : cB;
        for (int t = 0; t < nt; t += 2) {
            const bool last = (t == nt - 2);
            const char* a1 = cA + (size_t)(t + 1) * kstep;
            const char* a2 = last ? nA : cA + (size_t)(t + 2) * kstep; const char* b2 = last ? nB : cB + (size_t)(t + 2) * kstep;
            const char* a3 = a2 + kstep; const char* b3 = b2 + kstep;
            PG8_LDB(B0, 0, 0); PG8_SCHED; PG8_LDA(At, 0, 0); PG8_STAGE(PG8_SA(1, 1), a1 + hstep, voffA);
            PG8_WAIT_L(8); PG8_BAR; PG8_WAIT_L(0); PG8_MMA(0, 0, At, B0); PG8_BAR; PG8_SCHED;
            PG8_LDB(B1, 0, 1); PG8_STAGE(PG8_SB(0, 0), b2, voffB);
            PG8_BAR; PG8_WAIT_L(0); PG8_MMA(0, 1, At, B1); PG8_BAR;
            PG8_LDA(At, 0, 1); PG8_STAGE(PG8_SA(0, 0), a2, voffA);
            PG8_BAR; PG8_WAIT_L(0); PG8_MMA(1, 0, At, B0); PG8_BAR; PG8_SCHED;
            PG8_STAGE(PG8_SB(0, 1), b2 + hstep, voffB);
            PG8_WAIT_V(6); PG8_BAR; PG8_MMA(1, 1, At, B1); PG8_BAR;
            PG8_LDB(B0, 1, 0); PG8_SCHED; PG8_LDA(At, 1, 0); PG8_STAGE(PG8_SA(0, 1), a2 + hstep, voffA);
            PG8_WAIT_L(8); PG8_BAR; PG8_WAIT_L(0); PG8_MMA(0, 0, At, B0); PG8_BAR; PG8_SCHED;
            PG8_LDB(B1, 1, 1); PG8_STAGE(PG8_SB(1, 0), b3, voffB);
            PG8_BAR; PG8_WAIT_L(0); PG8_MMA(0, 1, At, B1); PG8_BAR;
            PG8_LDA(At, 1, 1); PG8_STAGE(PG8_SA(1, 0), a3, voffA);
            PG8_BAR; PG8_WAIT_L(0); PG8_MMA(1, 0, At, B0); PG8_BAR; PG8_SCHED;
            PG8_STAGE(PG8_SB(1, 1), b3 + hstep, voffB);
            PG8_WAIT_V(6); PG8_BAR; PG8_MMA(1, 1, At, B1); PG8_BAR;
        }
        E(acc, cur, wr, wc, fr, fq);
        if (!has_next) break;
#pragma unroll
        for (int a = 0; a < 2; ++a)
#pragma unroll
            for (int b = 0; b < 2; ++b)
#pragma unroll
                for (int m = 0; m < 4; ++m)
#pragma unroll
                    for (int n = 0; n < 2; ++n) acc[a][b][m][n] = (f32x4){0.f, 0.f, 0.f, 0.f};
        cur = nxt; cA = nA; cB = nB; ++ui;
    }
    PG8_WAIT_V(0);
    if (wr == 0) PG8_BAR;
    PG8_BAR;
#undef PG8_SA
#undef PG8_SB
#undef PG8_STAGE
#undef PG8_LDA
#undef PG8_LDB
#undef PG8_MMA
#undef PG8_WAIT_V
#undef PG8_WAIT_L
#undef PG8_BAR
#undef PG8_SCHED
}
}

template <int MODE>
DI int wrow_map(int n) {
    if (MODE == 0) return n;
    if (MODE == 2) { if (n < 1280 || n >= 2304) return n;
        const int gi = (n - 1280) >> 6, d = (n - 1280) & 63, hi = d >> 5, f = d & 31, bj = f >> 4, fq = (f >> 2) & 3, jj = f & 3;
        return 256 * (5 + (gi >> 2)) + 128 * bj + 32 * (gi & 3) + 8 * fq + 2 * jj + hi; }
    const int isu = n >= DFF ? 1 : 0, j = n - isu * DFF; return 8 * (j >> 2) + 4 * isu + (j & 3); }
template <int MODE>
DI void p0_transpose_item(const float* W, int K, int N, bf16_t* WT, LAS float* scr, int item, int lane) {
    const int nblk = N / 32, kb = item / nblk, nb = item % nblk, k0 = 64 * kb, n0 = 32 * nb;
    float wv[32];
#pragma unroll
    for (int i = 0; i < 32; ++i) wv[i] = W[(size_t)(k0 + 2 * i + (lane >> 5)) * N + n0 + (lane & 31)];
#pragma unroll
    for (int i = 0; i < 32; ++i) scr[(2 * i + (lane >> 5)) * 33 + (lane & 31)] = wv[i];
    asm volatile("s_waitcnt lgkmcnt(0)" ::: "memory");
    const int c = lane & 7;
#pragma unroll
    for (int j = 0; j < 4; ++j) { const int n = (lane >> 3) + 8 * j; const LAS float* s = scr + (8 * c) * 33 + n;
        u32x4 o; o.x = pk2(s[0 * 33], s[1 * 33]); o.y = pk2(s[2 * 33], s[3 * 33]); o.z = pk2(s[4 * 33], s[5 * 33]); o.w = pk2(s[6 * 33], s[7 * 33]);
        *(u32x4*)(WT + (size_t)wrow_map<MODE>(n0 + n) * K + k0 + 8 * c) = o; }
    asm volatile("s_waitcnt lgkmcnt(0)" ::: "memory");
}

DI void phase0(const Params& p, LAS unsigned char* lds) {
    const int tid = opq(threadIdx.x), lane = tid & 63, wave = tid >> 6, G = gridDim.x;
    {
        LAS float* cact = (LAS float*)lds;
        float* mod = (float*)(p.ws + WS_MOD);
        constexpr int NITEM = NL * (MODW / 64);
        for (int it = blockIdx.x; it < NITEM; it += G) {
            const int l = it / (MODW / 64), n0 = (it % (MODW / 64)) * 64;
            for (int idx = tid; idx < NB * DM; idx += 512) { const int k = idx >> 5, b = idx & 31; const float v = p.c[b * DM + k]; cact[idx] = v * sigmoidf_fast(v); }
            __syncthreads();
            float acc[32];
#pragma unroll
            for (int b = 0; b < 32; ++b) acc[b] = 0.f;
            const float* wp = p.w_ada + ((size_t)l * DM + 128 * wave) * MODW + n0 + lane;
            const LAS f32x4* cp = (const LAS f32x4*)(cact + (128 * wave) * 32);
#pragma unroll 1
            for (int kk0 = 0; kk0 < 128; kk0 += 32) {
                float wv[32];
#pragma unroll
                for (int i = 0; i < 32; ++i) wv[i] = wp[(size_t)(kk0 + i) * MODW];
#pragma unroll
                for (int i = 0; i < 32; ++i) {
#pragma unroll
                    for (int q = 0; q < 8; ++q) { const f32x4 cv = cp[(kk0 + i) * 8 + q]; acc[4 * q] += cv[0] * wv[i]; acc[4 * q + 1] += cv[1] * wv[i]; acc[4 * q + 2] += cv[2] * wv[i]; acc[4 * q + 3] += cv[3] * wv[i]; }
                }
            }
            __syncthreads();
            LAS float* red = (LAS float*)lds;
#pragma unroll
            for (int b = 0; b < 32; ++b) red[(wave * 32 + b) * 64 + lane] = acc[b];
            __syncthreads();
#pragma unroll
            for (int j = 0; j < 4; ++j) { const int o = tid + 512 * j, b = o >> 6, n = o & 63; float s = p.b_ada[l * MODW + n0 + n];
#pragma unroll
                for (int w = 0; w < 8; ++w) s += red[(w * 32 + b) * 64 + n];
                mod[((size_t)l * NB + b) * MODW + n0 + n] = s; }
            __syncthreads();
        }
    }
    {
        LAS float* scr = (LAS float*)(lds + wave * 16384);
        const int gw = blockIdx.x * 8 + wave, NGW = G * 8;
        constexpr int I_IN = (DM / 64) * (INW / 32), I_OUT = (DM / 64) * (DM / 32), I_GU = (DM / 64) * (GU / 32), I_DN = (DFF / 64) * (DM / 32);
        constexpr int PER_L = I_IN + I_OUT + I_GU + I_DN;
        for (int it = gw; it < NL * PER_L; it += NGW) {
            const int l = it / PER_L; int r = it % PER_L;
            if (r < I_IN) { p0_transpose_item<2>(p.w_in + (size_t)l * DM * INW, DM, INW, (bf16_t*)(p.ws + WS_WT_IN) + (size_t)l * INW * DM, scr, r, lane); continue; } r -= I_IN;
            if (r < I_OUT) { p0_transpose_item<0>(p.w_out + (size_t)l * DM * DM, DM, DM, (bf16_t*)(p.ws + WS_WT_OUT) + (size_t)l * DM * DM, scr, r, lane); continue; } r -= I_OUT;
            if (r < I_GU) { p0_transpose_item<1>(p.w_gate_up + (size_t)l * DM * GU, DM, GU, (bf16_t*)(p.ws + WS_WT_GU) + (size_t)l * GU * DM, scr, r, lane); continue; } r -= I_GU;
            p0_transpose_item<0>(p.w_down + (size_t)l * DFF * DM, DFF, DM, (bf16_t*)(p.ws + WS_WT_DN) + (size_t)l * DM * DFF, scr, r, lane);
        }
    }
    {
        float* rc = (float*)(p.ws + WS_ROPE); float* rs = rc + SEQ * 32;
        for (int idx = blockIdx.x * 512 + tid; idx < SEQ * 32; idx += G * 512) {
            const int s = idx >> 5, i = idx & 31;
            double inv = 1.0, bpow = 0.7498942093324559;
#pragma unroll
            for (int bit = 0; bit < 5; ++bit) { if ((i >> bit) & 1) inv *= bpow; bpow *= bpow; }
            const double rev = (double)p.pos[s] * inv * 0.15915494309189535;
            const float fr = (float)(rev - floor(rev));
            rc[idx] = __builtin_amdgcn_cosf(fr); rs[idx] = __builtin_amdgcn_sinf(fr);
        }
    }
}

DI void phase_pre(const Params& p) {
    const int tid = opq(threadIdx.x), lane = tid & 63, wave = tid >> 6, G = gridDim.x, NGW = G * 8, gw = blockIdx.x * 8 + wave;
    const float* mod = (const float*)(p.ws + WS_MOD);
    {
        const int r = lane & 31, h = lane >> 5;
        constexpr int NBLK_IN = INW / 32, NBLK_GU = GU / 32, PER_L = NBLK_IN + NBLK_GU;
        for (int it = gw; it < NL * PER_L; it += NGW) {
            const int l = it / PER_L, q = it % PER_L; const bool isgu = q >= NBLK_IN; const int nb = isgu ? q - NBLK_IN : q;
            const bf16_t* W = isgu ? (const bf16_t*)(p.ws + WS_WT_GU) + ((size_t)l * GU + nb * 32 + r) * DM : (const bf16_t*)(p.ws + WS_WT_IN) + ((size_t)l * INW + nb * 32 + r) * DM;
            const float* sh = mod + ((size_t)l * NB + r) * MODW + (isgu ? 3 * DM : 0);
            f32x16 acc;
#pragma unroll
            for (int i = 0; i < 16; ++i) acc[i] = 0.f;
#pragma unroll 8
            for (int ks = 0; ks < DM / 16; ++ks) {
                const int k0 = ks * 16 + h * 8;
                const bf16x8 bfrag = *(const bf16x8*)(W + k0);
                const f32x4 s0 = *(const f32x4*)(sh + k0), s1 = *(const f32x4*)(sh + k0 + 4);
                u32x4 a; a.x = pk2(s0[0], s0[1]); a.y = pk2(s0[2], s0[3]); a.z = pk2(s1[0], s1[1]); a.w = pk2(s1[2], s1[3]);
                acc = __builtin_amdgcn_mfma_f32_32x32x16_bf16(__builtin_bit_cast(bf16x8, a), bfrag, acc, 0, 0, 0);
            }
            float* o = isgu ? (float*)(p.ws + WS_SHW_GU) + (size_t)l * NB * GU : (float*)(p.ws + WS_SHW_IN) + (size_t)l * NB * INW;
            const int ld = isgu ? GU : INW;
#pragma unroll
            for (int i = 0; i < 16; ++i) o[(size_t)((i & 3) + 8 * (i >> 2) + 4 * h) * ld + nb * 32 + r] = acc[i];
        }
    }
    {
        float* gm = (float*)(p.ws + WS_GM);
        for (int idx = blockIdx.x * 512 + tid; idx < NL * 2 * NB * DM; idx += G * 512) {
            const int k = idx & 1023, b = (idx >> 10) & 31, sx = (idx >> 15) & 1, l = idx >> 16;
            const float g = (sx ? p.norm2_g : p.norm1_g)[l * DM + k], sc = mod[((size_t)l * NB + b) * MODW + (sx ? 4 : 1) * DM + k];
            gm[idx] = g * (1.0f + sc);
        }
    }
    {
        bf16_t* H = (bf16_t*)(p.ws + WS_H); float* rowss = (float*)(p.ws + WS_ROWSS);
        for (int rb = gw; rb < MTOK / 32; rb += NGW) {
            const int b = (rb * 32) / SEQ;
            f32x4 gs[4];
#pragma unroll
            for (int j = 0; j < 4; ++j) { const int col = 4 * lane + 256 * j;
                const f32x4 gg = *(const f32x4*)(p.norm1_g + col), sc = *(const f32x4*)(mod + (size_t)b * MODW + DM + col);
                gs[j] = gg * (sc + 1.0f); }
            for (int r = 0; r < 32; r += 4) {
                const size_t row = (size_t)rb * 32 + r;
                const f32x4* xr = (const f32x4*)(p.x + row * DM) + lane;
                f32x4 v[4][4];
#pragma unroll
                for (int q = 0; q < 4; ++q)
#pragma unroll
                    for (int j = 0; j < 4; ++j) v[q][j] = xr[256 * q + 64 * j];
#pragma unroll
                for (int q = 0; q < 4; ++q) { float sq = 0.f;
#pragma unroll
                    for (int j = 0; j < 4; ++j) sq += (v[q][j][0] * v[q][j][0] + v[q][j][1] * v[q][j][1]) + (v[q][j][2] * v[q][j][2] + v[q][j][3] * v[q][j][3]);
                    sq = wave_sum(sq);
                    if (lane < 16) rowss[(row + q) * 16 + lane] = (lane == 0) ? sq : 0.f;
                    u32x2* o8 = (u32x2*)(H + (row + q) * DM) + lane; h16x4* x8 = (h16x4*)((_Float16*)(p.ws + WS_X16) + (row + q) * DM) + lane;
#pragma unroll
                    for (int j = 0; j < 4; ++j) { const f32x4 y = v[q][j] * gs[j]; u32x2 w; w.x = pk2(y[0], y[1]); w.y = pk2(y[2], y[3]); o8[64 * j] = w; x8[64 * j] = __builtin_convertvector(v[q][j], h16x4); } }
            }
        }
    }
}

DI void phase_prep(const Params& p, int l, LAS unsigned char* lds) {
    const int tid = opq(threadIdx.x), lane = tid & 63, wave = tid >> 6, G = gridDim.x;
    const bf16_t* Z = (const bf16_t*)(p.ws + WS_Z);
    bf16_t* MIX = (bf16_t*)(p.ws + WS_MIX);
    LAS float* U = (LAS float*)lds;
    LAS float* CV = (LAS float*)(lds + 65536);
    const int cch = tid & 255, th = tid >> 8;
    float cw[31];
#pragma unroll
    for (int j = 0; j < 31; ++j) cw[j] = p.conv_a_w[((size_t)l * 31 + j) * 256 + cch];
    const float cbias = p.conv_a_b[l * 256 + cch];
    const f32x4 ga = *(const f32x4*)(p.conv_a_norm_g + l * 256 + 4 * lane);
    const f32x4 gb = *(const f32x4*)(p.sc_norm_g + l * 256 + 4 * lane);
    f32x4 wb[3];
#pragma unroll
    for (int j = 0; j < 3; ++j) wb[j] = *(const f32x4*)(p.conv_b_w + ((size_t)l * 3 + j) * 256 + 4 * lane);

    const int pvcu = (G % 8 == 0) ? ((blockIdx.x & 7) * (G >> 3) + (blockIdx.x >> 3)) : blockIdx.x;
    for (int it = pvcu; it < MTOK / 32; it += G) {
        const int b = it >> 6, t0 = (it & 63) * 32;
        const size_t tokbase = (size_t)b * SEQ;
        u32x4 av[4], ag[4];
#pragma unroll
        for (int k4 = 0; k4 < 4; ++k4) { const int ci = tid + 512 * k4, row = ci >> 5, ch8 = ci & 31, tok = t0 - 15 + row;
            av[k4] = (u32x4){0u, 0u, 0u, 0u}; ag[k4] = av[k4];
            if (ci < 62 * 32 && tok >= 0 && tok < SEQ) { const bf16_t* zp = Z + (tokbase + tok) * INW + ch8 * 8; av[k4] = *(const u32x4*)zp; ag[k4] = *(const u32x4*)(zp + 256); } }
        const int tw = t0 + wave * 4;
        u32x2 bcg[6], bhv[6], bbg[4];
#pragma unroll
        for (int r = 0; r < 6; ++r) { const int tok = tw - 1 + r; bcg[r] = (u32x2){0u, 0u}; bhv[r] = bcg[r];
            if (tok >= 0 && tok < SEQ) { const bf16_t* zp = Z + (tokbase + tok) * INW + 512 + 4 * lane; bcg[r] = *(const u32x2*)(zp + 256); bhv[r] = *(const u32x2*)(zp + 512);
                if (r >= 1 && r <= 4) bbg[r - 1] = *(const u32x2*)zp; } }
#pragma unroll
        for (int k4 = 0; k4 < 4; ++k4) { const int ci = tid + 512 * k4, row = ci >> 5, ch8 = ci & 31;
            if (ci < 62 * 32) { const u32x4 v = av[k4], gt = ag[k4]; f32x4 o0, o1;
                o0[0] = bf_lo(v.x) * sigmoidf_fast(bf_lo(gt.x)); o0[1] = bf_hi(v.x) * sigmoidf_fast(bf_hi(gt.x));
                o0[2] = bf_lo(v.y) * sigmoidf_fast(bf_lo(gt.y)); o0[3] = bf_hi(v.y) * sigmoidf_fast(bf_hi(gt.y));
                o1[0] = bf_lo(v.z) * sigmoidf_fast(bf_lo(gt.z)); o1[1] = bf_hi(v.z) * sigmoidf_fast(bf_hi(gt.z));
                o1[2] = bf_lo(v.w) * sigmoidf_fast(bf_lo(gt.w)); o1[3] = bf_hi(v.w) * sigmoidf_fast(bf_hi(gt.w));
                *(LAS f32x4*)(U + row * 256 + ch8 * 8) = o0; *(LAS f32x4*)(U + row * 256 + ch8 * 8 + 4) = o1; } }
        __syncthreads();
#pragma unroll 1
        for (int chunk = 0; chunk < 2; ++chunk) {
            const int tb = th * 16 + chunk * 8;
            float uu[38];
#pragma unroll
            for (int i = 0; i < 38; ++i) uu[i] = U[(tb + i) * 256 + cch];
#pragma unroll
            for (int t = 0; t < 8; ++t) { float a = cbias;
#pragma unroll
                for (int j = 0; j < 31; ++j) a += cw[j] * uu[t + j];
                CV[(tb + t) * 256 + cch] = a; }
        }
        __syncthreads();
#pragma unroll
        for (int q = 0; q < 4; ++q) { const int t = wave * 4 + q;
            const f32x4 v = *(const LAS f32x4*)(CV + t * 256 + 4 * lane);
            const float ss = wave_sum((v[0] * v[0] + v[1] * v[1]) + (v[2] * v[2] + v[3] * v[3]));
            const f32x4 y = v * rsqrtf(ss * (1.f / 256.f) + EPS) * ga;
            f32x4 o;
#pragma unroll
            for (int i = 0; i < 4; ++i) o[i] = y[i] * sigmoidf_fast(y[i]);
            u32x2 w; w.x = pk2(o[0], o[1]); w.y = pk2(o[2], o[3]);
            *(u32x2*)(MIX + (tokbase + t0 + t) * DM + 4 * lane) = w; }
        {
            f32x4 mrow[6], bgv[4];
#pragma unroll
            for (int r = 0; r < 6; ++r) { mrow[r][0] = bf_lo(bcg[r].x) * bf_lo(bhv[r].x); mrow[r][1] = bf_hi(bcg[r].x) * bf_hi(bhv[r].x); mrow[r][2] = bf_lo(bcg[r].y) * bf_lo(bhv[r].y); mrow[r][3] = bf_hi(bcg[r].y) * bf_hi(bhv[r].y); }
#pragma unroll
            for (int q = 0; q < 4; ++q) { bgv[q][0] = bf_lo(bbg[q].x); bgv[q][1] = bf_hi(bbg[q].x); bgv[q][2] = bf_lo(bbg[q].y); bgv[q][3] = bf_hi(bbg[q].y); }
#pragma unroll
            for (int q = 0; q < 4; ++q) {
                const f32x4 y = bgv[q] * (wb[0] * mrow[q] + wb[1] * mrow[q + 1] + wb[2] * mrow[q + 2]);
                const float ss = wave_sum((y[0] * y[0] + y[1] * y[1]) + (y[2] * y[2] + y[3] * y[3]));
                const f32x4 o = y * rsqrtf(ss * (1.f / 256.f) + EPS) * gb;
                u32x2 w; w.x = pk2(o[0], o[1]); w.y = pk2(o[2], o[3]);
                *(u32x2*)(MIX + (tokbase + tw + q) * DM + 256 + 4 * lane) = w; }
        }
        __syncthreads();
    }
}

constexpr int KROW = 272, VROW = 320, KBYTES = 64 * KROW, VBYTES = 64 * VROW, ABUF = KBYTES + VBYTES;
typedef short s16x4 __attribute__((ext_vector_type(4)));
#define MFMA32(a, b, c) __builtin_amdgcn_mfma_f32_32x32x16_bf16((a), (b), (c), 0, 0, 0)

DI void phase_attn(const Params& p, int l, float lambda_init, LAS unsigned char* lds) {
    const int tid = opq(threadIdx.x), lane = tid & 63, wave = tid >> 6, G = gridDim.x, r = lane & 31, h = lane >> 5;
    const int rg = wave >> 1, hf = wave & 1;
    const bf16_t* Z = (const bf16_t*)(p.ws + WS_Z);
    const bf16_t* QH = (const bf16_t*)(p.ws + WS_QH); const bf16_t* KH = (const bf16_t*)(p.ws + WS_KH);
    bf16_t* MIX = (bf16_t*)(p.ws + WS_MIX);
    const float sa = wave_sum(p.lam_q1[l * 64 + lane] * p.lam_k1[l * 64 + lane]), sb = wave_sum(p.lam_q2[l * 64 + lane] * p.lam_k2[l * 64 + lane]);
    const float lam = expf(sa) - expf(sb) + lambda_init;
    const float oscale = 1.0f - lambda_init;
    const int kkey = tid >> 3, kch = tid & 7;
    const int vtr = (4 * (lane >> 5) + ((lane >> 2) & 3)) * VROW + (16 * ((lane >> 4) & 1) + 4 * (lane & 3)) * 2;
    const int vcu = (G % 8 == 0) ? ((blockIdx.x & 7) * (G >> 3) + (blockIdx.x >> 3)) : blockIdx.x;
    LAS float* X = (LAS float*)lds + rg * (128 * 32);

    bf16x8 qf[4]; u32x4 krA[2], vrA[2], krB[2], vrB[2];
#define ATT_ITEM_PTRS(it_) const int qblk = (it_) & 15, head = ((it_) >> 4) & 3, b = (it_) >> 6; const size_t tokb = (size_t)b * SEQ; \
        const size_t qtok = tokb + qblk * 128 + rg * 32 + r; \
        const bf16_t* kg = KH + (tokb + kkey) * 512 + head * 128 + kch * 8; const bf16_t* vg = Z + (tokb + kkey) * INW + 2304 + head * 128 + kch * 8;
#define ATT_LOAD(KR, VR, t_) do { const bf16_t* kg2_ = kg + (size_t)(t_) * 64 * 512; const bf16_t* vg2_ = vg + (size_t)(t_) * 64 * INW; \
            KR[0] = *(const u32x4*)kg2_; KR[1] = *(const u32x4*)(kg2_ + 64); VR[0] = *(const u32x4*)vg2_; VR[1] = *(const u32x4*)(vg2_ + 64); } while (0)
#define ATT_ITEM_PREFETCH() do { ATT_LOAD(krA, vrA, 0); ATT_LOAD(krB, vrB, 1); \
            _Pragma("unroll") for (int kk = 0; kk < 4; ++kk) qf[kk] = *(const bf16x8*)(QH + qtok * 512 + head * 128 + hf * 64 + kk * 16 + h * 8); } while (0)
    if (vcu < NB * 4 * 16) { ATT_ITEM_PTRS(vcu); ATT_ITEM_PREFETCH(); }
    for (int it = vcu; it < NB * 4 * 16; it += G) {
        ATT_ITEM_PTRS(it);
        f32x16 o[4];
#pragma unroll
        for (int eb = 0; eb < 4; ++eb)
#pragma unroll
            for (int i = 0; i < 16; ++i) o[eb][i] = 0.f;
        float lsum = 0.f;
#define ATT_WRITE(KR, VR, buf) do { LAS unsigned char* kb_ = lds + (buf) * ABUF; LAS unsigned char* vb_ = kb_ + KBYTES; \
            *(LAS u32x4*)(kb_ + kkey * KROW + kch * 16) = KR[0]; *(LAS u32x4*)(kb_ + kkey * KROW + kch * 16 + 128) = KR[1]; \
            *(LAS u32x4*)(vb_ + kkey * VROW + kch * 16) = VR[0]; *(LAS u32x4*)(vb_ + kkey * VROW + kch * 16 + 128) = VR[1]; } while (0)
#define ATT_COMPUTE(buf) do { const LAS unsigned char* kb = lds + (buf) * ABUF; LAS unsigned char* vb = lds + (buf) * ABUF + KBYTES; \
            _Pragma("unroll") for (int kbk = 0; kbk < 2; ++kbk) { \
                f32x16 s; \
                _Pragma("unroll") for (int i = 0; i < 16; ++i) s[i] = 0.f; \
                _Pragma("unroll") for (int kk = 0; kk < 4; ++kk) { const bf16x8 a = *(const LAS bf16x8*)(kb + (kbk * 32 + r) * KROW + hf * 128 + kk * 32 + h * 16); s = MFMA32(a, qf[kk], s); } \
                float ls = 0.f; \
                _Pragma("unroll") for (int i = 0; i < 16; ++i) { s[i] = __builtin_amdgcn_exp2f(s[i]); ls += s[i]; } \
                lsum += ls; \
                bf16x8 pf[2]; \
                _Pragma("unroll") for (int st = 0; st < 2; ++st) { u32x4 w; w.x = pk2(s[8 * st], s[8 * st + 1]); w.y = pk2(s[8 * st + 2], s[8 * st + 3]); w.z = pk2(s[8 * st + 4], s[8 * st + 5]); w.w = pk2(s[8 * st + 6], s[8 * st + 7]); \
                    pf[st] = __builtin_bit_cast(bf16x8, w); } \
                _Pragma("unroll") for (int st = 0; st < 2; ++st) \
                    _Pragma("unroll") for (int eb = 0; eb < 4; ++eb) { \
                        const s16x4 vlo = __builtin_amdgcn_ds_read_tr16_b64_v4i16((LAS s16x4*)(vb + vtr + (kbk * 32 + st * 16) * VROW + eb * 64)); \
                        const s16x4 vhi = __builtin_amdgcn_ds_read_tr16_b64_v4i16((LAS s16x4*)(vb + vtr + (kbk * 32 + st * 16 + 8) * VROW + eb * 64)); \
                        const bf16x8 vf = __builtin_shufflevector(vlo, vhi, 0, 1, 2, 3, 4, 5, 6, 7); \
                        o[eb] = MFMA32(vf, pf[st], o[eb]); } \
            } } while (0)
        ATT_WRITE(krA, vrA, 0);
        ATT_LOAD(krA, vrA, 2);
        __syncthreads();
#pragma unroll 1
        for (int t = 0; t < SEQ / 64; t += 2) {
            ATT_COMPUTE(0);
            ATT_WRITE(krB, vrB, 1);
            if (t + 3 < SEQ / 64) ATT_LOAD(krB, vrB, t + 3);
            __syncthreads();
            ATT_COMPUTE(1);
            if (t + 2 < SEQ / 64) { ATT_WRITE(krA, vrA, 0);
                if (t + 4 < SEQ / 64) ATT_LOAD(krA, vrA, t + 4); }
            __syncthreads();
        }
#undef ATT_COMPUTE
        bf16_t* orow = MIX + qtok * DM + 512 + head * 128;
        if (it + G < NB * 4 * 16) { ATT_ITEM_PTRS(it + G); ATT_ITEM_PREFETCH(); }
        const float lt = lsum + __shfl_xor(lsum, 32);
        if (hf == 1) {
            const float sc1 = lam / lt;
#pragma unroll
            for (int eb = 0; eb < 4; ++eb)
#pragma unroll
                for (int i = 0; i < 16; ++i) X[(eb * 32 + (i & 3) + 8 * (i >> 2) + 4 * h) * 32 + r] = o[eb][i] * sc1;
        }
        __syncthreads();
        if (hf == 0) {
            const float i0 = 1.0f / lt;
            float ss = 0.f;
#pragma unroll
            for (int eb = 0; eb < 4; ++eb)
#pragma unroll
                for (int i = 0; i < 16; ++i) { const float v = o[eb][i] * i0 - X[(eb * 32 + (i & 3) + 8 * (i >> 2) + 4 * h) * 32 + r]; o[eb][i] = v; ss += v * v; }
            ss += __shfl_xor(ss, 32);
            const float rn = rsqrtf(ss * (1.f / 128.f) + EPS) * oscale;
#pragma unroll
            for (int eb = 0; eb < 4; ++eb)
#pragma unroll
                for (int g4 = 0; g4 < 4; ++g4) { const int e = eb * 32 + 8 * g4 + 4 * h;
                    const f32x4 gg = *(const f32x4*)(p.attn_norm_g + l * 128 + e);
                    u32x2 w; w.x = pk2(o[eb][4 * g4] * rn * gg[0], o[eb][4 * g4 + 1] * rn * gg[1]); w.y = pk2(o[eb][4 * g4 + 2] * rn * gg[2], o[eb][4 * g4 + 3] * rn * gg[3]);
                    *(u32x2*)(orow + e) = w; }
        }
        __syncthreads();
    }
#undef ATT_WRITE
#undef ATT_LOAD
#undef ATT_ITEM_PTRS
#undef ATT_ITEM_PREFETCH
}

#define XB_TMO      128
#define XB_XCNT(j)  (256  + 64 * (j))
#define XB_XSUB(j)  (1280 + 64 * (j))
#define XB_XGEN(j)  (2304 + 64 * (j))
#define XB_TOP      3328
#define XB_TOPGEN   3392
#define XCD_BAR_WORDS 3456
#define XB_SPIN_CAP (1u << 20)
DI unsigned xb_ld(unsigned* p)              { return __hip_atomic_load(p, __ATOMIC_RELAXED, __HIP_MEMORY_SCOPE_AGENT); }
DI unsigned xb_add(unsigned* p, unsigned v) { return __hip_atomic_fetch_add(p, v, __ATOMIC_RELAXED, __HIP_MEMORY_SCOPE_AGENT); }
DI unsigned xb_xcc_id() { return (unsigned)__builtin_amdgcn_s_getreg((3 << 11) | 20) & 0xFu; }
#define XB_SPIN(cond, bar) do { unsigned _sp = 0; while (cond) { __builtin_amdgcn_s_sleep(1); \
    if ((++_sp & 255u) == 0u) { if (xb_ld(&(bar)[XB_TMO])) break; if (_sp > XB_SPIN_CAP) { atomicAdd(&(bar)[XB_TMO], 1u); break; } } } } while (0)
struct XcdBarrier { unsigned* bar; unsigned x; volatile LAS unsigned* st; };
DI XcdBarrier xcd_barrier_post(unsigned* bar, volatile LAS unsigned* st) {
    XcdBarrier b; b.bar = bar; b.x = xb_xcc_id(); b.st = st;
    if (threadIdx.x == 0) (void)xb_add(&bar[XB_XCNT(b.x)], 1u);
    return b;
}
DI void xcd_barrier_complete(unsigned* bar, unsigned x, unsigned& nloc, unsigned& nx) {
    const unsigned G = gridDim.x * gridDim.y * gridDim.z;
    unsigned sum, cnt, mine, sp = 0u;
    for (;;) {
        sum = 0u; cnt = 0u; mine = 0u;
#pragma unroll
        for (unsigned j = 0; j < 16; ++j) { const unsigned c = xb_ld(&bar[XB_XCNT(j)]); sum += c; cnt += (c > 0u) ? 1u : 0u; mine = (j == x) ? c : mine; }
        if (sum == G) break;
        __builtin_amdgcn_s_sleep(1);
        if ((++sp & 255u) == 0u) { if (xb_ld(&bar[XB_TMO])) break; if (sp > XB_SPIN_CAP) { atomicAdd(&bar[XB_TMO], 1u); break; } }
    }
    nloc = mine > 0u ? mine : 1u; nx = cnt > 0u ? cnt : 1u;
}
DI void xcd_barrier(const XcdBarrier& b) {
    asm volatile("s_waitcnt vmcnt(0)" ::: "memory");
    __syncthreads();
    if (threadIdx.x == 0) {
        unsigned* bar = b.bar;
        __builtin_amdgcn_s_waitcnt(0);
        unsigned nloc = b.st[0], nx = b.st[1];
        if (nloc == 0u) { xcd_barrier_complete(bar, b.x, nloc, nx); b.st[0] = nloc; b.st[1] = nx; }
        const unsigned old = xb_add(&bar[XB_XSUB(b.x)], 1u);
        const unsigned gen = old / nloc;
        if (old + 1u == (gen + 1u) * nloc) {
            __builtin_amdgcn_fence(__ATOMIC_RELEASE, "agent");
            asm volatile("s_waitcnt vmcnt(0)" ::: "memory");
            const unsigned og = xb_add(&bar[XB_TOP], 1u);
            const unsigned tg = og / nx;
            if (og + 1u == (tg + 1u) * nx) xb_add(&bar[XB_TOPGEN], 1u);
            else XB_SPIN(xb_ld(&bar[XB_TOPGEN]) == tg, bar);
            __builtin_amdgcn_fence(__ATOMIC_ACQUIRE, "agent");
            xb_add(&bar[XB_XGEN(b.x)], 1u);
            asm volatile("s_waitcnt vmcnt(0)" ::: "memory");
        } else {
            XB_SPIN(xb_ld(&bar[XB_XGEN(b.x)]) == gen, bar);
            __builtin_amdgcn_fence(__ATOMIC_ACQUIRE, "agent");
            asm volatile("s_waitcnt vmcnt(0)" ::: "memory");
        }
    }
    __syncthreads();
}

__global__ void __launch_bounds__(512, 2) fwd_megakernel(Params p) {
    extern __shared__ __attribute__((aligned(16))) unsigned char shm[];
    LAS unsigned char* lds = (LAS unsigned char*)shm;
    cg::grid_group grid = cg::this_grid();
    const int G = gridDim.x, c = blockIdx.x;
    float* mod = (float*)(p.ws + WS_MOD);
    bf16_t* H = (bf16_t*)(p.ws + WS_H); bf16_t* Zb = (bf16_t*)(p.ws + WS_Z); bf16_t* MIX = (bf16_t*)(p.ws + WS_MIX);
    volatile LAS unsigned* bst = (volatile LAS unsigned*)(lds + 131072);
    if (threadIdx.x < 4) bst[threadIdx.x] = 0u;
    __syncthreads();
    const XcdBarrier xb = xcd_barrier_post((unsigned*)(p.ws + WS_BAR), bst);
    float* rowss = (float*)(p.ws + WS_ROWSS);
    for (int ph = p.ph_lo; ph < p.ph_hi; ++ph) {
        if (ph > p.ph_lo) { if (ph == p.ph_lo + 1) grid.sync(); else xcd_barrier(xb); }
        if (ph == 0) { phase0(p, lds); continue; }
        if (ph == 1) { phase_pre(p); continue; }
        const int l = (ph - 2) / 5, s5 = (ph - 2) % 5, sub = s5 + (s5 >= 2 ? 1 : 0);
        const float* modl = mod + (size_t)l * NB * MODW;
        float* rs1 = rowss + (size_t)(2 * l) * MTOK * 16; float* rs2 = rs1 + (size_t)MTOK * 16;
        const float* gml = (const float*)(p.ws + WS_GM) + (size_t)l * 2 * NB * DM;
        if (sub == 0) { pg8::StaticOrder S; S.init(MTOK, INW, G, c); pg8::Gemm g{H, (const bf16_t*)(p.ws + WS_WT_IN) + (size_t)l * INW * DM, MTOK, INW, DM};
            pg8::EpiZ E{Zb, INW, rs1, (const float*)(p.ws + WS_SHW_IN) + (size_t)l * NB * INW, (bf16_t*)(p.ws + WS_QH), (bf16_t*)(p.ws + WS_KH), p.q_norm_g + l * 64, p.k_norm_g + l * 64, (const float*)(p.ws + WS_ROPE), (const float*)(p.ws + WS_ROPE) + SEQ * 32}; pg8::gemm_phase(lds, g, S, E); }
        else if (sub == 1) { phase_prep(p, l, lds); const float lambda_init = 0.8f - 0.6f * expf(-0.3f * (float)l); phase_attn(p, l, lambda_init, lds); }
        else if (sub == 3 || sub == 5) {
            pg8::StaticOrder S; S.init(MTOK, DM, G, c);
            pg8::Gemm g; pg8::EpiRes E;
            _Float16* X16 = (_Float16*)(p.ws + WS_X16);
            if (sub == 3) { g = pg8::Gemm{MIX, (const bf16_t*)(p.ws + WS_WT_OUT) + (size_t)l * DM * DM, MTOK, DM, DM}; E = pg8::EpiRes{X16, X16, nullptr, modl + 2 * DM, gml + NB * DM, H, rs2}; }
            else { const bool lastl = (l == NL - 1);
                g = pg8::Gemm{Zb, (const bf16_t*)(p.ws + WS_WT_DN) + (size_t)l * DM * DFF, MTOK, DM, DFF};
                E = pg8::EpiRes{X16, X16, lastl ? p.out : nullptr, modl + 5 * DM, lastl ? nullptr : gml + 2 * NB * DM, H, lastl ? nullptr : rs1 + (size_t)2 * MTOK * 16}; }
            pg8::gemm_phase(lds, g, S, E); }
        else { pg8::StaticOrder S; S.init(MTOK, GU, G, c); pg8::Gemm g{H, (const bf16_t*)(p.ws + WS_WT_GU) + (size_t)l * GU * DM, MTOK, GU, DM};
            pg8::EpiSwiGLU E{Zb, rs2, (const float*)(p.ws + WS_SHW_GU) + (size_t)l * NB * GU}; pg8::gemm_phase(lds, g, S, E); }
    }
}

extern "C" void kernel_launch(void* const* d_in, const int* in_sizes, int n_in, void* d_out, int out_size, void* d_ws, size_t ws_size, hipStream_t stream) {
    static int grid = 0;
    if (grid == 0) {
        if (n_in != 23 || ws_size < WS_END) { fprintf(stderr, "kernel_launch: unexpected n_in %d or ws_size %zu < %zu\n", n_in, ws_size, (size_t)WS_END); grid = -1; return; }
        int dev = 0, cus = 0, per_cu = 0;
        if (hipGetDevice(&dev) != hipSuccess || hipDeviceGetAttribute(&cus, hipDeviceAttributeMultiprocessorCount, dev) != hipSuccess) { grid = -1; return; }
        if (hipFuncSetAttribute((const void*)fwd_megakernel, hipFuncAttributeMaxDynamicSharedMemorySize, LDS_BYTES) != hipSuccess) { fprintf(stderr, "kernel_launch: hipFuncSetAttribute failed\n"); grid = -1; return; }
        if (hipOccupancyMaxActiveBlocksPerMultiprocessor(&per_cu, (const void*)fwd_megakernel, 512, LDS_BYTES) != hipSuccess || per_cu < 1) { fprintf(stderr, "kernel_launch: occupancy query says %d\n", per_cu); per_cu = 1; }
        (void)hipGetLastError();
        grid = cus;
    }
    if (grid < 0) return;
    if (hipMemsetAsync((char*)d_ws + WS_BAR, 0, 16384, stream) != hipSuccess) { fprintf(stderr, "kernel_launch: memset of the barrier word failed\n"); return; }
    Params p{};
    p.x = (const float*)d_in[0]; p.c = (const float*)d_in[1]; p.pos = (const int*)d_in[2];
    p.norm1_g = (const float*)d_in[3]; p.norm2_g = (const float*)d_in[4]; p.w_ada = (const float*)d_in[5]; p.b_ada = (const float*)d_in[6];
    p.w_in = (const float*)d_in[7]; p.conv_a_w = (const float*)d_in[8]; p.conv_a_b = (const float*)d_in[9]; p.conv_a_norm_g = (const float*)d_in[10];
    p.conv_b_w = (const float*)d_in[11]; p.sc_norm_g = (const float*)d_in[12]; p.q_norm_g = (const float*)d_in[13]; p.k_norm_g = (const float*)d_in[14];
    p.lam_q1 = (const float*)d_in[15]; p.lam_k1 = (const float*)d_in[16]; p.lam_q2 = (const float*)d_in[17]; p.lam_k2 = (const float*)d_in[18];
    p.attn_norm_g = (const float*)d_in[19]; p.w_out = (const float*)d_in[20]; p.w_gate_up = (const float*)d_in[21]; p.w_down = (const float*)d_in[22];
    p.out = (float*)d_out; p.ws = (unsigned char*)d_ws;
#if MK_MULTI
    for (int ph = 0; ph < NPHASE; ++ph) {
        p.ph_lo = ph; p.ph_hi = ph + 1;
        hipLaunchKernelGGL(fwd_megakernel, dim3(grid), dim3(512), LDS_BYTES, stream, p);
    }
#else
    p.ph_lo = 0; p.ph_hi = NPHASE;
    void* args[] = {&p};
    hipError_t e = hipLaunchCooperativeKernel((const void*)fwd_megakernel, dim3(grid), dim3(512), args, LDS_BYTES, stream);
    if (e != hipSuccess) fprintf(stderr, "kernel_launch: cooperative launch failed: %s (grid %d)\n", hipGetErrorString(e), grid);
#endif
}
```

```cpp
#include <hip/hip_runtime.h>
#include <hip/hip_cooperative_groups.h>
#include <cstdio>
namespace cg = cooperative_groups;

#ifndef MK_MULTI
#define MK_MULTI 0
#endif

#define LAS __attribute__((address_space(3)))
#define DI __device__ __forceinline__
typedef unsigned short bf16_t;
typedef short bf16x8 __attribute__((ext_vector_type(8)));
typedef float f32x4 __attribute__((ext_vector_type(4)));
typedef float f32x2 __attribute__((ext_vector_type(2)));
typedef float f32x16 __attribute__((ext_vector_type(16)));
typedef unsigned u32x4 __attribute__((ext_vector_type(4)));
typedef unsigned u32x2 __attribute__((ext_vector_type(2)));
typedef __bf16 bf16x2n __attribute__((ext_vector_type(2)));
typedef _Float16 h16x8 __attribute__((ext_vector_type(8)));
typedef _Float16 h16x4 __attribute__((ext_vector_type(4)));
typedef float f32x8 __attribute__((ext_vector_type(8)));

constexpr int NB = 32, SEQ = 2048, DM = 1024, MTOK = NB * SEQ, NL = 4, INW = 2816, DFF = 2816, GU = 2 * DFF;
constexpr int MODW = 6 * DM;
constexpr float EPS = 1e-6f;
constexpr float LOG2E = 1.4426950408889634f;
constexpr int LDS_BYTES = 131072 + 16;
constexpr int NPHASE = 2 + 5 * NL;

constexpr size_t WS_WT_IN = 0;
constexpr size_t WS_WT_OUT = WS_WT_IN + (size_t)NL * INW * DM * 2;
constexpr size_t WS_WT_GU = WS_WT_OUT + (size_t)NL * DM * DM * 2;
constexpr size_t WS_WT_DN = WS_WT_GU + (size_t)NL * GU * DM * 2;
constexpr size_t WS_MOD = WS_WT_DN + (size_t)NL * DM * DFF * 2;
constexpr size_t WS_ROPE = WS_MOD + (size_t)NL * NB * MODW * 4;
constexpr size_t WS_H = WS_ROPE + (size_t)2 * SEQ * 32 * 4;
constexpr size_t WS_Z = WS_H + (size_t)MTOK * DM * 2;
constexpr size_t WS_QH = WS_Z + (size_t)MTOK * INW * 2;
constexpr size_t WS_KH = WS_QH + (size_t)MTOK * 512 * 2;
constexpr size_t WS_MIX = WS_KH + (size_t)MTOK * 512 * 2;
constexpr size_t WS_ROWSS = WS_MIX + (size_t)MTOK * DM * 2;
constexpr size_t WS_SHW_IN = WS_ROWSS + (size_t)NL * 2 * MTOK * 16 * 4;
constexpr size_t WS_SHW_GU = WS_SHW_IN + (size_t)NL * NB * INW * 4;
constexpr size_t WS_GM = WS_SHW_GU + (size_t)NL * NB * GU * 4;
constexpr size_t WS_X16 = WS_GM + (size_t)NL * 2 * NB * DM * 4;
constexpr size_t WS_BAR = WS_X16 + (size_t)MTOK * DM * 2;
constexpr size_t WS_END = WS_BAR + 16384;

struct Params {
    const float* x; const float* c; const int* pos;
    const float *norm1_g, *norm2_g, *w_ada, *b_ada, *w_in, *conv_a_w, *conv_a_b, *conv_a_norm_g, *conv_b_w, *sc_norm_g,
        *q_norm_g, *k_norm_g, *lam_q1, *lam_k1, *lam_q2, *lam_k2, *attn_norm_g, *w_out, *w_gate_up, *w_down;
    float* out; unsigned char* ws;
    int ph_lo, ph_hi;
};

DI unsigned pk2(float lo, float hi) { f32x2 v = {lo, hi}; return __builtin_bit_cast(unsigned, __builtin_convertvector(v, bf16x2n)); }
DI float bf_lo(unsigned u) { return __uint_as_float(u << 16); }
DI float bf_hi(unsigned u) { return __uint_as_float(u & 0xffff0000u); }
DI float wave_sum(float v) {
#pragma unroll
    for (int o = 1; o < 64; o <<= 1) v += __shfl_xor(v, o);
    return v;
}
DI float wave_max(float v) {
#pragma unroll
    for (int o = 1; o < 64; o <<= 1) v = fmaxf(v, __shfl_xor(v, o));
    return v;
}
DI int opq(int v) { asm volatile("" : "+v"(v)); return v; }
DI float sigmoidf_fast(float v) { return __builtin_amdgcn_rcpf(1.0f + __builtin_amdgcn_exp2f(-v * LOG2E)); }

namespace pg8 {
constexpr int BM = 256, BK = 64, HALF = 128, HTB = HALF * BK * 2, NXCD = 8, WGM = 8;
DI int lds_byte(int r, int c) { const int st = (r >> 4) * 2 + (c >> 5), rr = r & 15, cc = c & 31, ob = rr * 64 + cc * 2; return st * 1024 + (ob ^ (((ob >> 9) & 1) << 5)); }
DI void stage_rc(int b, int& R, int& C) { const int st = b / 1024, sb = b % 1024, swz = sb ^ (((sb >> 9) & 1) << 5); R = (st >> 1) * 16 + swz / 64; C = (st & 1) * 32 + (swz % 64) / 2; }
DI int perm32(int rho) { const int n = rho >> 4, i = rho & 15; return 8 * (i >> 2) + 4 * n + (i & 3); }
struct Unit { int pm, pn; };
struct Gemm { const bf16_t* A; const bf16_t* Bt; int M, N, K; };
struct StaticOrder {
    int nM, nN, nwg, G, c;
    DI void init(int M, int N, int G_, int c_) { nM = M / BM; nN = N / BM; nwg = nM * nN; G = G_; c = c_; }
    DI bool next(int i, Unit& u) const {
        const long L = (long)i * G + c; if (L >= nwg) return false;
        int wgid = (int)L; { const int q = nwg / NXCD, r = nwg % NXCD, xcd = wgid % NXCD, off = wgid / NXCD; wgid = (xcd < r ? xcd * (q + 1) : r * (q + 1) + (xcd - r) * q) + off; }
        const int nig = WGM * nN, gid = wgid / nig, fm = gid * WGM, gsz = (nM - fm) < WGM ? (nM - fm) : WGM;
        u.pm = fm + ((wgid % nig) % gsz); u.pn = (wgid % nig) / gsz; return true;
    }
};

DI void row_rstd8(const float* rowss, int row0, int fq, float (&rstd)[2][4]) {
    f32x4 pr[2][4];
#pragma unroll
    for (int ai = 0; ai < 2; ++ai)
#pragma unroll
        for (int m = 0; m < 4; ++m) pr[ai][m] = *(const f32x4*)(rowss + (size_t)(row0 + ai * HALF + m * 16) * 16 + 4 * fq);
#pragma unroll
    for (int ai = 0; ai < 2; ++ai)
#pragma unroll
        for (int m = 0; m < 4; ++m) { float t = (pr[ai][m][0] + pr[ai][m][1]) + (pr[ai][m][2] + pr[ai][m][3]);
            t += __shfl_xor(t, 16); t += __shfl_xor(t, 32);
            rstd[ai][m] = rsqrtf(t * (1.f / DM) + EPS); }
}
struct EpiZ {
    static constexpr bool PERM = true;
    bf16_t* O; int ldc; const float* rowss; const float* shw;
    bf16_t* QH; bf16_t* KH; const float* gq; const float* gk; const float* rc; const float* rs;
    DI void operator()(const f32x4 (&acc)[2][2][4][2], const Unit& u, int wr, int wc, int fr, int fq) const {
        const int row0 = u.pm * BM + wr * 64 + fr, col0 = u.pn * BM + wc * 32 + 8 * fq, b = (u.pm * BM) / SEQ;
        float rstd8[2][4]; row_rstd8(rowss, row0, fq, rstd8);
        const float* svp = shw + (size_t)b * ldc + col0;
        if (u.pn < 5 || u.pn > 8) {
            f32x4 sv[2][2];
#pragma unroll
            for (int bj = 0; bj < 2; ++bj)
#pragma unroll
                for (int n = 0; n < 2; ++n) sv[bj][n] = *(const f32x4*)(svp + bj * HALF + 4 * n);
#pragma unroll
            for (int ai = 0; ai < 2; ++ai)
#pragma unroll
                for (int m = 0; m < 4; ++m) { const int row = row0 + ai * HALF + m * 16; bf16_t* rowp = O + (size_t)row * ldc + col0;
                    const float rstd = rstd8[ai][m];
#pragma unroll
                    for (int bj = 0; bj < 2; ++bj) { const f32x4 v0 = acc[ai][bj][m][0] * rstd + sv[bj][0], v1 = acc[ai][bj][m][1] * rstd + sv[bj][1];
                        u32x4 w; w.x = pk2(v0[0], v0[1]); w.y = pk2(v0[2], v0[3]); w.z = pk2(v1[0], v1[1]); w.w = pk2(v1[2], v1[3]);
                        *(u32x4*)(rowp + bj * HALF) = w; } }
        } else {
            const int gi = (u.pn - 5) * 4 + wc, isk = gi >> 3, hd = (gi >> 1) & 3, hfh = gi & 1;
            const float* gg = isk ? gk : gq; bf16_t* dst = (isk ? KH : QH) + hd * 128 + hfh * 64 + 4 * fq;
            const float qs = isk ? 1.0f : LOG2E * 0.125f;
#pragma unroll
            for (int ai = 0; ai < 2; ++ai)
#pragma unroll
                for (int m = 0; m < 4; ++m) { const int row = row0 + ai * HALF + m * 16, spos = row & (SEQ - 1);
                    const float rstd = rstd8[ai][m];
                    f32x4 lo[2], hi[2]; float ss = 0.f;
#pragma unroll
                    for (int bj = 0; bj < 2; ++bj) { const f32x4 v0 = acc[ai][bj][m][0] * rstd + *(const f32x4*)(svp + bj * HALF), v1 = acc[ai][bj][m][1] * rstd + *(const f32x4*)(svp + bj * HALF + 4);
                        lo[bj] = (f32x4){v0[0], v0[2], v1[0], v1[2]}; hi[bj] = (f32x4){v0[1], v0[3], v1[1], v1[3]};
                        ss += ((v0[0] * v0[0] + v0[1] * v0[1]) + (v0[2] * v0[2] + v0[3] * v0[3])) + ((v1[0] * v1[0] + v1[1] * v1[1]) + (v1[2] * v1[2] + v1[3] * v1[3])); }
                    ss += __shfl_xor(ss, 16); ss += __shfl_xor(ss, 32);
                    const float rg = rsqrtf(ss * (1.f / 64.f) + EPS) * qs;
#pragma unroll
                    for (int bj = 0; bj < 2; ++bj) {
                        const f32x4 glo = *(const f32x4*)(gg + bj * 16 + fq * 4), ghi = *(const f32x4*)(gg + 32 + bj * 16 + fq * 4);
                        const f32x4 c4 = *(const f32x4*)(rc + spos * 32 + bj * 16 + fq * 4), s4 = *(const f32x4*)(rs + spos * 32 + bj * 16 + fq * 4);
                        const f32x4 a = lo[bj] * rg * glo, bb = hi[bj] * rg * ghi;
                        const f32x4 olo = a * c4 - bb * s4, ohi = bb * c4 + a * s4;
                        u32x2 w0, w1; w0.x = pk2(olo[0], olo[1]); w0.y = pk2(olo[2], olo[3]); w1.x = pk2(ohi[0], ohi[1]); w1.y = pk2(ohi[2], ohi[3]);
                        *(u32x2*)(dst + (size_t)row * 512 + bj * 16) = w0; *(u32x2*)(dst + (size_t)row * 512 + 32 + bj * 16) = w1; }
                    asm volatile("" ::: "memory"); }
        }
    }
};
struct EpiRes {
    static constexpr bool PERM = true;
    const _Float16* xin; _Float16* xout; float* xout32; const float* gate; const float* gm; bf16_t* Hout; float* rowss_out;
    DI void operator()(const f32x4 (&acc)[2][2][4][2], const Unit& u, int wr, int wc, int fr, int fq) const {
        const int row0 = u.pm * BM + wr * 64 + fr, col0 = u.pn * BM + wc * 64 + 8 * fq, b = (u.pm * BM) / SEQ;
        const bool nxt = gm != nullptr, o32 = xout32 != nullptr;
        f32x4 gv[2][2], gmv[2][2];
#pragma unroll
        for (int bj = 0; bj < 2; ++bj)
#pragma unroll
            for (int n = 0; n < 2; ++n) { gv[bj][n] = *(const f32x4*)(gate + (size_t)b * MODW + col0 + bj * 32 + 4 * n);
                gmv[bj][n] = nxt ? *(const f32x4*)(gm + (size_t)b * DM + col0 + bj * 32 + 4 * n) : (f32x4){0.f, 0.f, 0.f, 0.f}; }
        h16x8 xv[4][2];
#define ER_LOAD(rnd) do { const size_t off_ = (size_t)(row0 + ((rnd) >> 2) * HALF + ((rnd) & 3) * 16) * DM + col0; \
            _Pragma("unroll") for (int bj = 0; bj < 2; ++bj) xv[(rnd) & 3][bj] = *(const h16x8*)(xin + off_ + bj * 32); } while (0)
        ER_LOAD(0); ER_LOAD(1); ER_LOAD(2);
        float ssum[4] = {0.f, 0.f, 0.f, 0.f};
#pragma unroll
        for (int rnd = 0; rnd < 8; ++rnd) {
            const int ai = rnd >> 2, m = rnd & 3;
            const size_t off = (size_t)(row0 + ai * HALF + m * 16) * DM + col0;
            f32x4 x0[2], x1[2];
#pragma unroll
            for (int bj = 0; bj < 2; ++bj) { const f32x8 xf = __builtin_convertvector(xv[rnd & 3][bj], f32x8);
                x0[bj] = (f32x4){xf[0], xf[1], xf[2], xf[3]} + gv[bj][0] * acc[ai][bj][m][0]; x1[bj] = (f32x4){xf[4], xf[5], xf[6], xf[7]} + gv[bj][1] * acc[ai][bj][m][1]; }
            if (rnd + 3 < 8) ER_LOAD(rnd + 3);
#pragma unroll
            for (int bj = 0; bj < 2; ++bj) {
                if (o32) { *(f32x4*)(xout32 + off + bj * 32) = x0[bj]; *(f32x4*)(xout32 + off + bj * 32 + 4) = x1[bj]; }
                else { const f32x8 xf = {x0[bj][0], x0[bj][1], x0[bj][2], x0[bj][3], x1[bj][0], x1[bj][1], x1[bj][2], x1[bj][3]};
                    *(h16x8*)(xout + off + bj * 32) = __builtin_convertvector(xf, h16x8); }
                if (nxt) {
                    ssum[m] += ((x0[bj][0] * x0[bj][0] + x0[bj][1] * x0[bj][1]) + (x0[bj][2] * x0[bj][2] + x0[bj][3] * x0[bj][3])) + ((x1[bj][0] * x1[bj][0] + x1[bj][1] * x1[bj][1]) + (x1[bj][2] * x1[bj][2] + x1[bj][3] * x1[bj][3]));
                    const f32x4 h0 = x0[bj] * gmv[bj][0], h1 = x1[bj] * gmv[bj][1];
                    u32x4 w; w.x = pk2(h0[0], h0[1]); w.y = pk2(h0[2], h0[3]); w.z = pk2(h1[0], h1[1]); w.w = pk2(h1[2], h1[3]);
                    *(u32x4*)(Hout + off + bj * 32) = w; } }
            asm volatile("" ::: "memory");
            if (nxt && m == 3) {
                const bool hi2 = (fq & 2) != 0, hi1 = (fq & 1) != 0;
                const float t0 = hi2 ? ssum[0] : ssum[2], t1 = hi2 ? ssum[1] : ssum[3], k0 = hi2 ? ssum[2] : ssum[0], k1 = hi2 ? ssum[3] : ssum[1];
                const float a0 = k0 + __shfl_xor(t0, 32), a1 = k1 + __shfl_xor(t1, 32);
                const float t = hi1 ? a0 : a1, k = hi1 ? a1 : a0;
                const float rsum = k + __shfl_xor(t, 16);
                rowss_out[(size_t)(u.pm * BM + ai * HALF + wr * 64 + fq * 16 + fr) * 16 + u.pn * 4 + wc] = rsum;
#pragma unroll
                for (int i = 0; i < 4; ++i) ssum[i] = 0.f;
            }
        }
#undef ER_LOAD
    }
};
struct EpiSwiGLU {
    static constexpr bool PERM = true;
    bf16_t* O; const float* rowss; const float* shw;
    DI void operator()(const f32x4 (&acc)[2][2][4][2], const Unit& u, int wr, int wc, int fr, int fq) const {
        const int row0 = u.pm * BM + wr * 64 + fr, colh = u.pn * 128 + wc * 16 + 4 * fq, b = (u.pm * BM) / SEQ;
        f32x4 sv[2][2];
#pragma unroll
        for (int bj = 0; bj < 2; ++bj)
#pragma unroll
            for (int n = 0; n < 2; ++n) sv[bj][n] = *(const f32x4*)(shw + (size_t)b * GU + 2 * colh + bj * HALF + 4 * n);
        float rstd8[2][4]; row_rstd8(rowss, row0, fq, rstd8);
#pragma unroll
        for (int ai = 0; ai < 2; ++ai)
#pragma unroll
            for (int m = 0; m < 4; ++m) { const int row = row0 + ai * HALF + m * 16; bf16_t* rowp = O + (size_t)row * DFF + colh;
                const float rstd = rstd8[ai][m];
#pragma unroll
                for (int bj = 0; bj < 2; ++bj) { const f32x4 g = acc[ai][bj][m][0] * rstd + sv[bj][0], uu = acc[ai][bj][m][1] * rstd + sv[bj][1];
                    float a[4];
#pragma unroll
                    for (int i = 0; i < 4; ++i) a[i] = g[i] * sigmoidf_fast(g[i]) * uu[i];
                    u32x2 w; w.x = pk2(a[0], a[1]); w.y = pk2(a[2], a[3]);
                    *(u32x2*)(rowp + bj * 64) = w; } }
    }
};

template <class Epi, class Sched>
DI void gemm_phase(LAS unsigned char* lds, const Gemm g, const Sched& S, const Epi& E) {
    const int tid = opq(threadIdx.x), wid = __builtin_amdgcn_readfirstlane(tid >> 6), lane = tid & 63, wr = wid >> 2, wc = wid & 3, fr = lane & 15, fq = lane >> 4;
    const int K = g.K, nt = K / BK;
    unsigned voffA[2], voffB[2];
#pragma unroll
    for (int i = 0; i < 2; ++i) { int R, C; stage_rc(tid * 16 + i * 8192, R, C); const int Rb = Epi::PERM ? ((R & ~31) + perm32(R & 31)) : R;
        voffA[i] = (unsigned)(R * K + C) * 2u; voffB[i] = (unsigned)(Rb * K + C) * 2u; }
    const size_t kstep = (size_t)(BK * 2);
    const size_t hstep = (size_t)HALF * K * 2;
    const size_t tstep = 2 * hstep;
    const unsigned ldsw = (unsigned)wid * 1024u;
    const int aoff = lds_byte(wr * 64 + fr, fq * 8), boff = lds_byte(wc * 32 + fr, fq * 8);
#define PG8_SA(b, h) (((b) * 2 + (h)) * HTB)
#define PG8_SB(b, h) ((4 + (b) * 2 + (h)) * HTB)
#define PG8_STAGE(bufoff, gbase, voff) do { _Pragma("unroll") for (int _i = 0; _i < 2; ++_i) \
        __builtin_amdgcn_global_load_lds((const unsigned*)((const char*)(gbase) + (voff)[_i]), (LAS unsigned*)(lds + (bufoff) + ldsw + _i * 8192), 16, 0, 0); } while (0)
#define PG8_LDA(dst, b, h) do { _Pragma("unroll") for (int m = 0; m < 4; ++m) _Pragma("unroll") for (int k = 0; k < 2; ++k) dst[m][k] = *(const LAS bf16x8*)(lds + PG8_SA(b, h) + aoff + m * 2048 + k * 1024); } while (0)
#define PG8_LDB(dst, b, h) do { _Pragma("unroll") for (int n = 0; n < 2; ++n) _Pragma("unroll") for (int k = 0; k < 2; ++k) dst[n][k] = *(const LAS bf16x8*)(lds + PG8_SB(b, h) + boff + n * 2048 + k * 1024); } while (0)
#define PG8_MMA(ai, bj, At, Bt) do { __builtin_amdgcn_s_setprio(1); _Pragma("unroll") for (int m = 0; m < 4; ++m) _Pragma("unroll") for (int n = 0; n < 2; ++n) _Pragma("unroll") for (int k = 0; k < 2; ++k) \
        acc[ai][bj][m][n] = __builtin_amdgcn_mfma_f32_16x16x32_bf16(Bt[n][k], At[m][k], acc[ai][bj][m][n], 0, 0, 0); __builtin_amdgcn_s_setprio(0); } while (0)
#define PG8_WAIT_V(n) asm volatile("s_waitcnt vmcnt(" #n ")" ::: "memory")
#define PG8_WAIT_L(n) asm volatile("s_waitcnt lgkmcnt(" #n ")" ::: "memory")
#define PG8_BAR __builtin_amdgcn_s_barrier()
#define PG8_SCHED __builtin_amdgcn_sched_barrier(0)
    Unit cur, nxt; int ui = 0;
    if (!S.next(0, cur)) return;
    f32x4 acc[2][2][4][2];
#pragma unroll
    for (int a = 0; a < 2; ++a)
#pragma unroll
        for (int b = 0; b < 2; ++b)
#pragma unroll
            for (int m = 0; m < 4; ++m)
#pragma unroll
                for (int n = 0; n < 2; ++n) acc[a][b][m][n] = (f32x4){0.f, 0.f, 0.f, 0.f};
    bf16x8 At[4][2], B0[2][2], B1[2][2];
    const char* cA = (const char*)g.A + (size_t)cur.pm * tstep; const char* cB = (const char*)g.Bt + (size_t)cur.pn * tstep;
    PG8_STAGE(PG8_SB(0, 0), cB, voffB); PG8_STAGE(PG8_SA(0, 0), cA, voffA); PG8_STAGE(PG8_SB(0, 1), cB + hstep, voffB); PG8_STAGE(PG8_SA(0, 1), cA + hstep, voffA);
    if (wr == 1) PG8_BAR;
    PG8_WAIT_V(4); PG8_BAR;
    PG8_STAGE(PG8_SB(1, 0), cB + kstep, voffB); PG8_STAGE(PG8_SA(1, 0), cA + kstep, voffA); PG8_STAGE(PG8_SB(1, 1), cB + hstep + kstep, voffB);
    PG8_WAIT_V(6); PG8_BAR;
    for (;;) {
        const bool has_next = S.next(ui + 1, nxt);
        const char* nA = has_next ? (const char*)g.A + (size_t)nxt.pm * tstep : cA; const char* nB = has_next ? (const char*)g.Bt + (size_t)nxt.pn * tstep : cB;
        for (int t = 0; t < nt; t += 2) {
            const bool last = (t == nt - 2);
            const char* a1 = cA + (size_t)(t + 1) * kstep;
            const char* a2 = last ? nA : cA + (size_t)(t + 2) * kstep; const char* b2 = last ? nB : cB + (size_t)(t + 2) * kstep;
            const char* a3 = a2 + kstep; const char* b3 = b2 + kstep;
            PG8_LDB(B0, 0, 0); PG8_SCHED; PG8_LDA(At, 0, 0); PG8_STAGE(PG8_SA(1, 1), a1 + hstep, voffA);
            PG8_WAIT_L(8); PG8_BAR; PG8_WAIT_L(0); PG8_MMA(0, 0, At, B0); PG8_BAR; PG8_SCHED;
            PG8_LDB(B1, 0, 1); PG8_STAGE(PG8_SB(0, 0), b2, voffB);
            PG8_BAR; PG8_WAIT_L(0); PG8_MMA(0, 1, At, B1); PG8_BAR;
            PG8_LDA(At, 0, 1); PG8_STAGE(PG8_SA(0, 0), a2, voffA);
            PG8_BAR; PG8_WAIT_L(0); PG8_MMA(1, 0, At, B0); PG8_BAR; PG8_SCHED;
            PG8_STAGE(PG8_SB(0, 1), b2 + hstep, voffB);
            PG8_WAIT_V(6); PG8_BAR; PG8_MMA(1, 1, At, B1); PG8_BAR;
            PG8_LDB(B0, 1, 0); PG8_SCHED; PG8_LDA(At, 1, 0); PG8_STAGE(PG8_SA(0, 1), a2 + hstep, voffA);
            PG8_WAIT_L(8); PG8_BAR; PG8_WAIT_L(0); PG8_MMA(0, 0, At, B0); PG8_BAR; PG8_SCHED;
            PG8_LDB(B1, 1, 1); PG8_STAGE(PG8_SB(1, 0), b3, voffB);
            PG8_BAR; PG8_WAIT_L(0); PG8_MMA(0, 1, At, B1); PG8_BAR;
            PG8_LDA(At, 1, 1); PG8_STAGE(PG8_SA(1, 0), a3, voffA);
            PG8_BAR; PG8_WAIT_L(0); PG8_MMA(1, 0, At, B0); PG8_BAR; PG8_SCHED;
            PG8_STAGE(PG8_SB(1, 1), b3 + hstep, voffB);
            PG8_WAIT_V(6); PG8_BAR; PG8_MMA(1, 1, At, B1); PG8_BAR;
        }
        E(acc, cur, wr, wc, fr, fq);
        if (!has_next) break;
#pragma unroll
        for (int a = 0; a < 2; ++a)
#pragma unroll
            for (int b = 0; b < 2; ++b)
#pragma unroll
                for (int m = 0; m < 4; ++m)
#pragma unroll
                    for (int n = 0; n < 2; ++n) acc[a][b][m][n] = (f32x4){0.f, 0.f, 0.f, 0.f};
        cur = nxt; cA = nA; cB = nB; ++ui;
    }
    PG8_WAIT_V(0);
    if (wr == 0) PG8_BAR;
    PG8_BAR;
#undef PG8_SA
#undef PG8_SB
#undef PG8_STAGE
#undef PG8_LDA
#undef PG8_LDB
#undef PG8_MMA
#undef PG8_WAIT_V
#undef PG8_WAIT_L
#undef PG8_BAR
#undef PG8_SCHED
}
}

template <int MODE>
DI int wrow_map(int n) {
    if (MODE == 0) return n;
    if (MODE == 2) { if (n < 1280 || n >= 2304) return n;
        const int gi = (n - 1280) >> 6, d = (n - 1280) & 63, hi = d >> 5, f = d & 31, bj = f >> 4, fq = (f >> 2) & 3, jj = f & 3;
        return 256 * (5 + (gi >> 2)) + 128 * bj + 32 * (gi & 3) + 8 * fq + 2 * jj + hi; }
    if (MODE == 3) return (n & ~255) + 128 * ((n >> 5) & 1) + 32 * ((n >> 6) & 3) + (n & 31);
    const int isu = n >= DFF ? 1 : 0, j = n - isu * DFF; return 8 * (j >> 2) + 4 * isu + (j & 3); }
template <int MODE>
DI void p0_transpose_item(const float* W, int K, int N, bf16_t* WT, LAS float* scr, int item, int lane) {
    const int nblk = N / 32, kb = item / nblk, nb = item % nblk, k0 = 64 * kb, n0 = 32 * nb;
    float wv[32];
#pragma unroll
    for (int i = 0; i < 32; ++i) wv[i] = W[(size_t)(k0 + 2 * i + (lane >> 5)) * N + n0 + (lane & 31)];
#pragma unroll
    for (int i = 0; i < 32; ++i) scr[(2 * i + (lane >> 5)) * 33 + (lane & 31)] = wv[i];
    asm volatile("s_waitcnt lgkmcnt(0)" ::: "memory");
    const int c = lane & 7;
#pragma unroll
    for (int j = 0; j < 4; ++j) { const int n = (lane >> 3) + 8 * j; const LAS float* s = scr + (8 * c) * 33 + n;
        u32x4 o; o.x = pk2(s[0 * 33], s[1 * 33]); o.y = pk2(s[2 * 33], s[3 * 33]); o.z = pk2(s[4 * 33], s[5 * 33]); o.w = pk2(s[6 * 33], s[7 * 33]);
        *(u32x4*)(WT + (size_t)wrow_map<MODE>(n0 + n) * K + k0 + 8 * c) = o; }
    asm volatile("s_waitcnt lgkmcnt(0)" ::: "memory");
}

DI void phase0(const Params& p, LAS unsigned char* lds) {
    const int tid = opq(threadIdx.x), lane = tid & 63, wave = tid >> 6, G = gridDim.x;
    {
        LAS float* cact = (LAS float*)lds;
        float* mod = (float*)(p.ws + WS_MOD);
        constexpr int NITEM = NL * (MODW / 64);
        for (int it = blockIdx.x; it < NITEM; it += G) {
            const int l = it / (MODW / 64), n0 = (it % (MODW / 64)) * 64;
            for (int idx = tid; idx < NB * DM; idx += 512) { const int k = idx >> 5, b = idx & 31; const float v = p.c[b * DM + k]; cact[idx] = v * sigmoidf_fast(v); }
            __syncthreads();
            float acc[32];
#pragma unroll
            for (int b = 0; b < 32; ++b) acc[b] = 0.f;
            const float* wp = p.w_ada + ((size_t)l * DM + 128 * wave) * MODW + n0 + lane;
            const LAS f32x4* cp = (const LAS f32x4*)(cact + (128 * wave) * 32);
#pragma unroll 1
            for (int kk0 = 0; kk0 < 128; kk0 += 32) {
                float wv[32];
#pragma unroll
                for (int i = 0; i < 32; ++i) wv[i] = wp[(size_t)(kk0 + i) * MODW];
#pragma unroll
                for (int i = 0; i < 32; ++i) {
#pragma unroll
                    for (int q = 0; q < 8; ++q) { const f32x4 cv = cp[(kk0 + i) * 8 + q]; acc[4 * q] += cv[0] * wv[i]; acc[4 * q + 1] += cv[1] * wv[i]; acc[4 * q + 2] += cv[2] * wv[i]; acc[4 * q + 3] += cv[3] * wv[i]; }
                }
            }
            __syncthreads();
            LAS float* red = (LAS float*)lds;
#pragma unroll
            for (int b = 0; b < 32; ++b) red[(wave * 32 + b) * 64 + lane] = acc[b];
            __syncthreads();
#pragma unroll
            for (int j = 0; j < 4; ++j) { const int o = tid + 512 * j, b = o >> 6, n = o & 63; float s = p.b_ada[l * MODW + n0 + n];
#pragma unroll
                for (int w = 0; w < 8; ++w) s += red[(w * 32 + b) * 64 + n];
                mod[((size_t)l * NB + b) * MODW + n0 + n] = s; }
            __syncthreads();
        }
    }
    {
        LAS float* scr = (LAS float*)(lds + wave * 16384);
        const int gw = blockIdx.x * 8 + wave, NGW = G * 8;
        constexpr int I_IN = (DM / 64) * (INW / 32), I_OUT = (DM / 64) * (DM / 32), I_GU = (DM / 64) * (GU / 32), I_DN = (DFF / 64) * (DM / 32);
        constexpr int PER_L = I_IN + I_OUT + I_GU + I_DN;
        for (int it = gw; it < NL * PER_L; it += NGW) {
            const int l = it / PER_L; int r = it % PER_L;
            if (r < I_IN) { p0_transpose_item<2>(p.w_in + (size_t)l * DM * INW, DM, INW, (bf16_t*)(p.ws + WS_WT_IN) + (size_t)l * INW * DM, scr, r, lane); continue; } r -= I_IN;
            if (r < I_OUT) { p0_transpose_item<3>(p.w_out + (size_t)l * DM * DM, DM, DM, (bf16_t*)(p.ws + WS_WT_OUT) + (size_t)l * DM * DM, scr, r, lane); continue; } r -= I_OUT;
            if (r < I_GU) { p0_transpose_item<1>(p.w_gate_up + (size_t)l * DM * GU, DM, GU, (bf16_t*)(p.ws + WS_WT_GU) + (size_t)l * GU * DM, scr, r, lane); continue; } r -= I_GU;
            p0_transpose_item<3>(p.w_down + (size_t)l * DFF * DM, DFF, DM, (bf16_t*)(p.ws + WS_WT_DN) + (size_t)l * DM * DFF, scr, r, lane);
        }
    }
    {
        float* rc = (float*)(p.ws + WS_ROPE); float* rs = rc + SEQ * 32;
        for (int idx = blockIdx.x * 512 + tid; idx < SEQ * 32; idx += G * 512) {
            const int s = idx >> 5, i = idx & 31;
            double inv = 1.0, bpow = 0.7498942093324559;
#pragma unroll
            for (int bit = 0; bit < 5; ++bit) { if ((i >> bit) & 1) inv *= bpow; bpow *= bpow; }
            const double rev = (double)p.pos[s] * inv * 0.15915494309189535;
            const float fr = (float)(rev - floor(rev));
            rc[idx] = __builtin_amdgcn_cosf(fr); rs[idx] = __builtin_amdgcn_sinf(fr);
        }
    }
}

DI void phase_pre(const Params& p) {
    const int tid = opq(threadIdx.x), lane = tid & 63, wave = tid >> 6, G = gridDim.x, NGW = G * 8, gw = blockIdx.x * 8 + wave;
    const float* mod = (const float*)(p.ws + WS_MOD);
    {
        const int r = lane & 31, h = lane >> 5;
        constexpr int NBLK_IN = INW / 32, NBLK_GU = GU / 32, PER_L = NBLK_IN + NBLK_GU;
        for (int it = gw; it < NL * PER_L; it += NGW) {
            const int l = it / PER_L, q = it % PER_L; const bool isgu = q >= NBLK_IN; const int nb = isgu ? q - NBLK_IN : q;
            const bf16_t* W = isgu ? (const bf16_t*)(p.ws + WS_WT_GU) + ((size_t)l * GU + nb * 32 + r) * DM : (const bf16_t*)(p.ws + WS_WT_IN) + ((size_t)l * INW + nb * 32 + r) * DM;
            const float* sh = mod + ((size_t)l * NB + r) * MODW + (isgu ? 3 * DM : 0);
            f32x16 acc;
#pragma unroll
            for (int i = 0; i < 16; ++i) acc[i] = 0.f;
#pragma unroll 8
            for (int ks = 0; ks < DM / 16; ++ks) {
                const int k0 = ks * 16 + h * 8;
                const bf16x8 bfrag = *(const bf16x8*)(W + k0);
                const f32x4 s0 = *(const f32x4*)(sh + k0), s1 = *(const f32x4*)(sh + k0 + 4);
                u32x4 a; a.x = pk2(s0[0], s0[1]); a.y = pk2(s0[2], s0[3]); a.z = pk2(s1[0], s1[1]); a.w = pk2(s1[2], s1[3]);
                acc = __builtin_amdgcn_mfma_f32_32x32x16_bf16(__builtin_bit_cast(bf16x8, a), bfrag, acc, 0, 0, 0);
            }
            float* o = isgu ? (float*)(p.ws + WS_SHW_GU) + (size_t)l * NB * GU : (float*)(p.ws + WS_SHW_IN) + (size_t)l * NB * INW;
            const int ld = isgu ? GU : INW;
#pragma unroll
            for (int i = 0; i < 16; ++i) o[(size_t)((i & 3) + 8 * (i >> 2) + 4 * h) * ld + nb * 32 + r] = acc[i];
        }
    }
    {
        float* gm = (float*)(p.ws + WS_GM);
        for (int idx = blockIdx.x * 512 + tid; idx < NL * 2 * NB * DM; idx += G * 512) {
            const int k = idx & 1023, b = (idx >> 10) & 31, sx = (idx >> 15) & 1, l = idx >> 16;
            const float g = (sx ? p.norm2_g : p.norm1_g)[l * DM + k], sc = mod[((size_t)l * NB + b) * MODW + (sx ? 4 : 1) * DM + k];
            gm[idx] = g * (1.0f + sc);
        }
    }
    {
        bf16_t* H = (bf16_t*)(p.ws + WS_H); float* rowss = (float*)(p.ws + WS_ROWSS);
        for (int rb = gw; rb < MTOK / 32; rb += NGW) {
            const int b = (rb * 32) / SEQ;
            f32x4 gs[4];
#pragma unroll
            for (int j = 0; j < 4; ++j) { const int col = 4 * lane + 256 * j;
                const f32x4 gg = *(const f32x4*)(p.norm1_g + col), sc = *(const f32x4*)(mod + (size_t)b * MODW + DM + col);
                gs[j] = gg * (sc + 1.0f); }
            for (int r = 0; r < 32; r += 4) {
                const size_t row = (size_t)rb * 32 + r;
                const f32x4* xr = (const f32x4*)(p.x + row * DM) + lane;
                f32x4 v[4][4];
#pragma unroll
                for (int q = 0; q < 4; ++q)
#pragma unroll
                    for (int j = 0; j < 4; ++j) v[q][j] = xr[256 * q + 64 * j];
#pragma unroll
                for (int q = 0; q < 4; ++q) { float sq = 0.f;
#pragma unroll
                    for (int j = 0; j < 4; ++j) sq += (v[q][j][0] * v[q][j][0] + v[q][j][1] * v[q][j][1]) + (v[q][j][2] * v[q][j][2] + v[q][j][3] * v[q][j][3]);
                    sq = wave_sum(sq);
                    if (lane < 16) rowss[(row + q) * 16 + lane] = (lane == 0) ? sq : 0.f;
                    u32x2* o8 = (u32x2*)(H + (row + q) * DM) + lane; h16x4* x8 = (h16x4*)((_Float16*)(p.ws + WS_X16) + (row + q) * DM) + lane;
#pragma unroll
                    for (int j = 0; j < 4; ++j) { const f32x4 y = v[q][j] * gs[j]; u32x2 w; w.x = pk2(y[0], y[1]); w.y = pk2(y[2], y[3]); o8[64 * j] = w; x8[64 * j] = __builtin_convertvector(v[q][j], h16x4); } }
            }
        }
    }
}

DI void phase_prep(const Params& p, int l, LAS unsigned char* lds) {
    const int tid = opq(threadIdx.x), lane = tid & 63, wave = tid >> 6, G = gridDim.x;
    const bf16_t* Z = (const bf16_t*)(p.ws + WS_Z);
    bf16_t* MIX = (bf16_t*)(p.ws + WS_MIX);
    LAS float* U = (LAS float*)lds;
    LAS float* CV = (LAS float*)(lds + 65536);
    const int cch = tid & 255, th = tid >> 8;
    float cw[31];
#pragma unroll
    for (int j = 0; j < 31; ++j) cw[j] = p.conv_a_w[((size_t)l * 31 + j) * 256 + cch];
    const float cbias = p.conv_a_b[l * 256 + cch];
    const f32x4 ga = *(const f32x4*)(p.conv_a_norm_g + l * 256 + 4 * lane);
    const f32x4 gb = *(const f32x4*)(p.sc_norm_g + l * 256 + 4 * lane);
    f32x4 wb[3];
#pragma unroll
    for (int j = 0; j < 3; ++j) wb[j] = *(const f32x4*)(p.conv_b_w + ((size_t)l * 3 + j) * 256 + 4 * lane);

    const int pvcu = (G % 8 == 0) ? ((blockIdx.x & 7) * (G >> 3) + (blockIdx.x >> 3)) : blockIdx.x;
    for (int it = pvcu; it < MTOK / 32; it += G) {
        const int b = it >> 6, t0 = (it & 63) * 32;
        const size_t tokbase = (size_t)b * SEQ;
        u32x4 av[4], ag[4];
#pragma unroll
        for (int k4 = 0; k4 < 4; ++k4) { const int ci = tid + 512 * k4, row = ci >> 5, ch8 = ci & 31, tok = t0 - 15 + row;
            av[k4] = (u32x4){0u, 0u, 0u, 0u}; ag[k4] = av[k4];
            if (ci < 62 * 32 && tok >= 0 && tok < SEQ) { const bf16_t* zp = Z + (tokbase + tok) * INW + ch8 * 8; av[k4] = *(const u32x4*)zp; ag[k4] = *(const u32x4*)(zp + 256); } }
        const int tw = t0 + wave * 4;
        u32x2 bcg[6], bhv[6], bbg[4];
#pragma unroll
        for (int r = 0; r < 6; ++r) { const int tok = tw - 1 + r; bcg[r] = (u32x2){0u, 0u}; bhv[r] = bcg[r];
            if (tok >= 0 && tok < SEQ) { const bf16_t* zp = Z + (tokbase + tok) * INW + 512 + 4 * lane; bcg[r] = *(const u32x2*)(zp + 256); bhv[r] = *(const u32x2*)(zp + 512);
                if (r >= 1 && r <= 4) bbg[r - 1] = *(const u32x2*)zp; } }
#pragma unroll
        for (int k4 = 0; k4 < 4; ++k4) { const int ci = tid + 512 * k4, row = ci >> 5, ch8 = ci & 31;
            if (ci < 62 * 32) { const u32x4 v = av[k4], gt = ag[k4]; f32x4 o0, o1;
                o0[0] = bf_lo(v.x) * sigmoidf_fast(bf_lo(gt.x)); o0[1] = bf_hi(v.x) * sigmoidf_fast(bf_hi(gt.x));
                o0[2] = bf_lo(v.y) * sigmoidf_fast(bf_lo(gt.y)); o0[3] = bf_hi(v.y) * sigmoidf_fast(bf_hi(gt.y));
                o1[0] = bf_lo(v.z) * sigmoidf_fast(bf_lo(gt.z)); o1[1] = bf_hi(v.z) * sigmoidf_fast(bf_hi(gt.z));
                o1[2] = bf_lo(v.w) * sigmoidf_fast(bf_lo(gt.w)); o1[3] = bf_hi(v.w) * sigmoidf_fast(bf_hi(gt.w));
                *(LAS f32x4*)(U + row * 256 + ch8 * 8) = o0; *(LAS f32x4*)(U + row * 256 + ch8 * 8 + 4) = o1; } }
        __syncthreads();
#pragma unroll 1
        for (int chunk = 0; chunk < 2; ++chunk) {
            const int tb = th * 16 + chunk * 8;
            float uu[38];
#pragma unroll
            for (int i = 0; i < 38; ++i) uu[i] = U[(tb + i) * 256 + cch];
#pragma unroll
            for (int t = 0; t < 8; ++t) { float a = cbias;
#pragma unroll
                for (int j = 0; j < 31; ++j) a += cw[j] * uu[t + j];
                CV[(tb + t) * 256 + cch] = a; }
        }
        __syncthreads();
#pragma unroll
        for (int q = 0; q < 4; ++q) { const int t = wave * 4 + q;
            const f32x4 v = *(const LAS f32x4*)(CV + t * 256 + 4 * lane);
            const float ss = wave_sum((v[0] * v[0] + v[1] * v[1]) + (v[2] * v[2] + v[3] * v[3]));
            const f32x4 y = v * rsqrtf(ss * (1.f / 256.f) + EPS) * ga;
            f32x4 o;
#pragma unroll
            for (int i = 0; i < 4; ++i) o[i] = y[i] * sigmoidf_fast(y[i]);
            u32x2 w; w.x = pk2(o[0], o[1]); w.y = pk2(o[2], o[3]);
            *(u32x2*)(MIX + (tokbase + t0 + t) * DM + 4 * lane) = w; }
        {
            f32x4 mrow[6], bgv[4];
#pragma unroll
            for (int r = 0; r < 6; ++r) { mrow[r][0] = bf_lo(bcg[r].x) * bf_lo(bhv[r].x); mrow[r][1] = bf_hi(bcg[r].x) * bf_hi(bhv[r].x); mrow[r][2] = bf_lo(bcg[r].y) * bf_lo(bhv[r].y); mrow[r][3] = bf_hi(bcg[r].y) * bf_hi(bhv[r].y); }
#pragma unroll
            for (int q = 0; q < 4; ++q) { bgv[q][0] = bf_lo(bbg[q].x); bgv[q][1] = bf_hi(bbg[q].x); bgv[q][2] = bf_lo(bbg[q].y); bgv[q][3] = bf_hi(bbg[q].y); }
#pragma unroll
            for (int q = 0; q < 4; ++q) {
                const f32x4 y = bgv[q] * (wb[0] * mrow[q] + wb[1] * mrow[q + 1] + wb[2] * mrow[q + 2]);
                const float ss = wave_sum((y[0] * y[0] + y[1] * y[1]) + (y[2] * y[2] + y[3] * y[3]));
                const f32x4 o = y * rsqrtf(ss * (1.f / 256.f) + EPS) * gb;
                u32x2 w; w.x = pk2(o[0], o[1]); w.y = pk2(o[2], o[3]);
                *(u32x2*)(MIX + (tokbase + tw + q) * DM + 256 + 4 * lane) = w; }
        }
        __syncthreads();
    }
}

constexpr int KROW = 272, VROW = 320, KBYTES = 64 * KROW, VBYTES = 64 * VROW, ABUF = KBYTES + VBYTES;
typedef short s16x4 __attribute__((ext_vector_type(4)));
#define MFMA32(a, b, c) __builtin_amdgcn_mfma_f32_32x32x16_bf16((a), (b), (c), 0, 0, 0)

DI void phase_attn(const Params& p, int l, float lambda_init, LAS unsigned char* lds) {
    const int tid = opq(threadIdx.x), lane = tid & 63, wave = tid >> 6, G = gridDim.x, r = lane & 31, h = lane >> 5;
    const int rg = wave >> 1, hf = wave & 1;
    const bf16_t* Z = (const bf16_t*)(p.ws + WS_Z);
    const bf16_t* QH = (const bf16_t*)(p.ws + WS_QH); const bf16_t* KH = (const bf16_t*)(p.ws + WS_KH);
    bf16_t* MIX = (bf16_t*)(p.ws + WS_MIX);
    const float sa = wave_sum(p.lam_q1[l * 64 + lane] * p.lam_k1[l * 64 + lane]), sb = wave_sum(p.lam_q2[l * 64 + lane] * p.lam_k2[l * 64 + lane]);
    const float lam = expf(sa) - expf(sb) + lambda_init;
    const float oscale = 1.0f - lambda_init;
    const int kkey = tid >> 3, kch = tid & 7;
    const int vtr = (4 * (lane >> 5) + ((lane >> 2) & 3)) * VROW + (16 * ((lane >> 4) & 1) + 4 * (lane & 3)) * 2;
    const int vcu = (G % 8 == 0) ? ((blockIdx.x & 7) * (G >> 3) + (blockIdx.x >> 3)) : blockIdx.x;
    LAS float* X = (LAS float*)lds + rg * (128 * 32);

    bf16x8 qf[4]; u32x4 krA[2], vrA[2], krB[2], vrB[2];
#define ATT_ITEM_PTRS(it_) const int qblk = (it_) & 15, head = ((it_) >> 4) & 3, b = (it_) >> 6; const size_t tokb = (size_t)b * SEQ; \
        const size_t qtok = tokb + qblk * 128 + rg * 32 + r; \
        const bf16_t* kg = KH + (tokb + kkey) * 512 + head * 128 + kch * 8; const bf16_t* vg = Z + (tokb + kkey) * INW + 2304 + head * 128 + kch * 8;
#define ATT_LOAD(KR, VR, t_) do { const bf16_t* kg2_ = kg + (size_t)(t_) * 64 * 512; const bf16_t* vg2_ = vg + (size_t)(t_) * 64 * INW; \
            KR[0] = *(const u32x4*)kg2_; KR[1] = *(const u32x4*)(kg2_ + 64); VR[0] = *(const u32x4*)vg2_; VR[1] = *(const u32x4*)(vg2_ + 64); } while (0)
#define ATT_ITEM_PREFETCH() do { ATT_LOAD(krA, vrA, 0); ATT_LOAD(krB, vrB, 1); \
            _Pragma("unroll") for (int kk = 0; kk < 4; ++kk) qf[kk] = *(const bf16x8*)(QH + qtok * 512 + head * 128 + hf * 64 + kk * 16 + h * 8); } while (0)
    if (vcu < NB * 4 * 16) { ATT_ITEM_PTRS(vcu); ATT_ITEM_PREFETCH(); }
    for (int it = vcu; it < NB * 4 * 16; it += G) {
        ATT_ITEM_PTRS(it);
        f32x16 o[4];
#pragma unroll
        for (int eb = 0; eb < 4; ++eb)
#pragma unroll
            for (int i = 0; i < 16; ++i) o[eb][i] = 0.f;
        float lsum = 0.f;
#define ATT_WRITE(KR, VR, buf) do { LAS unsigned char* kb_ = lds + (buf) * ABUF; LAS unsigned char* vb_ = kb_ + KBYTES; \
            *(LAS u32x4*)(kb_ + kkey * KROW + kch * 16) = KR[0]; *(LAS u32x4*)(kb_ + kkey * KROW + kch * 16 + 128) = KR[1]; \
            *(LAS u32x4*)(vb_ + kkey * VROW + kch * 16) = VR[0]; *(LAS u32x4*)(vb_ + kkey * VROW + kch * 16 + 128) = VR[1]; } while (0)
#define ATT_COMPUTE(buf) do { const LAS unsigned char* kb = lds + (buf) * ABUF; LAS unsigned char* vb = lds + (buf) * ABUF + KBYTES; \
            _Pragma("unroll") for (int kbk = 0; kbk < 2; ++kbk) { \
                f32x16 s; \
                _Pragma("unroll") for (int i = 0; i < 16; ++i) s[i] = 0.f; \
                _Pragma("unroll") for (int kk = 0; kk < 4; ++kk) { const bf16x8 a = *(const LAS bf16x8*)(kb + (kbk * 32 + r) * KROW + hf * 128 + kk * 32 + h * 16); s = MFMA32(a, qf[kk], s); } \
                float ls = 0.f; \
                _Pragma("unroll") for (int i = 0; i < 16; ++i) { s[i] = __builtin_amdgcn_exp2f(s[i]); ls += s[i]; } \
                lsum += ls; \
                bf16x8 pf[2]; \
                _Pragma("unroll") for (int st = 0; st < 2; ++st) { u32x4 w; w.x = pk2(s[8 * st], s[8 * st + 1]); w.y = pk2(s[8 * st + 2], s[8 * st + 3]); w.z = pk2(s[8 * st + 4], s[8 * st + 5]); w.w = pk2(s[8 * st + 6], s[8 * st + 7]); \
                    pf[st] = __builtin_bit_cast(bf16x8, w); } \
                _Pragma("unroll") for (int st = 0; st < 2; ++st) \
                    _Pragma("unroll") for (int eb = 0; eb < 4; ++eb) { \
                        const s16x4 vlo = __builtin_amdgcn_ds_read_tr16_b64_v4i16((LAS s16x4*)(vb + vtr + (kbk * 32 + st * 16) * VROW + eb * 64)); \
                        const s16x4 vhi = __builtin_amdgcn_ds_read_tr16_b64_v4i16((LAS s16x4*)(vb + vtr + (kbk * 32 + st * 16 + 8) * VROW + eb * 64)); \
                        const bf16x8 vf = __builtin_shufflevector(vlo, vhi, 0, 1, 2, 3, 4, 5, 6, 7); \
                        o[eb] = MFMA32(vf, pf[st], o[eb]); } \
            } } while (0)
        ATT_WRITE(krA, vrA, 0);
        ATT_LOAD(krA, vrA, 2);
        __syncthreads();
#pragma unroll 1
        for (int t = 0; t < SEQ / 64; t += 2) {
            ATT_COMPUTE(0);
            ATT_WRITE(krB, vrB, 1);
            if (t + 3 < SEQ / 64) ATT_LOAD(krB, vrB, t + 3);
            __syncthreads();
            ATT_COMPUTE(1);
            if (t + 2 < SEQ / 64) { ATT_WRITE(krA, vrA, 0);
                if (t + 4 < SEQ / 64) ATT_LOAD(krA, vrA, t + 4); }
            __syncthreads();
        }
#undef ATT_COMPUTE
        bf16_t* orow = MIX + qtok * DM + 512 + head * 128;
        if (it + G < NB * 4 * 16) { ATT_ITEM_PTRS(it + G); ATT_ITEM_PREFETCH(); }
        const float lt = lsum + __shfl_xor(lsum, 32);
        if (hf == 1) {
            const float sc1 = lam / lt;
#pragma unroll
            for (int eb = 0; eb < 4; ++eb)
#pragma unroll
                for (int i = 0; i < 16; ++i) X[(eb * 32 + (i & 3) + 8 * (i >> 2) + 4 * h) * 32 + r] = o[eb][i] * sc1;
        }
        __syncthreads();
        if (hf == 0) {
            const float i0 = 1.0f / lt;
            float ss = 0.f;
#pragma unroll
            for (int eb = 0; eb < 4; ++eb)
#pragma unroll
                for (int i = 0; i < 16; ++i) { const float v = o[eb][i] * i0 - X[(eb * 32 + (i & 3) + 8 * (i >> 2) + 4 * h) * 32 + r]; o[eb][i] = v; ss += v * v; }
            ss += __shfl_xor(ss, 32);
            const float rn = rsqrtf(ss * (1.f / 128.f) + EPS) * oscale;
#pragma unroll
            for (int eb = 0; eb < 4; ++eb)
#pragma unroll
                for (int g4 = 0; g4 < 4; ++g4) { const int e = eb * 32 + 8 * g4 + 4 * h;
                    const f32x4 gg = *(const f32x4*)(p.attn_norm_g + l * 128 + e);
                    u32x2 w; w.x = pk2(o[eb][4 * g4] * rn * gg[0], o[eb][4 * g4 + 1] * rn * gg[1]); w.y = pk2(o[eb][4 * g4 + 2] * rn * gg[2], o[eb][4 * g4 + 3] * rn * gg[3]);
                    *(u32x2*)(orow + e) = w; }
        }
        __syncthreads();
    }
#undef ATT_WRITE
#undef ATT_LOAD
#undef ATT_ITEM_PTRS
#undef ATT_ITEM_PREFETCH
}

#define XB_TMO      128
#define XB_XCNT(j)  (256  + 64 * (j))
#define XB_XSUB(j)  (1280 + 64 * (j))
#define XB_XGEN(j)  (2304 + 64 * (j))
#define XB_TOP      3328
#define XB_TOPGEN   3392
#define XCD_BAR_WORDS 3456
#define XB_SPIN_CAP (1u << 20)
DI unsigned xb_ld(unsigned* p)              { return __hip_atomic_load(p, __ATOMIC_RELAXED, __HIP_MEMORY_SCOPE_AGENT); }
DI unsigned xb_add(unsigned* p, unsigned v) { return __hip_atomic_fetch_add(p, v, __ATOMIC_RELAXED, __HIP_MEMORY_SCOPE_AGENT); }
DI unsigned xb_xcc_id() { return (unsigned)__builtin_amdgcn_s_getreg((3 << 11) | 20) & 0xFu; }
#define XB_SPIN(cond, bar) do { unsigned _sp = 0; while (cond) { __builtin_amdgcn_s_sleep(1); \
    if ((++_sp & 255u) == 0u) { if (xb_ld(&(bar)[XB_TMO])) break; if (_sp > XB_SPIN_CAP) { atomicAdd(&(bar)[XB_TMO], 1u); break; } } } } while (0)
struct XcdBarrier { unsigned* bar; unsigned x; volatile LAS unsigned* st; };
DI XcdBarrier xcd_barrier_post(unsigned* bar, volatile LAS unsigned* st) {
    XcdBarrier b; b.bar = bar; b.x = xb_xcc_id(); b.st = st;
    if (threadIdx.x == 0) (void)xb_add(&bar[XB_XCNT(b.x)], 1u);
    return b;
}
DI void xcd_barrier_complete(unsigned* bar, unsigned x, unsigned& nloc, unsigned& nx) {
    const unsigned G = gridDim.x * gridDim.y * gridDim.z;
    unsigned sum, cnt, mine, sp = 0u;
    for (;;) {
        sum = 0u; cnt = 0u; mine = 0u;
#pragma unroll
        for (unsigned j = 0; j < 16; ++j) { const unsigned c = xb_ld(&bar[XB_XCNT(j)]); sum += c; cnt += (c > 0u) ? 1u : 0u; mine = (j == x) ? c : mine; }
        if (sum == G) break;
        __builtin_amdgcn_s_sleep(1);
        if ((++sp & 255u) == 0u) { if (xb_ld(&bar[XB_TMO])) break; if (sp > XB_SPIN_CAP) { atomicAdd(&bar[XB_TMO], 1u); break; } }
    }
    nloc = mine > 0u ? mine : 1u; nx = cnt > 0u ? cnt : 1u;
}
DI void xcd_barrier(const XcdBarrier& b) {
    asm volatile("s_waitcnt vmcnt(0)" ::: "memory");
    __syncthreads();
    if (threadIdx.x == 0) {
        unsigned* bar = b.bar;
        __builtin_amdgcn_s_waitcnt(0);
        unsigned nloc = b.st[0], nx = b.st[1];
        if (nloc == 0u) { xcd_barrier_complete(bar, b.x, nloc, nx); b.st[0] = nloc; b.st[1] = nx; }
        const unsigned old = xb_add(&bar[XB_XSUB(b.x)], 1u);
        const unsigned gen = old / nloc;
        if (old + 1u == (gen + 1u) * nloc) {
            __builtin_amdgcn_fence(__ATOMIC_RELEASE, "agent");
            asm volatile("s_waitcnt vmcnt(0)" ::: "memory");
            const unsigned og = xb_add(&bar[XB_TOP], 1u);
            const unsigned tg = og / nx;
            if (og + 1u == (tg + 1u) * nx) xb_add(&bar[XB_TOPGEN], 1u);
            else XB_SPIN(xb_ld(&bar[XB_TOPGEN]) == tg, bar);
            __builtin_amdgcn_fence(__ATOMIC_ACQUIRE, "agent");
            xb_add(&bar[XB_XGEN(b.x)], 1u);
            asm volatile("s_waitcnt vmcnt(0)" ::: "memory");
        } else {
            XB_SPIN(xb_ld(&bar[XB_XGEN(b.x)]) == gen, bar);
            __builtin_amdgcn_fence(__ATOMIC_ACQUIRE, "agent");
            asm volatile("s_waitcnt vmcnt(0)" ::: "memory");
        }
    }
    __syncthreads();
}

__global__ void __launch_bounds__(512, 2) fwd_megakernel(Params p) {
    extern __shared__ __attribute__((aligned(16))) unsigned char shm[];
    LAS unsigned char* lds = (LAS unsigned char*)shm;
    cg::grid_group grid = cg::this_grid();
    const int G = gridDim.x, c = blockIdx.x;
    float* mod = (float*)(p.ws + WS_MOD);
    bf16_t* H = (bf16_t*)(p.ws + WS_H); bf16_t* Zb = (bf16_t*)(p.ws + WS_Z); bf16_t* MIX = (bf16_t*)(p.ws + WS_MIX);
    volatile LAS unsigned* bst = (volatile LAS unsigned*)(lds + 131072);
    if (threadIdx.x < 4) bst[threadIdx.x] = 0u;
    __syncthreads();
    const XcdBarrier xb = xcd_barrier_post((unsigned*)(p.ws + WS_BAR), bst);
    float* rowss = (float*)(p.ws + WS_ROWSS);
    for (int ph = p.ph_lo; ph < p.ph_hi; ++ph) {
        if (ph > p.ph_lo) { if (ph == p.ph_lo + 1) grid.sync(); else xcd_barrier(xb); }
        if (ph == 0) { phase0(p, lds); continue; }
        if (ph == 1) { phase_pre(p); continue; }
        const int l = (ph - 2) / 5, s5 = (ph - 2) % 5, sub = s5 + (s5 >= 2 ? 1 : 0);
        const float* modl = mod + (size_t)l * NB * MODW;
        float* rs1 = rowss + (size_t)(2 * l) * MTOK * 16; float* rs2 = rs1 + (size_t)MTOK * 16;
        const float* gml = (const float*)(p.ws + WS_GM) + (size_t)l * 2 * NB * DM;
        if (sub == 0) { pg8::StaticOrder S; S.init(MTOK, INW, G, c); pg8::Gemm g{H, (const bf16_t*)(p.ws + WS_WT_IN) + (size_t)l * INW * DM, MTOK, INW, DM};
            pg8::EpiZ E{Zb, INW, rs1, (const float*)(p.ws + WS_SHW_IN) + (size_t)l * NB * INW, (bf16_t*)(p.ws + WS_QH), (bf16_t*)(p.ws + WS_KH), p.q_norm_g + l * 64, p.k_norm_g + l * 64, (const float*)(p.ws + WS_ROPE), (const float*)(p.ws + WS_ROPE) + SEQ * 32}; pg8::gemm_phase(lds, g, S, E); }
        else if (sub == 1) { phase_prep(p, l, lds); const float lambda_init = 0.8f - 0.6f * expf(-0.3f * (float)l); phase_attn(p, l, lambda_init, lds); }
        else if (sub == 3 || sub == 5) {
            pg8::StaticOrder S; S.init(MTOK, DM, G, c);
            pg8::Gemm g; pg8::EpiRes E;
            _Float16* X16 = (_Float16*)(p.ws + WS_X16);
            if (sub == 3) { g = pg8::Gemm{MIX, (const bf16_t*)(p.ws + WS_WT_OUT) + (size_t)l * DM * DM, MTOK, DM, DM}; E = pg8::EpiRes{X16, X16, nullptr, modl + 2 * DM, gml + NB * DM, H, rs2}; }
            else { const bool lastl = (l == NL - 1);
                g = pg8::Gemm{Zb, (const bf16_t*)(p.ws + WS_WT_DN) + (size_t)l * DM * DFF, MTOK, DM, DFF};
                E = pg8::EpiRes{X16, X16, lastl ? p.out : nullptr, modl + 5 * DM, lastl ? nullptr : gml + 2 * NB * DM, H, lastl ? nullptr : rs1 + (size_t)2 * MTOK * 16}; }
            pg8::gemm_phase(lds, g, S, E); }
        else { pg8::StaticOrder S; S.init(MTOK, GU, G, c); pg8::Gemm g{H, (const bf16_t*)(p.ws + WS_WT_GU) + (size_t)l * GU * DM, MTOK, GU, DM};
            pg8::EpiSwiGLU E{Zb, rs2, (const float*)(p.ws + WS_SHW_GU) + (size_t)l * NB * GU}; pg8::gemm_phase(lds, g, S, E); }
    }
}

extern "C" void kernel_launch(void* const* d_in, const int* in_sizes, int n_in, void* d_out, int out_size, void* d_ws, size_t ws_size, hipStream_t stream) {
    static int grid = 0;
    if (grid == 0) {
        if (n_in != 23 || ws_size < WS_END) { fprintf(stderr, "kernel_launch: unexpected n_in %d or ws_size %zu < %zu\n", n_in, ws_size, (size_t)WS_END); grid = -1; return; }
        int dev = 0, cus = 0, per_cu = 0;
        if (hipGetDevice(&dev) != hipSuccess || hipDeviceGetAttribute(&cus, hipDeviceAttributeMultiprocessorCount, dev) != hipSuccess) { grid = -1; return; }
        if (hipFuncSetAttribute((const void*)fwd_megakernel, hipFuncAttributeMaxDynamicSharedMemorySize, LDS_BYTES) != hipSuccess) { fprintf(stderr, "kernel_launch: hipFuncSetAttribute failed\n"); grid = -1; return; }
        if (hipOccupancyMaxActiveBlocksPerMultiprocessor(&per_cu, (const void*)fwd_megakernel, 512, LDS_BYTES) != hipSuccess || per_cu < 1) { fprintf(stderr, "kernel_launch: occupancy query says %d\n", per_cu); per_cu = 1; }
        (void)hipGetLastError();
        grid = cus;
    }
    if (grid < 0) return;
    if (hipMemsetAsync((char*)d_ws + WS_BAR, 0, 16384, stream) != hipSuccess) { fprintf(stderr, "kernel_launch: memset of the barrier word failed\n"); return; }
    Params p{};
    p.x = (const float*)d_in[0]; p.c = (const float*)d_in[1]; p.pos = (const int*)d_in[2];
    p.norm1_g = (const float*)d_in[3]; p.norm2_g = (const float*)d_in[4]; p.w_ada = (const float*)d_in[5]; p.b_ada = (const float*)d_in[6];
    p.w_in = (const float*)d_in[7]; p.conv_a_w = (const float*)d_in[8]; p.conv_a_b = (const float*)d_in[9]; p.conv_a_norm_g = (const float*)d_in[10];
    p.conv_b_w = (const float*)d_in[11]; p.sc_norm_g = (const float*)d_in[12]; p.q_norm_g = (const float*)d_in[13]; p.k_norm_g = (const float*)d_in[14];
    p.lam_q1 = (const float*)d_in[15]; p.lam_k1 = (const float*)d_in[16]; p.lam_q2 = (const float*)d_in[17]; p.lam_k2 = (const float*)d_in[18];
    p.attn_norm_g = (const float*)d_in[19]; p.w_out = (const float*)d_in[20]; p.w_gate_up = (const float*)d_in[21]; p.w_down = (const float*)d_in[22];
    p.out = (float*)d_out; p.ws = (unsigned char*)d_ws;
#if MK_MULTI
    for (int ph = 0; ph < NPHASE; ++ph) {
        p.ph_lo = ph; p.ph_hi = ph + 1;
        hipLaunchKernelGGL(fwd_megakernel, dim3(grid), dim3(512), LDS_BYTES, stream, p);
    }
#else
    p.ph_lo = 0; p.ph_hi = NPHASE;
    void* args[] = {&p};
    hipError_t e = hipLaunchCooperativeKernel((const void*)fwd_megakernel, dim3(grid), dim3(512), args, LDS_BYTES, stream);
    if (e != hipSuccess) fprintf(stderr, "kernel_launch: cooperative launch failed: %s (grid %d)\n", hipGetErrorString(e), grid);
#endif
}
```

```cpp
#include <hip/hip_runtime.h>
#include <hip/hip_cooperative_groups.h>
#include <cstdio>
namespace cg = cooperative_groups;

#ifndef MK_MULTI
#define MK_MULTI 0
#endif

#define LAS __attribute__((address_space(3)))
#define DI __device__ __forceinline__
typedef unsigned short bf16_t;
typedef short bf16x8 __attribute__((ext_vector_type(8)));
typedef float f32x4 __attribute__((ext_vector_type(4)));
typedef float f32x2 __attribute__((ext_vector_type(2)));
typedef float f32x16 __attribute__((ext_vector_type(16)));
typedef unsigned u32x4 __attribute__((ext_vector_type(4)));
typedef unsigned u32x2 __attribute__((ext_vector_type(2)));
typedef __bf16 bf16x2n __attribute__((ext_vector_type(2)));
typedef _Float16 h16x8 __attribute__((ext_vector_type(8)));
typedef _Float16 h16x4 __attribute__((ext_vector_type(4)));
typedef float f32x8 __attribute__((ext_vector_type(8)));

constexpr int NB = 32, SEQ = 2048, DM = 1024, MTOK = NB * SEQ, NL = 4, INW = 2816, DFF = 2816, GU = 2 * DFF;
constexpr int MODW = 6 * DM;
constexpr float EPS = 1e-6f;
constexpr float LOG2E = 1.4426950408889634f;
constexpr int LDS_BYTES = 131072 + 16;
constexpr int NPHASE = 2 + 5 * NL;

constexpr size_t WS_WT_IN = 0;
constexpr size_t WS_WT_OUT = WS_WT_IN + (size_t)NL * INW * DM * 2;
constexpr size_t WS_WT_GU = WS_WT_OUT + (size_t)NL * DM * DM * 2;
constexpr size_t WS_WT_DN = WS_WT_GU + (size_t)NL * GU * DM * 2;
constexpr size_t WS_MOD = WS_WT_DN + (size_t)NL * DM * DFF * 2;
constexpr size_t WS_ROPE = WS_MOD + (size_t)NL * NB * MODW * 4;
constexpr size_t WS_H = WS_ROPE + (size_t)2 * SEQ * 32 * 4;
constexpr size_t WS_Z = WS_H + (size_t)MTOK * DM * 2;
constexpr size_t WS_QH = WS_Z + (size_t)MTOK * INW * 2;
constexpr size_t WS_KH = WS_QH + (size_t)MTOK * 512 * 2;
constexpr size_t WS_MIX = WS_KH + (size_t)MTOK * 512 * 2;
constexpr size_t WS_ROWSS = WS_MIX + (size_t)MTOK * DM * 2;
constexpr size_t WS_SHW_IN = WS_ROWSS + (size_t)NL * 2 * MTOK * 16 * 4;
constexpr size_t WS_SHW_GU = WS_SHW_IN + (size_t)NL * NB * INW * 4;
constexpr size_t WS_GM = WS_SHW_GU + (size_t)NL * NB * GU * 4;
constexpr size_t WS_X16 = WS_GM + (size_t)NL * 2 * NB * DM * 4;
constexpr size_t WS_BAR = WS_X16 + (size_t)MTOK * DM * 2;
constexpr size_t WS_END = WS_BAR + 16384;

struct Params {
    const float* x; const float* c; const int* pos;
    const float *norm1_g, *norm2_g, *w_ada, *b_ada, *w_in, *conv_a_w, *conv_a_b, *conv_a_norm_g, *conv_b_w, *sc_norm_g,
        *q_norm_g, *k_norm_g, *lam_q1, *lam_k1, *lam_q2, *lam_k2, *attn_norm_g, *w_out, *w_gate_up, *w_down;
    float* out; unsigned char* ws;
    int ph_lo, ph_hi;
};

DI unsigned pk2(float lo, float hi) { f32x2 v = {lo, hi}; return __builtin_bit_cast(unsigned, __builtin_convertvector(v, bf16x2n)); }
DI float bf_lo(unsigned u) { return __uint_as_float(u << 16); }
DI float bf_hi(unsigned u) { return __uint_as_float(u & 0xffff0000u); }
DI float wave_sum(float v) {
#pragma unroll
    for (int o = 1; o < 64; o <<= 1) v += __shfl_xor(v, o);
    return v;
}
DI float wave_max(float v) {
#pragma unroll
    for (int o = 1; o < 64; o <<= 1) v = fmaxf(v, __shfl_xor(v, o));
    return v;
}
DI int opq(int v) { asm volatile("" : "+v"(v)); return v; }
DI float sigmoidf_fast(float v) { return __builtin_amdgcn_rcpf(1.0f + __builtin_amdgcn_exp2f(-v * LOG2E)); }

namespace pg8 {
constexpr int BM = 256, BK = 64, HALF = 128, HTB = HALF * BK * 2, NXCD = 8, WGM = 8;
DI int lds_byte(int r, int c) { const int st = (r >> 4) * 2 + (c >> 5), rr = r & 15, cc = c & 31, ob = rr * 64 + cc * 2; return st * 1024 + (ob ^ (((ob >> 9) & 1) << 5)); }
DI void stage_rc(int b, int& R, int& C) { const int st = b / 1024, sb = b % 1024, swz = sb ^ (((sb >> 9) & 1) << 5); R = (st >> 1) * 16 + swz / 64; C = (st & 1) * 32 + (swz % 64) / 2; }
DI int perm32(int rho) { const int n = rho >> 4, i = rho & 15; return 8 * (i >> 2) + 4 * n + (i & 3); }
struct Unit { int pm, pn; };
struct Gemm { const bf16_t* A; const bf16_t* Bt; int M, N, K; };
struct StaticOrder {
    int nM, nN, nwg, G, c;
    DI void init(int M, int N, int G_, int c_) { nM = M / BM; nN = N / BM; nwg = nM * nN; G = G_; c = c_; }
    DI bool next(int i, Unit& u) const {
        const long L = (long)i * G + c; if (L >= nwg) return false;
        int wgid = (int)L; { const int q = nwg / NXCD, r = nwg % NXCD, xcd = wgid % NXCD, off = wgid / NXCD; wgid = (xcd < r ? xcd * (q + 1) : r * (q + 1) + (xcd - r) * q) + off; }
        const int nig = WGM * nN, gid = wgid / nig, fm = gid * WGM, gsz = (nM - fm) < WGM ? (nM - fm) : WGM;
        u.pm = fm + ((wgid % nig) % gsz); u.pn = (wgid % nig) / gsz; return true;
    }
};

DI void row_rstd8(const float* rowss, int row0, int fq, float (&rstd)[2][4]) {
    f32x4 pr[2][4];
#pragma unroll
    for (int ai = 0; ai < 2; ++ai)
#pragma unroll
        for (int m = 0; m < 4; ++m) pr[ai][m] = *(const f32x4*)(rowss + (size_t)(row0 + ai * HALF + m * 16) * 16 + 4 * fq);
#pragma unroll
    for (int ai = 0; ai < 2; ++ai)
#pragma unroll
        for (int m = 0; m < 4; ++m) { float t = (pr[ai][m][0] + pr[ai][m][1]) + (pr[ai][m][2] + pr[ai][m][3]);
            t += __shfl_xor(t, 16); t += __shfl_xor(t, 32);
            rstd[ai][m] = rsqrtf(t * (1.f / DM) + EPS); }
}
DI void warm_panel(const float* rowss, int c, int tid) {
    const int panel = 32 * (c & 7) + ((c >> 3) & 31);
    const u32x4* src = (const u32x4*)(rowss + (size_t)panel * 256 * 16) + tid;
    const u32x4 a = src[0], b = src[512];
    asm volatile("" :: "v"(a), "v"(b));
}
struct EpiZ {
    static constexpr bool PERM = true;
    bf16_t* O; int ldc; const float* rowss; const float* shw;
    bf16_t* QH; bf16_t* KH; const float* gq; const float* gk; const float* rc; const float* rs;
    DI void warm_phase(int c, int tid) const { warm_panel(rowss, c, tid); }
    DI void operator()(const f32x4 (&acc)[2][2][4][2], const Unit& u, int wr, int wc, int fr, int fq) const {
        const int row0 = u.pm * BM + wr * 64 + fr, col0 = u.pn * BM + wc * 32 + 8 * fq, b = (u.pm * BM) / SEQ;
        float rstd8[2][4]; row_rstd8(rowss, row0, fq, rstd8);
        const float* svp = shw + (size_t)b * ldc + col0;
        if (u.pn < 5 || u.pn > 8) {
            f32x4 sv[2][2];
#pragma unroll
            for (int bj = 0; bj < 2; ++bj)
#pragma unroll
                for (int n = 0; n < 2; ++n) sv[bj][n] = *(const f32x4*)(svp + bj * HALF + 4 * n);
#pragma unroll
            for (int ai = 0; ai < 2; ++ai)
#pragma unroll
                for (int m = 0; m < 4; ++m) { const int row = row0 + ai * HALF + m * 16; bf16_t* rowp = O + (size_t)row * ldc + col0;
                    const float rstd = rstd8[ai][m];
#pragma unroll
                    for (int bj = 0; bj < 2; ++bj) { const f32x4 v0 = acc[ai][bj][m][0] * rstd + sv[bj][0], v1 = acc[ai][bj][m][1] * rstd + sv[bj][1];
                        u32x4 w; w.x = pk2(v0[0], v0[1]); w.y = pk2(v0[2], v0[3]); w.z = pk2(v1[0], v1[1]); w.w = pk2(v1[2], v1[3]);
                        *(u32x4*)(rowp + bj * HALF) = w; } }
        } else {
            const int gi = (u.pn - 5) * 4 + wc, isk = gi >> 3, hd = (gi >> 1) & 3, hfh = gi & 1;
            const float* gg = isk ? gk : gq; bf16_t* dst = (isk ? KH : QH) + hd * 128 + hfh * 64 + 4 * fq;
            const float qs = isk ? 1.0f : LOG2E * 0.125f;
#pragma unroll
            for (int ai = 0; ai < 2; ++ai)
#pragma unroll
                for (int m = 0; m < 4; ++m) { const int row = row0 + ai * HALF + m * 16, spos = row & (SEQ - 1);
                    const float rstd = rstd8[ai][m];
                    f32x4 lo[2], hi[2]; float ss = 0.f;
#pragma unroll
                    for (int bj = 0; bj < 2; ++bj) { const f32x4 v0 = acc[ai][bj][m][0] * rstd + *(const f32x4*)(svp + bj * HALF), v1 = acc[ai][bj][m][1] * rstd + *(const f32x4*)(svp + bj * HALF + 4);
                        lo[bj] = (f32x4){v0[0], v0[2], v1[0], v1[2]}; hi[bj] = (f32x4){v0[1], v0[3], v1[1], v1[3]};
                        ss += ((v0[0] * v0[0] + v0[1] * v0[1]) + (v0[2] * v0[2] + v0[3] * v0[3])) + ((v1[0] * v1[0] + v1[1] * v1[1]) + (v1[2] * v1[2] + v1[3] * v1[3])); }
                    ss += __shfl_xor(ss, 16); ss += __shfl_xor(ss, 32);
                    const float rg = rsqrtf(ss * (1.f / 64.f) + EPS) * qs;
#pragma unroll
                    for (int bj = 0; bj < 2; ++bj) {
                        const f32x4 glo = *(const f32x4*)(gg + bj * 16 + fq * 4), ghi = *(const f32x4*)(gg + 32 + bj * 16 + fq * 4);
                        const f32x4 c4 = *(const f32x4*)(rc + spos * 32 + bj * 16 + fq * 4), s4 = *(const f32x4*)(rs + spos * 32 + bj * 16 + fq * 4);
                        const f32x4 a = lo[bj] * rg * glo, bb = hi[bj] * rg * ghi;
                        const f32x4 olo = a * c4 - bb * s4, ohi = bb * c4 + a * s4;
                        u32x2 w0, w1; w0.x = pk2(olo[0], olo[1]); w0.y = pk2(olo[2], olo[3]); w1.x = pk2(ohi[0], ohi[1]); w1.y = pk2(ohi[2], ohi[3]);
                        *(u32x2*)(dst + (size_t)row * 512 + bj * 16) = w0; *(u32x2*)(dst + (size_t)row * 512 + 32 + bj * 16) = w1; }
                    asm volatile("" ::: "memory"); }
        }
    }
};
struct EpiRes {
    static constexpr bool PERM = true;
    const _Float16* xin; _Float16* xout; float* xout32; const float* gate; const float* gm; bf16_t* Hout; float* rowss_out;
    DI void warm_phase(int, int) const {}
    DI void operator()(const f32x4 (&acc)[2][2][4][2], const Unit& u, int wr, int wc, int fr, int fq) const {
        const int row0 = u.pm * BM + wr * 64 + fr, col0 = u.pn * BM + wc * 64 + 8 * fq, b = (u.pm * BM) / SEQ;
        const bool nxt = gm != nullptr, o32 = xout32 != nullptr;
        f32x4 gv[2][2], gmv[2][2];
#pragma unroll
        for (int bj = 0; bj < 2; ++bj)
#pragma unroll
            for (int n = 0; n < 2; ++n) { gv[bj][n] = *(const f32x4*)(gate + (size_t)b * MODW + col0 + bj * 32 + 4 * n);
                gmv[bj][n] = nxt ? *(const f32x4*)(gm + (size_t)b * DM + col0 + bj * 32 + 4 * n) : (f32x4){0.f, 0.f, 0.f, 0.f}; }
        h16x8 xv[4][2];
#define ER_LOAD(rnd) do { const size_t off_ = (size_t)(row0 + ((rnd) >> 2) * HALF + ((rnd) & 3) * 16) * DM + col0; \
            _Pragma("unroll") for (int bj = 0; bj < 2; ++bj) xv[(rnd) & 3][bj] = *(const h16x8*)(xin + off_ + bj * 32); } while (0)
        ER_LOAD(0); ER_LOAD(1); ER_LOAD(2);
        float ssum[4] = {0.f, 0.f, 0.f, 0.f};
#pragma unroll
        for (int rnd = 0; rnd < 8; ++rnd) {
            const int ai = rnd >> 2, m = rnd & 3;
            const size_t off = (size_t)(row0 + ai * HALF + m * 16) * DM + col0;
            f32x4 x0[2], x1[2];
#pragma unroll
            for (int bj = 0; bj < 2; ++bj) { const f32x8 xf = __builtin_convertvector(xv[rnd & 3][bj], f32x8);
                x0[bj] = (f32x4){xf[0], xf[1], xf[2], xf[3]} + gv[bj][0] * acc[ai][bj][m][0]; x1[bj] = (f32x4){xf[4], xf[5], xf[6], xf[7]} + gv[bj][1] * acc[ai][bj][m][1]; }
            if (rnd + 3 < 8) ER_LOAD(rnd + 3);
#pragma unroll
            for (int bj = 0; bj < 2; ++bj) {
                if (o32) { *(f32x4*)(xout32 + off + bj * 32) = x0[bj]; *(f32x4*)(xout32 + off + bj * 32 + 4) = x1[bj]; }
                else { const f32x8 xf = {x0[bj][0], x0[bj][1], x0[bj][2], x0[bj][3], x1[bj][0], x1[bj][1], x1[bj][2], x1[bj][3]};
                    *(h16x8*)(xout + off + bj * 32) = __builtin_convertvector(xf, h16x8); }
                if (nxt) {
                    ssum[m] += ((x0[bj][0] * x0[bj][0] + x0[bj][1] * x0[bj][1]) + (x0[bj][2] * x0[bj][2] + x0[bj][3] * x0[bj][3])) + ((x1[bj][0] * x1[bj][0] + x1[bj][1] * x1[bj][1]) + (x1[bj][2] * x1[bj][2] + x1[bj][3] * x1[bj][3]));
                    const f32x4 h0 = x0[bj] * gmv[bj][0], h1 = x1[bj] * gmv[bj][1];
                    u32x4 w; w.x = pk2(h0[0], h0[1]); w.y = pk2(h0[2], h0[3]); w.z = pk2(h1[0], h1[1]); w.w = pk2(h1[2], h1[3]);
                    *(u32x4*)(Hout + off + bj * 32) = w; } }
            asm volatile("" ::: "memory");
            if (nxt && m == 3) {
                const bool hi2 = (fq & 2) != 0, hi1 = (fq & 1) != 0;
                const float t0 = hi2 ? ssum[0] : ssum[2], t1 = hi2 ? ssum[1] : ssum[3], k0 = hi2 ? ssum[2] : ssum[0], k1 = hi2 ? ssum[3] : ssum[1];
                const float a0 = k0 + __shfl_xor(t0, 32), a1 = k1 + __shfl_xor(t1, 32);
                const float t = hi1 ? a0 : a1, k = hi1 ? a1 : a0;
                const float rsum = k + __shfl_xor(t, 16);
                rowss_out[(size_t)(u.pm * BM + ai * HALF + wr * 64 + fq * 16 + fr) * 16 + u.pn * 4 + wc] = rsum;
#pragma unroll
                for (int i = 0; i < 4; ++i) ssum[i] = 0.f;
            }
        }
#undef ER_LOAD
    }
};
struct EpiSwiGLU {
    static constexpr bool PERM = true;
    bf16_t* O; const float* rowss; const float* shw;
    DI void warm_phase(int c, int tid) const { warm_panel(rowss, c, tid); }
    DI void operator()(const f32x4 (&acc)[2][2][4][2], const Unit& u, int wr, int wc, int fr, int fq) const {
        const int row0 = u.pm * BM + wr * 64 + fr, colh = u.pn * 128 + wc * 16 + 4 * fq, b = (u.pm * BM) / SEQ;
        f32x4 sv[2][2];
#pragma unroll
        for (int bj = 0; bj < 2; ++bj)
#pragma unroll
            for (int n = 0; n < 2; ++n) sv[bj][n] = *(const f32x4*)(shw + (size_t)b * GU + 2 * colh + bj * HALF + 4 * n);
        float rstd8[2][4]; row_rstd8(rowss, row0, fq, rstd8);
#pragma unroll
        for (int ai = 0; ai < 2; ++ai)
#pragma unroll
            for (int m = 0; m < 4; ++m) { const int row = row0 + ai * HALF + m * 16; bf16_t* rowp = O + (size_t)row * DFF + colh;
                const float rstd = rstd8[ai][m];
#pragma unroll
                for (int bj = 0; bj < 2; ++bj) { const f32x4 g = acc[ai][bj][m][0] * rstd + sv[bj][0], uu = acc[ai][bj][m][1] * rstd + sv[bj][1];
                    float a[4];
#pragma unroll
                    for (int i = 0; i < 4; ++i) a[i] = g[i] * sigmoidf_fast(g[i]) * uu[i];
                    u32x2 w; w.x = pk2(a[0], a[1]); w.y = pk2(a[2], a[3]);
                    *(u32x2*)(rowp + bj * 64) = w; } }
    }
};

template <class Epi, class Sched>
DI void gemm_phase(LAS unsigned char* lds, const Gemm g, const Sched& S, const Epi& E) {
    const int tid = opq(threadIdx.x), wid = __builtin_amdgcn_readfirstlane(tid >> 6), lane = tid & 63, wr = wid >> 2, wc = wid & 3, fr = lane & 15, fq = lane >> 4;
    const int K = g.K, nt = K / BK;
    unsigned voffA[2], voffB[2];
#pragma unroll
    for (int i = 0; i < 2; ++i) { int R, C; stage_rc(tid * 16 + i * 8192, R, C); const int Rb = Epi::PERM ? ((R & ~31) + perm32(R & 31)) : R;
        voffA[i] = (unsigned)(R * K + C) * 2u; voffB[i] = (unsigned)(Rb * K + C) * 2u; }
    const size_t kstep = (size_t)(BK * 2);
    const size_t hstep = (size_t)HALF * K * 2;
    const size_t tstep = 2 * hstep;
    const unsigned ldsw = (unsigned)wid * 1024u;
    const int aoff = lds_byte(wr * 64 + fr, fq * 8), boff = lds_byte(wc * 32 + fr, fq * 8);
#define PG8_SA(b, h) (((b) * 2 + (h)) * HTB)
#define PG8_SB(b, h) ((4 + (b) * 2 + (h)) * HTB)
#define PG8_STAGE(bufoff, gbase, voff) do { _Pragma("unroll") for (int _i = 0; _i < 2; ++_i) \
        __builtin_amdgcn_global_load_lds((const unsigned*)((const char*)(gbase) + (voff)[_i]), (LAS unsigned*)(lds + (bufoff) + ldsw + _i * 8192), 16, 0, 0); } while (0)
#define PG8_LDA(dst, b, h) do { _Pragma("unroll") for (int m = 0; m < 4; ++m) _Pragma("unroll") for (int k = 0; k < 2; ++k) dst[m][k] = *(const LAS bf16x8*)(lds + PG8_SA(b, h) + aoff + m * 2048 + k * 1024); } while (0)
#define PG8_LDB(dst, b, h) do { _Pragma("unroll") for (int n = 0; n < 2; ++n) _Pragma("unroll") for (int k = 0; k < 2; ++k) dst[n][k] = *(const LAS bf16x8*)(lds + PG8_SB(b, h) + boff + n * 2048 + k * 1024); } while (0)
#define PG8_MMA(ai, bj, At, Bt) do { __builtin_amdgcn_s_setprio(1); _Pragma("unroll") for (int m = 0; m < 4; ++m) _Pragma("unroll") for (int n = 0; n < 2; ++n) _Pragma("unroll") for (int k = 0; k < 2; ++k) \
        acc[ai][bj][m][n] = __builtin_amdgcn_mfma_f32_16x16x32_bf16(Bt[n][k], At[m][k], acc[ai][bj][m][n], 0, 0, 0); __builtin_amdgcn_s_setprio(0); } while (0)
#define PG8_WAIT_V(n) asm volatile("s_waitcnt vmcnt(" #n ")" ::: "memory")
#define PG8_WAIT_L(n) asm volatile("s_waitcnt lgkmcnt(" #n ")" ::: "memory")
#define PG8_BAR __builtin_amdgcn_s_barrier()
#define PG8_SCHED __builtin_amdgcn_sched_barrier(0)
    Unit cur, nxt; int ui = 0;
    if (!S.next(0, cur)) return;
    E.warm_phase(S.c, tid);
    f32x4 acc[2][2][4][2];
#pragma unroll
    for (int a = 0; a < 2; ++a)
#pragma unroll
        for (int b = 0; b < 2; ++b)
#pragma unroll
            for (int m = 0; m < 4; ++m)
#pragma unroll
                for (int n = 0; n < 2; ++n) acc[a][b][m][n] = (f32x4){0.f, 0.f, 0.f, 0.f};
    bf16x8 At[4][2], B0[2][2], B1[2][2];
    const char* cA = (const char*)g.A + (size_t)cur.pm * tstep; const char* cB = (const char*)g.Bt + (size_t)cur.pn * tstep;
    PG8_STAGE(PG8_SB(0, 0), cB, voffB); PG8_STAGE(PG8_SA(0, 0), cA, voffA); PG8_STAGE(PG8_SB(0, 1), cB + hstep, voffB); PG8_STAGE(PG8_SA(0, 1), cA + hstep, voffA);
    if (wr == 1) PG8_BAR;
    PG8_WAIT_V(4); PG8_BAR;
    PG8_STAGE(PG8_SB(1, 0), cB + kstep, voffB); PG8_STAGE(PG8_SA(1, 0), cA + kstep, voffA); PG8_STAGE(PG8_SB(1, 1), cB + hstep + kstep, voffB);
    PG8_WAIT_V(6); PG8_BAR;
    for (;;) {
        const bool has_next = S.next(ui + 1, nxt);
        const char* nA = has_next ? (const char*)g.A + (size_t)nxt.pm * tstep : cA; const char* nB = has_next ? (const char*)g.Bt + (size_t)nxt.pn * tstep : cB;
        for (int t = 0; t < nt; t += 2) {
            const bool last = (t == nt - 2);
            const char* a1 = cA + (size_t)(t + 1) * kstep;
            const char* a2 = last ? nA : cA + (size_t)(t + 2) * kstep; const char* b2 = last ? nB : cB + (size_t)(t + 2) * kstep;
            const char* a3 = a2 + kstep; const char* b3 = b2 + kstep;
            PG8_LDB(B0, 0, 0); PG8_SCHED; PG8_LDA(At, 0, 0); PG8_STAGE(PG8_SA(1, 1), a1 + hstep, voffA);
            PG8_WAIT_L(8); PG8_BAR; PG8_WAIT_L(0); PG8_MMA(0, 0, At, B0); PG8_BAR; PG8_SCHED;
            PG8_LDB(B1, 0, 1); PG8_STAGE(PG8_SB(0, 0), b2, voffB);
            PG8_BAR; PG8_WAIT_L(0); PG8_MMA(0, 1, At, B1); PG8_BAR;
            PG8_LDA(At, 0, 1); PG8_STAGE(PG8_SA(0, 0), a2, voffA);
            PG8_BAR; PG8_WAIT_L(0); PG8_MMA(1, 0, At, B0); PG8_BAR; PG8_SCHED;
            PG8_STAGE(PG8_SB(0, 1), b2 + hstep, voffB);
            PG8_WAIT_V(6); PG8_BAR; PG8_MMA(1, 1, At, B1); PG8_BAR;
            PG8_LDB(B0, 1, 0); PG8_SCHED; PG8_LDA(At, 1, 0); PG8_STAGE(PG8_SA(0, 1), a2 + hstep, voffA);
            PG8_WAIT_L(8); PG8_BAR; PG8_WAIT_L(0); PG8_MMA(0, 0, At, B0); PG8_BAR; PG8_SCHED;
            PG8_LDB(B1, 1, 1); PG8_STAGE(PG8_SB(1, 0), b3, voffB);
            PG8_BAR; PG8_WAIT_L(0); PG8_MMA(0, 1, At, B1); PG8_BAR;
            PG8_LDA(At, 1, 1); PG8_STAGE(PG8_SA(1, 0), a3, voffA);
            PG8_BAR; PG8_WAIT_L(0); PG8_MMA(1, 0, At, B0); PG8_BAR; PG8_SCHED;
            PG8_STAGE(PG8_SB(1, 1), b3 + hstep, voffB);
            PG8_WAIT_V(6); PG8_BAR; PG8_MMA(1, 1, At, B1); PG8_BAR;
        }
        E(acc, cur, wr, wc, fr, fq);
        if (!has_next) break;
#pragma unroll
        for (int a = 0; a < 2; ++a)
#pragma unroll
            for (int b = 0; b < 2; ++b)
#pragma unroll
                for (int m = 0; m < 4; ++m)
#pragma unroll
                    for (int n = 0; n < 2; ++n) acc[a][b][m][n] = (f32x4){0.f, 0.f, 0.f, 0.f};
        cur = nxt; cA = nA; cB = nB; ++ui;
    }
    PG8_WAIT_V(0);
    if (wr == 0) PG8_BAR;
    PG8_BAR;
#undef PG8_SA
#undef PG8_SB
#undef PG8_STAGE
#undef PG8_LDA
#undef PG8_LDB
#undef PG8_MMA
#undef PG8_WAIT_V
#undef PG8_WAIT_L
#undef PG8_BAR
#undef PG8_SCHED
}
}

template <int MODE>
DI int wrow_map(int n) {
    if (MODE == 0) return n;
    if (MODE == 2) { if (n < 1280 || n >= 2304) return n;
        const int gi = (n - 1280) >> 6, d = (n - 1280) & 63, hi = d >> 5, f = d & 31, bj = f >> 4, fq = (f >> 2) & 3, jj = f & 3;
        return 256 * (5 + (gi >> 2)) + 128 * bj + 32 * (gi & 3) + 8 * fq + 2 * jj + hi; }
    if (MODE == 3) return (n & ~255) + 128 * ((n >> 5) & 1) + 32 * ((n >> 6) & 3) + (n & 31);
    const int isu = n >= DFF ? 1 : 0, j = n - isu * DFF; return 8 * (j >> 2) + 4 * isu + (j & 3); }
template <int MODE>
DI void p0_transpose_item(const float* W, int K, int N, bf16_t* WT, LAS float* scr, int item, int lane) {
    const int nblk = N / 32, kb = item / nblk, nb = item % nblk, k0 = 64 * kb, n0 = 32 * nb;
    float wv[32];
#pragma unroll
    for (int i = 0; i < 32; ++i) wv[i] = W[(size_t)(k0 + 2 * i + (lane >> 5)) * N + n0 + (lane & 31)];
#pragma unroll
    for (int i = 0; i < 32; ++i) scr[(2 * i + (lane >> 5)) * 33 + (lane & 31)] = wv[i];
    asm volatile("s_waitcnt lgkmcnt(0)" ::: "memory");
    const int c = lane & 7;
#pragma unroll
    for (int j = 0; j < 4; ++j) { const int n = (lane >> 3) + 8 * j; const LAS float* s = scr + (8 * c) * 33 + n;
        u32x4 o; o.x = pk2(s[0 * 33], s[1 * 33]); o.y = pk2(s[2 * 33], s[3 * 33]); o.z = pk2(s[4 * 33], s[5 * 33]); o.w = pk2(s[6 * 33], s[7 * 33]);
        *(u32x4*)(WT + (size_t)wrow_map<MODE>(n0 + n) * K + k0 + 8 * c) = o; }
    asm volatile("s_waitcnt lgkmcnt(0)" ::: "memory");
}

DI void phase0(const Params& p, LAS unsigned char* lds) {
    const int tid = opq(threadIdx.x), lane = tid & 63, wave = tid >> 6, G = gridDim.x;
    {
        LAS float* cact = (LAS float*)lds;
        float* mod = (float*)(p.ws + WS_MOD);
        constexpr int NITEM = NL * (MODW / 64);
        for (int it = blockIdx.x; it < NITEM; it += G) {
            const int l = it / (MODW / 64), n0 = (it % (MODW / 64)) * 64;
            for (int idx = tid; idx < NB * DM; idx += 512) { const int k = idx >> 5, b = idx & 31; const float v = p.c[b * DM + k]; cact[idx] = v * sigmoidf_fast(v); }
            __syncthreads();
            float acc[32];
#pragma unroll
            for (int b = 0; b < 32; ++b) acc[b] = 0.f;
            const float* wp = p.w_ada + ((size_t)l * DM + 128 * wave) * MODW + n0 + lane;
            const LAS f32x4* cp = (const LAS f32x4*)(cact + (128 * wave) * 32);
#pragma unroll 1
            for (int kk0 = 0; kk0 < 128; kk0 += 32) {
                float wv[32];
#pragma unroll
                for (int i = 0; i < 32; ++i) wv[i] = wp[(size_t)(kk0 + i) * MODW];
#pragma unroll
                for (int i = 0; i < 32; ++i) {
#pragma unroll
                    for (int q = 0; q < 8; ++q) { const f32x4 cv = cp[(kk0 + i) * 8 + q]; acc[4 * q] += cv[0] * wv[i]; acc[4 * q + 1] += cv[1] * wv[i]; acc[4 * q + 2] += cv[2] * wv[i]; acc[4 * q + 3] += cv[3] * wv[i]; }
                }
            }
            __syncthreads();
            LAS float* red = (LAS float*)lds;
#pragma unroll
            for (int b = 0; b < 32; ++b) red[(wave * 32 + b) * 64 + lane] = acc[b];
            __syncthreads();
#pragma unroll
            for (int j = 0; j < 4; ++j) { const int o = tid + 512 * j, b = o >> 6, n = o & 63; float s = p.b_ada[l * MODW + n0 + n];
#pragma unroll
                for (int w = 0; w < 8; ++w) s += red[(w * 32 + b) * 64 + n];
                mod[((size_t)l * NB + b) * MODW + n0 + n] = s; }
            __syncthreads();
        }
    }
    {
        LAS float* scr = (LAS float*)(lds + wave * 16384);
        const int gw = blockIdx.x * 8 + wave, NGW = G * 8;
        constexpr int I_IN = (DM / 64) * (INW / 32), I_OUT = (DM / 64) * (DM / 32), I_GU = (DM / 64) * (GU / 32), I_DN = (DFF / 64) * (DM / 32);
        constexpr int PER_L = I_IN + I_OUT + I_GU + I_DN;
        for (int it = gw; it < NL * PER_L; it += NGW) {
            const int l = it / PER_L; int r = it % PER_L;
            if (r < I_IN) { p0_transpose_item<2>(p.w_in + (size_t)l * DM * INW, DM, INW, (bf16_t*)(p.ws + WS_WT_IN) + (size_t)l * INW * DM, scr, r, lane); continue; } r -= I_IN;
            if (r < I_OUT) { p0_transpose_item<3>(p.w_out + (size_t)l * DM * DM, DM, DM, (bf16_t*)(p.ws + WS_WT_OUT) + (size_t)l * DM * DM, scr, r, lane); continue; } r -= I_OUT;
            if (r < I_GU) { p0_transpose_item<1>(p.w_gate_up + (size_t)l * DM * GU, DM, GU, (bf16_t*)(p.ws + WS_WT_GU) + (size_t)l * GU * DM, scr, r, lane); continue; } r -= I_GU;
            p0_transpose_item<3>(p.w_down + (size_t)l * DFF * DM, DFF, DM, (bf16_t*)(p.ws + WS_WT_DN) + (size_t)l * DM * DFF, scr, r, lane);
        }
    }
    {
        float* rc = (float*)(p.ws + WS_ROPE); float* rs = rc + SEQ * 32;
        for (int idx = blockIdx.x * 512 + tid; idx < SEQ * 32; idx += G * 512) {
            const int s = idx >> 5, i = idx & 31;
            double inv = 1.0, bpow = 0.7498942093324559;
#pragma unroll
            for (int bit = 0; bit < 5; ++bit) { if ((i >> bit) & 1) inv *= bpow; bpow *= bpow; }
            const double rev = (double)p.pos[s] * inv * 0.15915494309189535;
            const float fr = (float)(rev - floor(rev));
            rc[idx] = __builtin_amdgcn_cosf(fr); rs[idx] = __builtin_amdgcn_sinf(fr);
        }
    }
}

DI void phase_pre(const Params& p) {
    const int tid = opq(threadIdx.x), lane = tid & 63, wave = tid >> 6, G = gridDim.x, NGW = G * 8, gw = blockIdx.x * 8 + wave;
    const float* mod = (const float*)(p.ws + WS_MOD);
    {
        const int r = lane & 31, h = lane >> 5;
        constexpr int NBLK_IN = INW / 32, NBLK_GU = GU / 32, PER_L = NBLK_IN + NBLK_GU;
        for (int it = gw; it < NL * PER_L; it += NGW) {
            const int l = it / PER_L, q = it % PER_L; const bool isgu = q >= NBLK_IN; const int nb = isgu ? q - NBLK_IN : q;
            const bf16_t* W = isgu ? (const bf16_t*)(p.ws + WS_WT_GU) + ((size_t)l * GU + nb * 32 + r) * DM : (const bf16_t*)(p.ws + WS_WT_IN) + ((size_t)l * INW + nb * 32 + r) * DM;
            const float* sh = mod + ((size_t)l * NB + r) * MODW + (isgu ? 3 * DM : 0);
            f32x16 acc;
#pragma unroll
            for (int i = 0; i < 16; ++i) acc[i] = 0.f;
#pragma unroll 8
            for (int ks = 0; ks < DM / 16; ++ks) {
                const int k0 = ks * 16 + h * 8;
                const bf16x8 bfrag = *(const bf16x8*)(W + k0);
                const f32x4 s0 = *(const f32x4*)(sh + k0), s1 = *(const f32x4*)(sh + k0 + 4);
                u32x4 a; a.x = pk2(s0[0], s0[1]); a.y = pk2(s0[2], s0[3]); a.z = pk2(s1[0], s1[1]); a.w = pk2(s1[2], s1[3]);
                acc = __builtin_amdgcn_mfma_f32_32x32x16_bf16(__builtin_bit_cast(bf16x8, a), bfrag, acc, 0, 0, 0);
            }
            float* o = isgu ? (float*)(p.ws + WS_SHW_GU) + (size_t)l * NB * GU : (float*)(p.ws + WS_SHW_IN) + (size_t)l * NB * INW;
            const int ld = isgu ? GU : INW;
#pragma unroll
            for (int i = 0; i < 16; ++i) o[(size_t)((i & 3) + 8 * (i >> 2) + 4 * h) * ld + nb * 32 + r] = acc[i];
        }
    }
    {
        float* gm = (float*)(p.ws + WS_GM);
        for (int idx = blockIdx.x * 512 + tid; idx < NL * 2 * NB * DM; idx += G * 512) {
            const int k = idx & 1023, b = (idx >> 10) & 31, sx = (idx >> 15) & 1, l = idx >> 16;
            const float g = (sx ? p.norm2_g : p.norm1_g)[l * DM + k], sc = mod[((size_t)l * NB + b) * MODW + (sx ? 4 : 1) * DM + k];
            gm[idx] = g * (1.0f + sc);
        }
    }
    {
        bf16_t* H = (bf16_t*)(p.ws + WS_H); float* rowss = (float*)(p.ws + WS_ROWSS);
        for (int rb = gw; rb < MTOK / 32; rb += NGW) {
            const int b = (rb * 32) / SEQ;
            f32x4 gs[4];
#pragma unroll
            for (int j = 0; j < 4; ++j) { const int col = 4 * lane + 256 * j;
                const f32x4 gg = *(const f32x4*)(p.norm1_g + col), sc = *(const f32x4*)(mod + (size_t)b * MODW + DM + col);
                gs[j] = gg * (sc + 1.0f); }
            for (int r = 0; r < 32; r += 4) {
                const size_t row = (size_t)rb * 32 + r;
                const f32x4* xr = (const f32x4*)(p.x + row * DM) + lane;
                f32x4 v[4][4];
#pragma unroll
                for (int q = 0; q < 4; ++q)
#pragma unroll
                    for (int j = 0; j < 4; ++j) v[q][j] = xr[256 * q + 64 * j];
#pragma unroll
                for (int q = 0; q < 4; ++q) { float sq = 0.f;
#pragma unroll
                    for (int j = 0; j < 4; ++j) sq += (v[q][j][0] * v[q][j][0] + v[q][j][1] * v[q][j][1]) + (v[q][j][2] * v[q][j][2] + v[q][j][3] * v[q][j][3]);
                    sq = wave_sum(sq);
                    if (lane < 16) rowss[(row + q) * 16 + lane] = (lane == 0) ? sq : 0.f;
                    u32x2* o8 = (u32x2*)(H + (row + q) * DM) + lane; h16x4* x8 = (h16x4*)((_Float16*)(p.ws + WS_X16) + (row + q) * DM) + lane;
#pragma unroll
                    for (int j = 0; j < 4; ++j) { const f32x4 y = v[q][j] * gs[j]; u32x2 w; w.x = pk2(y[0], y[1]); w.y = pk2(y[2], y[3]); o8[64 * j] = w; x8[64 * j] = __builtin_convertvector(v[q][j], h16x4); } }
            }
        }
    }
}

DI void phase_prep(const Params& p, int l, LAS unsigned char* lds) {
    const int tid = opq(threadIdx.x), lane = tid & 63, wave = tid >> 6, G = gridDim.x;
    const bf16_t* Z = (const bf16_t*)(p.ws + WS_Z);
    bf16_t* MIX = (bf16_t*)(p.ws + WS_MIX);
    LAS float* U = (LAS float*)lds;
    LAS float* CV = (LAS float*)(lds + 65536);
    const int cch = tid & 255, th = tid >> 8;
    float cw[31];
#pragma unroll
    for (int j = 0; j < 31; ++j) cw[j] = p.conv_a_w[((size_t)l * 31 + j) * 256 + cch];
    const float cbias = p.conv_a_b[l * 256 + cch];
    const f32x4 ga = *(const f32x4*)(p.conv_a_norm_g + l * 256 + 4 * lane);
    const f32x4 gb = *(const f32x4*)(p.sc_norm_g + l * 256 + 4 * lane);
    f32x4 wb[3];
#pragma unroll
    for (int j = 0; j < 3; ++j) wb[j] = *(const f32x4*)(p.conv_b_w + ((size_t)l * 3 + j) * 256 + 4 * lane);

    const int pvcu = (G % 8 == 0) ? ((blockIdx.x & 7) * (G >> 3) + (blockIdx.x >> 3)) : blockIdx.x;
    for (int it = pvcu; it < MTOK / 32; it += G) {
        const int b = it >> 6, t0 = (it & 63) * 32;
        const size_t tokbase = (size_t)b * SEQ;
        u32x4 av[4], ag[4];
#pragma unroll
        for (int k4 = 0; k4 < 4; ++k4) { const int ci = tid + 512 * k4, row = ci >> 5, ch8 = ci & 31, tok = t0 - 15 + row;
            av[k4] = (u32x4){0u, 0u, 0u, 0u}; ag[k4] = av[k4];
            if (ci < 62 * 32 && tok >= 0 && tok < SEQ) { const bf16_t* zp = Z + (tokbase + tok) * INW + ch8 * 8; av[k4] = *(const u32x4*)zp; ag[k4] = *(const u32x4*)(zp + 256); } }
        const int tw = t0 + wave * 4;
        u32x2 bcg[6], bhv[6], bbg[4];
#pragma unroll
        for (int r = 0; r < 6; ++r) { const int tok = tw - 1 + r; bcg[r] = (u32x2){0u, 0u}; bhv[r] = bcg[r];
            if (tok >= 0 && tok < SEQ) { const bf16_t* zp = Z + (tokbase + tok) * INW + 512 + 4 * lane; bcg[r] = *(const u32x2*)(zp + 256); bhv[r] = *(const u32x2*)(zp + 512);
                if (r >= 1 && r <= 4) bbg[r - 1] = *(const u32x2*)zp; } }
#pragma unroll
        for (int k4 = 0; k4 < 4; ++k4) { const int ci = tid + 512 * k4, row = ci >> 5, ch8 = ci & 31;
            if (ci < 62 * 32) { const u32x4 v = av[k4], gt = ag[k4]; f32x4 o0, o1;
                o0[0] = bf_lo(v.x) * sigmoidf_fast(bf_lo(gt.x)); o0[1] = bf_hi(v.x) * sigmoidf_fast(bf_hi(gt.x));
                o0[2] = bf_lo(v.y) * sigmoidf_fast(bf_lo(gt.y)); o0[3] = bf_hi(v.y) * sigmoidf_fast(bf_hi(gt.y));
                o1[0] = bf_lo(v.z) * sigmoidf_fast(bf_lo(gt.z)); o1[1] = bf_hi(v.z) * sigmoidf_fast(bf_hi(gt.z));
                o1[2] = bf_lo(v.w) * sigmoidf_fast(bf_lo(gt.w)); o1[3] = bf_hi(v.w) * sigmoidf_fast(bf_hi(gt.w));
                *(LAS f32x4*)(U + row * 256 + ch8 * 8) = o0; *(LAS f32x4*)(U + row * 256 + ch8 * 8 + 4) = o1; } }
        __syncthreads();
#pragma unroll 1
        for (int chunk = 0; chunk < 2; ++chunk) {
            const int tb = th * 16 + chunk * 8;
            float uu[38];
#pragma unroll
            for (int i = 0; i < 38; ++i) uu[i] = U[(tb + i) * 256 + cch];
#pragma unroll
            for (int t = 0; t < 8; ++t) { float a = cbias;
#pragma unroll
                for (int j = 0; j < 31; ++j) a += cw[j] * uu[t + j];
                CV[(tb + t) * 256 + cch] = a; }
        }
        __syncthreads();
#pragma unroll
        for (int q = 0; q < 4; ++q) { const int t = wave * 4 + q;
            const f32x4 v = *(const LAS f32x4*)(CV + t * 256 + 4 * lane);
            const float ss = wave_sum((v[0] * v[0] + v[1] * v[1]) + (v[2] * v[2] + v[3] * v[3]));
            const f32x4 y = v * rsqrtf(ss * (1.f / 256.f) + EPS) * ga;
            f32x4 o;
#pragma unroll
            for (int i = 0; i < 4; ++i) o[i] = y[i] * sigmoidf_fast(y[i]);
            u32x2 w; w.x = pk2(o[0], o[1]); w.y = pk2(o[2], o[3]);
            *(u32x2*)(MIX + (tokbase + t0 + t) * DM + 4 * lane) = w; }
        {
            f32x4 mrow[6], bgv[4];
#pragma unroll
            for (int r = 0; r < 6; ++r) { mrow[r][0] = bf_lo(bcg[r].x) * bf_lo(bhv[r].x); mrow[r][1] = bf_hi(bcg[r].x) * bf_hi(bhv[r].x); mrow[r][2] = bf_lo(bcg[r].y) * bf_lo(bhv[r].y); mrow[r][3] = bf_hi(bcg[r].y) * bf_hi(bhv[r].y); }
#pragma unroll
            for (int q = 0; q < 4; ++q) { bgv[q][0] = bf_lo(bbg[q].x); bgv[q][1] = bf_hi(bbg[q].x); bgv[q][2] = bf_lo(bbg[q].y); bgv[q][3] = bf_hi(bbg[q].y); }
#pragma unroll
            for (int q = 0; q < 4; ++q) {
                const f32x4 y = bgv[q] * (wb[0] * mrow[q] + wb[1] * mrow[q + 1] + wb[2] * mrow[q + 2]);
                const float ss = wave_sum((y[0] * y[0] + y[1] * y[1]) + (y[2] * y[2] + y[3] * y[3]));
                const f32x4 o = y * rsqrtf(ss * (1.f / 256.f) + EPS) * gb;
                u32x2 w; w.x = pk2(o[0], o[1]); w.y = pk2(o[2], o[3]);
                *(u32x2*)(MIX + (tokbase + tw + q) * DM + 256 + 4 * lane) = w; }
        }
        __syncthreads();
    }
}

constexpr int KROW = 272, VROW = 320, KBYTES = 64 * KROW, VBYTES = 64 * VROW, ABUF = KBYTES + VBYTES;
typedef short s16x4 __attribute__((ext_vector_type(4)));
#define MFMA32(a, b, c) __builtin_amdgcn_mfma_f32_32x32x16_bf16((a), (b), (c), 0, 0, 0)

DI void phase_attn(const Params& p, int l, float lambda_init, LAS unsigned char* lds) {
    const int tid = opq(threadIdx.x), lane = tid & 63, wave = tid >> 6, G = gridDim.x, r = lane & 31, h = lane >> 5;
    const int rg = wave >> 1, hf = wave & 1;
    const bf16_t* Z = (const bf16_t*)(p.ws + WS_Z);
    const bf16_t* QH = (const bf16_t*)(p.ws + WS_QH); const bf16_t* KH = (const bf16_t*)(p.ws + WS_KH);
    bf16_t* MIX = (bf16_t*)(p.ws + WS_MIX);
    const float sa = wave_sum(p.lam_q1[l * 64 + lane] * p.lam_k1[l * 64 + lane]), sb = wave_sum(p.lam_q2[l * 64 + lane] * p.lam_k2[l * 64 + lane]);
    const float lam = expf(sa) - expf(sb) + lambda_init;
    const float oscale = 1.0f - lambda_init;
    const int kkey = tid >> 3, kch = tid & 7;
    const int vtr = (4 * (lane >> 5) + ((lane >> 2) & 3)) * VROW + (16 * ((lane >> 4) & 1) + 4 * (lane & 3)) * 2;
    const int vcu = (G % 8 == 0) ? ((blockIdx.x & 7) * (G >> 3) + (blockIdx.x >> 3)) : blockIdx.x;
    LAS float* X = (LAS float*)lds + rg * (128 * 32);

    bf16x8 qf[4]; u32x4 krA[2], vrA[2], krB[2], vrB[2];
#define ATT_ITEM_PTRS(it_) const int qblk = (it_) & 15, head = ((it_) >> 4) & 3, b = (it_) >> 6; const size_t tokb = (size_t)b * SEQ; \
        const size_t qtok = tokb + qblk * 128 + rg * 32 + r; \
        const bf16_t* kg = KH + (tokb + kkey) * 512 + head * 128 + kch * 8; const bf16_t* vg = Z + (tokb + kkey) * INW + 2304 + head * 128 + kch * 8;
#define ATT_LOAD(KR, VR, t_) do { const bf16_t* kg2_ = kg + (size_t)(t_) * 64 * 512; const bf16_t* vg2_ = vg + (size_t)(t_) * 64 * INW; \
            KR[0] = *(const u32x4*)kg2_; KR[1] = *(const u32x4*)(kg2_ + 64); VR[0] = *(const u32x4*)vg2_; VR[1] = *(const u32x4*)(vg2_ + 64); } while (0)
#define ATT_ITEM_PREFETCH() do { ATT_LOAD(krA, vrA, 0); ATT_LOAD(krB, vrB, 1); \
            _Pragma("unroll") for (int kk = 0; kk < 4; ++kk) qf[kk] = *(const bf16x8*)(QH + qtok * 512 + head * 128 + hf * 64 + kk * 16 + h * 8); } while (0)
    if (vcu < NB * 4 * 16) { ATT_ITEM_PTRS(vcu); ATT_ITEM_PREFETCH(); }
    for (int it = vcu; it < NB * 4 * 16; it += G) {
        ATT_ITEM_PTRS(it);
        f32x16 o[4];
#pragma unroll
        for (int eb = 0; eb < 4; ++eb)
#pragma unroll
            for (int i = 0; i < 16; ++i) o[eb][i] = 0.f;
        float lsum = 0.f;
#define ATT_WRITE(KR, VR, buf) do { LAS unsigned char* kb_ = lds + (buf) * ABUF; LAS unsigned char* vb_ = kb_ + KBYTES; \
            *(LAS u32x4*)(kb_ + kkey * KROW + kch * 16) = KR[0]; *(LAS u32x4*)(kb_ + kkey * KROW + kch * 16 + 128) = KR[1]; \
            *(LAS u32x4*)(vb_ + kkey * VROW + kch * 16) = VR[0]; *(LAS u32x4*)(vb_ + kkey * VROW + kch * 16 + 128) = VR[1]; } while (0)
#define ATT_COMPUTE(buf) do { const LAS unsigned char* kb = lds + (buf) * ABUF; LAS unsigned char* vb = lds + (buf) * ABUF + KBYTES; \
            _Pragma("unroll") for (int kbk = 0; kbk < 2; ++kbk) { \
                f32x16 s; \
                _Pragma("unroll") for (int i = 0; i < 16; ++i) s[i] = 0.f; \
                _Pragma("unroll") for (int kk = 0; kk < 4; ++kk) { const bf16x8 a = *(const LAS bf16x8*)(kb + (kbk * 32 + r) * KROW + hf * 128 + kk * 32 + h * 16); s = MFMA32(a, qf[kk], s); } \
                float ls = 0.f; \
                _Pragma("unroll") for (int i = 0; i < 16; ++i) { s[i] = __builtin_amdgcn_exp2f(s[i]); ls += s[i]; } \
                lsum += ls; \
                bf16x8 pf[2]; \
                _Pragma("unroll") for (int st = 0; st < 2; ++st) { u32x4 w; w.x = pk2(s[8 * st], s[8 * st + 1]); w.y = pk2(s[8 * st + 2], s[8 * st + 3]); w.z = pk2(s[8 * st + 4], s[8 * st + 5]); w.w = pk2(s[8 * st + 6], s[8 * st + 7]); \
                    pf[st] = __builtin_bit_cast(bf16x8, w); } \
                _Pragma("unroll") for (int st = 0; st < 2; ++st) \
                    _Pragma("unroll") for (int eb = 0; eb < 4; ++eb) { \
                        const s16x4 vlo = __builtin_amdgcn_ds_read_tr16_b64_v4i16((LAS s16x4*)(vb + vtr + (kbk * 32 + st * 16) * VROW + eb * 64)); \
                        const s16x4 vhi = __builtin_amdgcn_ds_read_tr16_b64_v4i16((LAS s16x4*)(vb + vtr + (kbk * 32 + st * 16 + 8) * VROW + eb * 64)); \
                        const bf16x8 vf = __builtin_shufflevector(vlo, vhi, 0, 1, 2, 3, 4, 5, 6, 7); \
                        o[eb] = MFMA32(vf, pf[st], o[eb]); } \
            } } while (0)
        ATT_WRITE(krA, vrA, 0);
        ATT_LOAD(krA, vrA, 2);
        __syncthreads();
#pragma unroll 1
        for (int t = 0; t < SEQ / 64; t += 2) {
            ATT_COMPUTE(0);
            ATT_WRITE(krB, vrB, 1);
            if (t + 3 < SEQ / 64) ATT_LOAD(krB, vrB, t + 3);
            __syncthreads();
            ATT_COMPUTE(1);
            if (t + 2 < SEQ / 64) { ATT_WRITE(krA, vrA, 0);
                if (t + 4 < SEQ / 64) ATT_LOAD(krA, vrA, t + 4); }
            __syncthreads();
        }
#undef ATT_COMPUTE
        bf16_t* orow = MIX + qtok * DM + 512 + head * 128;
        if (it + G < NB * 4 * 16) { ATT_ITEM_PTRS(it + G); ATT_ITEM_PREFETCH(); }
        const float lt = lsum + __shfl_xor(lsum, 32);
        if (hf == 1) {
            const float sc1 = lam / lt;
#pragma unroll
            for (int eb = 0; eb < 4; ++eb)
#pragma unroll
                for (int i = 0; i < 16; ++i) X[(eb * 32 + (i & 3) + 8 * (i >> 2) + 4 * h) * 32 + r] = o[eb][i] * sc1;
        }
        __syncthreads();
        if (hf == 0) {
            const float i0 = 1.0f / lt;
            float ss = 0.f;
#pragma unroll
            for (int eb = 0; eb < 4; ++eb)
#pragma unroll
                for (int i = 0; i < 16; ++i) { const float v = o[eb][i] * i0 - X[(eb * 32 + (i & 3) + 8 * (i >> 2) + 4 * h) * 32 + r]; o[eb][i] = v; ss += v * v; }
            ss += __shfl_xor(ss, 32);
            const float rn = rsqrtf(ss * (1.f / 128.f) + EPS) * oscale;
#pragma unroll
            for (int eb = 0; eb < 4; ++eb)
#pragma unroll
                for (int g4 = 0; g4 < 4; ++g4) { const int e = eb * 32 + 8 * g4 + 4 * h;
                    const f32x4 gg = *(const f32x4*)(p.attn_norm_g + l * 128 + e);
                    u32x2 w; w.x = pk2(o[eb][4 * g4] * rn * gg[0], o[eb][4 * g4 + 1] * rn * gg[1]); w.y = pk2(o[eb][4 * g4 + 2] * rn * gg[2], o[eb][4 * g4 + 3] * rn * gg[3]);
                    *(u32x2*)(orow + e) = w; }
        }
        __syncthreads();
    }
#undef ATT_WRITE
#undef ATT_LOAD
#undef ATT_ITEM_PTRS
#undef ATT_ITEM_PREFETCH
}

#define XB_TMO      128
#define XB_XCNT(j)  (256  + 64 * (j))
#define XB_XSUB(j)  (1280 + 64 * (j))
#define XB_XGEN(j)  (2304 + 64 * (j))
#define XB_TOP      3328
#define XB_TOPGEN   3392
#define XCD_BAR_WORDS 3456
#define XB_SPIN_CAP (1u << 20)
DI unsigned xb_ld(unsigned* p)              { return __hip_atomic_load(p, __ATOMIC_RELAXED, __HIP_MEMORY_SCOPE_AGENT); }
DI unsigned xb_add(unsigned* p, unsigned v) { return __hip_atomic_fetch_add(p, v, __ATOMIC_RELAXED, __HIP_MEMORY_SCOPE_AGENT); }
DI unsigned xb_xcc_id() { return (unsigned)__builtin_amdgcn_s_getreg((3 << 11) | 20) & 0xFu; }
#define XB_SPIN(cond, bar) do { unsigned _sp = 0; while (cond) { __builtin_amdgcn_s_sleep(1); \
    if ((++_sp & 255u) == 0u) { if (xb_ld(&(bar)[XB_TMO])) break; if (_sp > XB_SPIN_CAP) { atomicAdd(&(bar)[XB_TMO], 1u); break; } } } } while (0)
struct XcdBarrier { unsigned* bar; unsigned x; volatile LAS unsigned* st; };
DI XcdBarrier xcd_barrier_post(unsigned* bar, volatile LAS unsigned* st) {
    XcdBarrier b; b.bar = bar; b.x = xb_xcc_id(); b.st = st;
    if (threadIdx.x == 0) (void)xb_add(&bar[XB_XCNT(b.x)], 1u);
    return b;
}
DI void xcd_barrier_complete(unsigned* bar, unsigned x, unsigned& nloc, unsigned& nx) {
    const unsigned G = gridDim.x * gridDim.y * gridDim.z;
    unsigned sum, cnt, mine, sp = 0u;
    for (;;) {
        sum = 0u; cnt = 0u; mine = 0u;
#pragma unroll
        for (unsigned j = 0; j < 16; ++j) { const unsigned c = xb_ld(&bar[XB_XCNT(j)]); sum += c; cnt += (c > 0u) ? 1u : 0u; mine = (j == x) ? c : mine; }
        if (sum == G) break;
        __builtin_amdgcn_s_sleep(1);
        if ((++sp & 255u) == 0u) { if (xb_ld(&bar[XB_TMO])) break; if (sp > XB_SPIN_CAP) { atomicAdd(&bar[XB_TMO], 1u); break; } }
    }
    nloc = mine > 0u ? mine : 1u; nx = cnt > 0u ? cnt : 1u;
}
DI void xcd_barrier(const XcdBarrier& b) {
    asm volatile("s_waitcnt vmcnt(0)" ::: "memory");
    __syncthreads();
    if (threadIdx.x == 0) {
        unsigned* bar = b.bar;
        __builtin_amdgcn_s_waitcnt(0);
        unsigned nloc = b.st[0], nx = b.st[1];
        if (nloc == 0u) { xcd_barrier_complete(bar, b.x, nloc, nx); b.st[0] = nloc; b.st[1] = nx; }
        const unsigned old = xb_add(&bar[XB_XSUB(b.x)], 1u);
        const unsigned gen = old / nloc;
        if (old + 1u == (gen + 1u) * nloc) {
            __builtin_amdgcn_fence(__ATOMIC_RELEASE, "agent");
            asm volatile("s_waitcnt vmcnt(0)" ::: "memory");
            const unsigned og = xb_add(&bar[XB_TOP], 1u);
            const unsigned tg = og / nx;
            if (og + 1u == (tg + 1u) * nx) xb_add(&bar[XB_TOPGEN], 1u);
            else XB_SPIN(xb_ld(&bar[XB_TOPGEN]) == tg, bar);
            __builtin_amdgcn_fence(__ATOMIC_ACQUIRE, "agent");
            xb_add(&bar[XB_XGEN(b.x)], 1u);
            asm volatile("s_waitcnt vmcnt(0)" ::: "memory");
        } else {
            XB_SPIN(xb_ld(&bar[XB_XGEN(b.x)]) == gen, bar);
            __builtin_amdgcn_fence(__ATOMIC_ACQUIRE, "agent");
            asm volatile("s_waitcnt vmcnt(0)" ::: "memory");
        }
    }
    __syncthreads();
}

__global__ void __launch_bounds__(512, 2) fwd_megakernel(Params p) {
    extern __shared__ __attribute__((aligned(16))) unsigned char shm[];
    LAS unsigned char* lds = (LAS unsigned char*)shm;
    cg::grid_group grid = cg::this_grid();
    const int G = gridDim.x, c = blockIdx.x;
    float* mod = (float*)(p.ws + WS_MOD);
    bf16_t* H = (bf16_t*)(p.ws + WS_H); bf16_t* Zb = (bf16_t*)(p.ws + WS_Z); bf16_t* MIX = (bf16_t*)(p.ws + WS_MIX);
    volatile LAS unsigned* bst = (volatile LAS unsigned*)(lds + 131072);
    if (threadIdx.x < 4) bst[threadIdx.x] = 0u;
    __syncthreads();
    const XcdBarrier xb = xcd_barrier_post((unsigned*)(p.ws + WS_BAR), bst);
    float* rowss = (float*)(p.ws + WS_ROWSS);
    for (int ph = p.ph_lo; ph < p.ph_hi; ++ph) {
        if (ph > p.ph_lo) { if (ph == p.ph_lo + 1) grid.sync(); else xcd_barrier(xb); }
        if (ph == 0) { phase0(p, lds); continue; }
        if (ph == 1) { phase_pre(p); continue; }
        const int l = (ph - 2) / 5, s5 = (ph - 2) % 5, sub = s5 + (s5 >= 2 ? 1 : 0);
        const float* modl = mod + (size_t)l * NB * MODW;
        float* rs1 = rowss + (size_t)(2 * l) * MTOK * 16; float* rs2 = rs1 + (size_t)MTOK * 16;
        const float* gml = (const float*)(p.ws + WS_GM) + (size_t)l * 2 * NB * DM;
        if (sub == 0) { pg8::StaticOrder S; S.init(MTOK, INW, G, c); pg8::Gemm g{H, (const bf16_t*)(p.ws + WS_WT_IN) + (size_t)l * INW * DM, MTOK, INW, DM};
            pg8::EpiZ E{Zb, INW, rs1, (const float*)(p.ws + WS_SHW_IN) + (size_t)l * NB * INW, (bf16_t*)(p.ws + WS_QH), (bf16_t*)(p.ws + WS_KH), p.q_norm_g + l * 64, p.k_norm_g + l * 64, (const float*)(p.ws + WS_ROPE), (const float*)(p.ws + WS_ROPE) + SEQ * 32}; pg8::gemm_phase(lds, g, S, E); }
        else if (sub == 1) { phase_prep(p, l, lds); const float lambda_init = 0.8f - 0.6f * expf(-0.3f * (float)l); phase_attn(p, l, lambda_init, lds); }
        else if (sub == 3 || sub == 5) {
            pg8::StaticOrder S; S.init(MTOK, DM, G, c);
            pg8::Gemm g; pg8::EpiRes E;
            _Float16* X16 = (_Float16*)(p.ws + WS_X16);
            if (sub == 3) { g = pg8::Gemm{MIX, (const bf16_t*)(p.ws + WS_WT_OUT) + (size_t)l * DM * DM, MTOK, DM, DM}; E = pg8::EpiRes{X16, X16, nullptr, modl + 2 * DM, gml + NB * DM, H, rs2}; }
            else { const bool lastl = (l == NL - 1);
                g = pg8::Gemm{Zb, (const bf16_t*)(p.ws + WS_WT_DN) + (size_t)l * DM * DFF, MTOK, DM, DFF};
                E = pg8::EpiRes{X16, X16, lastl ? p.out : nullptr, modl + 5 * DM, lastl ? nullptr : gml + 2 * NB * DM, H, lastl ? nullptr : rs1 + (size_t)2 * MTOK * 16}; }
            pg8::gemm_phase(lds, g, S, E); }
        else { pg8::StaticOrder S; S.init(MTOK, GU, G, c); pg8::Gemm g{H, (const bf16_t*)(p.ws + WS_WT_GU) + (size_t)l * GU * DM, MTOK, GU, DM};
            pg8::EpiSwiGLU E{Zb, rs2, (const float*)(p.ws + WS_SHW_GU) + (size_t)l * NB * GU}; pg8::gemm_phase(lds, g, S, E); }
    }
}

extern "C" void kernel_launch(void* const* d_in, const int* in_sizes, int n_in, void* d_out, int out_size, void* d_ws, size_t ws_size, hipStream_t stream) {
    static int grid = 0;
    if (grid == 0) {
        if (n_in != 23 || ws_size < WS_END) { fprintf(stderr, "kernel_launch: unexpected n_in %d or ws_size %zu < %zu\n", n_in, ws_size, (size_t)WS_END); grid = -1; return; }
        int dev = 0, cus = 0, per_cu = 0;
        if (hipGetDevice(&dev) != hipSuccess || hipDeviceGetAttribute(&cus, hipDeviceAttributeMultiprocessorCount, dev) != hipSuccess) { grid = -1; return; }
        if (hipFuncSetAttribute((const void*)fwd_megakernel, hipFuncAttributeMaxDynamicSharedMemorySize, LDS_BYTES) != hipSuccess) { fprintf(stderr, "kernel_launch: hipFuncSetAttribute failed\n"); grid = -1; return; }
        if (hipOccupancyMaxActiveBlocksPerMultiprocessor(&per_cu, (const void*)fwd_megakernel, 512, LDS_BYTES) != hipSuccess || per_cu < 1) { fprintf(stderr, "kernel_launch: occupancy query says %d\n", per_cu); per_cu = 1; }
        (void)hipGetLastError();
        grid = cus;
    }
    if (grid < 0) return;
    if (hipMemsetAsync((char*)d_ws + WS_BAR, 0, 16384, stream) != hipSuccess) { fprintf(stderr, "kernel_launch: memset of the barrier word failed\n"); return; }
    Params p{};
    p.x = (const float*)d_in[0]; p.c = (const float*)d_in[1]; p.pos = (const int*)d_in[2];
    p.norm1_g = (const float*)d_in[3]; p.norm2_g = (const float*)d_in[4]; p.w_ada = (const float*)d_in[5]; p.b_ada = (const float*)d_in[6];
    p.w_in = (const float*)d_in[7]; p.conv_a_w = (const float*)d_in[8]; p.conv_a_b = (const float*)d_in[9]; p.conv_a_norm_g = (const float*)d_in[10];
    p.conv_b_w = (const float*)d_in[11]; p.sc_norm_g = (const float*)d_in[12]; p.q_norm_g = (const float*)d_in[13]; p.k_norm_g = (const float*)d_in[14];
    p.lam_q1 = (const float*)d_in[15]; p.lam_k1 = (const float*)d_in[16]; p.lam_q2 = (const float*)d_in[17]; p.lam_k2 = (const float*)d_in[18];
    p.attn_norm_g = (const float*)d_in[19]; p.w_out = (const float*)d_in[20]; p.w_gate_up = (const float*)d_in[21]; p.w_down = (const float*)d_in[22];
    p.out = (float*)d_out; p.ws = (unsigned char*)d_ws;
#if MK_MULTI
    for (int ph = 0; ph < NPHASE; ++ph) {
        p.ph_lo = ph; p.ph_hi = ph + 1;
        hipLaunchKernelGGL(fwd_megakernel, dim3(grid), dim3(512), LDS_BYTES, stream, p);
    }
#else
    p.ph_lo = 0; p.ph_hi = NPHASE;
    void* args[] = {&p};
    hipError_t e = hipLaunchCooperativeKernel((const void*)fwd_megakernel, dim3(grid), dim3(512), args, LDS_BYTES, stream);
    if (e != hipSuccess) fprintf(stderr, "kernel_launch: cooperative launch failed: %s (grid %d)\n", hipGetErrorString(e), grid);
#endif
}
```

```cpp
#include <hip/hip_runtime.h>
#include <hip/hip_cooperative_groups.h>
#include <cstdio>
namespace cg = cooperative_groups;

#ifndef MK_MULTI
#define MK_MULTI 0
#endif

#define LAS __attribute__((address_space(3)))
#define DI __device__ __forceinline__
typedef unsigned short bf16_t;
typedef short bf16x8 __attribute__((ext_vector_type(8)));
typedef float f32x4 __attribute__((ext_vector_type(4)));
typedef float f32x2 __attribute__((ext_vector_type(2)));
typedef float f32x16 __attribute__((ext_vector_type(16)));
typedef unsigned u32x4 __attribute__((ext_vector_type(4)));
typedef unsigned u32x2 __attribute__((ext_vector_type(2)));
typedef __bf16 bf16x2n __attribute__((ext_vector_type(2)));
typedef _Float16 h16x8 __attribute__((ext_vector_type(8)));
typedef _Float16 h16x4 __attribute__((ext_vector_type(4)));
typedef float f32x8 __attribute__((ext_vector_type(8)));

constexpr int NB = 32, SEQ = 2048, DM = 1024, MTOK = NB * SEQ, NL = 4, INW = 2816, DFF = 2816, GU = 2 * DFF;
constexpr int MODW = 6 * DM;
constexpr float EPS = 1e-6f;
constexpr float LOG2E = 1.4426950408889634f;
constexpr int LDS_BYTES = 131072 + 16;
constexpr int NPHASE = 2 + 5 * NL;

constexpr size_t WS_WT_IN = 0;
constexpr size_t WS_WT_OUT = WS_WT_IN + (size_t)NL * INW * DM * 2;
constexpr size_t WS_WT_GU = WS_WT_OUT + (size_t)NL * DM * DM * 2;
constexpr size_t WS_WT_DN = WS_WT_GU + (size_t)NL * GU * DM * 2;
constexpr size_t WS_MOD = WS_WT_DN + (size_t)NL * DM * DFF * 2;
constexpr size_t WS_ROPE = WS_MOD + (size_t)NL * NB * MODW * 4;
constexpr size_t WS_H = WS_ROPE + (size_t)2 * SEQ * 32 * 4;
constexpr size_t WS_Z = WS_H + (size_t)MTOK * DM * 2;
constexpr size_t WS_QH = WS_Z + (size_t)MTOK * INW * 2;
constexpr size_t WS_KH = WS_QH + (size_t)MTOK * 512 * 2;
constexpr size_t WS_MIX = WS_KH + (size_t)MTOK * 512 * 2;
constexpr size_t WS_ROWSS = WS_MIX + (size_t)MTOK * DM * 2;
constexpr size_t WS_SHW_IN = WS_ROWSS + (size_t)NL * 2 * MTOK * 16 * 4;
constexpr size_t WS_SHW_GU = WS_SHW_IN + (size_t)NL * NB * INW * 4;
constexpr size_t WS_GM = WS_SHW_GU + (size_t)NL * NB * GU * 4;
constexpr size_t WS_X16 = WS_GM + (size_t)NL * 2 * NB * DM * 4;
constexpr size_t WS_BAR = WS_X16 + (size_t)MTOK * DM * 2;
constexpr size_t WS_END = WS_BAR + 16384;

struct Params {
    const float* x; const float* c; const int* pos;
    const float *norm1_g, *norm2_g, *w_ada, *b_ada, *w_in, *conv_a_w, *conv_a_b, *conv_a_norm_g, *conv_b_w, *sc_norm_g,
        *q_norm_g, *k_norm_g, *lam_q1, *lam_k1, *lam_q2, *lam_k2, *attn_norm_g, *w_out, *w_gate_up, *w_down;
    float* out; unsigned char* ws;
    int ph_lo, ph_hi;
};

DI unsigned pk2(float lo, float hi) { f32x2 v = {lo, hi}; return __builtin_bit_cast(unsigned, __builtin_convertvector(v, bf16x2n)); }
DI float bf_lo(unsigned u) { return __uint_as_float(u << 16); }
DI float bf_hi(unsigned u) { return __uint_as_float(u & 0xffff0000u); }
DI float wave_sum(float v) {
#pragma unroll
    for (int o = 1; o < 64; o <<= 1) v += __shfl_xor(v, o);
    return v;
}
DI float wave_max(float v) {
#pragma unroll
    for (int o = 1; o < 64; o <<= 1) v = fmaxf(v, __shfl_xor(v, o));
    return v;
}
DI int opq(int v) { asm volatile("" : "+v"(v)); return v; }
DI float sigmoidf_fast(float v) { return __builtin_amdgcn_rcpf(1.0f + __builtin_amdgcn_exp2f(-v * LOG2E)); }

namespace pg8 {
constexpr int BM = 256, BK = 64, HALF = 128, HTB = HALF * BK * 2, NXCD = 8, WGM = 8;
DI int lds_byte(int r, int c) { const int st = (r >> 4) * 2 + (c >> 5), rr = r & 15, cc = c & 31, ob = rr * 64 + cc * 2; return st * 1024 + (ob ^ (((ob >> 9) & 1) << 5)); }
DI void stage_rc(int b, int& R, int& C) { const int st = b / 1024, sb = b % 1024, swz = sb ^ (((sb >> 9) & 1) << 5); R = (st >> 1) * 16 + swz / 64; C = (st & 1) * 32 + (swz % 64) / 2; }
DI int perm32(int rho) { const int n = rho >> 4, i = rho & 15; return 8 * (i >> 2) + 4 * n + (i & 3); }
struct Unit { int pm, pn; };
struct Gemm { const bf16_t* A; const bf16_t* Bt; int M, N, K; };
struct StaticOrder {
    int nM, nN, nwg, G, c;
    DI void init(int M, int N, int G_, int c_) { nM = M / BM; nN = N / BM; nwg = nM * nN; G = G_; c = c_; }
    DI bool next(int i, Unit& u) const {
        const long L = (long)i * G + c; if (L >= nwg) return false;
        int wgid = (int)L; { const int q = nwg / NXCD, r = nwg % NXCD, xcd = wgid % NXCD, off = wgid / NXCD; wgid = (xcd < r ? xcd * (q + 1) : r * (q + 1) + (xcd - r) * q) + off; }
        const int nig = WGM * nN, gid = wgid / nig, fm = gid * WGM, gsz = (nM - fm) < WGM ? (nM - fm) : WGM;
        u.pm = fm + ((wgid % nig) % gsz); u.pn = (wgid % nig) / gsz; return true;
    }
};

DI void row_rstd8(const float* rowss, int row0, int fq, float (&rstd)[2][4]) {
    f32x4 pr[2][4];
#pragma unroll
    for (int ai = 0; ai < 2; ++ai)
#pragma unroll
        for (int m = 0; m < 4; ++m) pr[ai][m] = *(const f32x4*)(rowss + (size_t)(row0 + ai * HALF + m * 16) * 16 + 4 * fq);
#pragma unroll
    for (int ai = 0; ai < 2; ++ai)
#pragma unroll
        for (int m = 0; m < 4; ++m) { float t = (pr[ai][m][0] + pr[ai][m][1]) + (pr[ai][m][2] + pr[ai][m][3]);
            t += __shfl_xor(t, 16); t += __shfl_xor(t, 32);
            rstd[ai][m] = rsqrtf(t * (1.f / DM) + EPS); }
}
DI void warm_panel(const float* rowss, int c, int tid) {
    const int panel = 32 * (c & 7) + ((c >> 3) & 31);
    const u32x4* src = (const u32x4*)(rowss + (size_t)panel * 256 * 16) + tid;
    const u32x4 a = src[0], b = src[512];
    asm volatile("" :: "v"(a), "v"(b));
}
DI void warm_shw(const float* shw, int ldc, int c, int tid) {
    const int per = ldc / 32;
    if (tid < per) { const u32x4 a = *((const u32x4*)(shw + (size_t)(4 * (c & 7)) * ldc) + ((c >> 3) & 31) * per + tid); asm volatile("" :: "v"(a)); }
}
DI void warm_rope(const float* rc, int c, int tid) {
    const u32x4* src = (const u32x4*)rc + ((c >> 3) & 31) * 1024 + tid;
    const u32x4 a = src[0], b = src[512];
    asm volatile("" :: "v"(a), "v"(b));
}
struct EpiZ {
    static constexpr bool PERM = true;
    bf16_t* O; int ldc; const float* rowss; const float* shw;
    bf16_t* QH; bf16_t* KH; const float* gq; const float* gk; const float* rc; const float* rs;
    DI void warm_phase(int c, int tid) const { warm_panel(rowss, c, tid); warm_shw(shw, ldc, c, tid); warm_rope(rc, c, tid); }
    DI void operator()(const f32x4 (&acc)[2][2][4][2], const Unit& u, int wr, int wc, int fr, int fq) const {
        const int row0 = u.pm * BM + wr * 64 + fr, col0 = u.pn * BM + wc * 32 + 8 * fq, b = (u.pm * BM) / SEQ;
        float rstd8[2][4]; row_rstd8(rowss, row0, fq, rstd8);
        const float* svp = shw + (size_t)b * ldc + col0;
        if (u.pn < 5 || u.pn > 8) {
            f32x4 sv[2][2];
#pragma unroll
            for (int bj = 0; bj < 2; ++bj)
#pragma unroll
                for (int n = 0; n < 2; ++n) sv[bj][n] = *(const f32x4*)(svp + bj * HALF + 4 * n);
#pragma unroll
            for (int ai = 0; ai < 2; ++ai)
#pragma unroll
                for (int m = 0; m < 4; ++m) { const int row = row0 + ai * HALF + m * 16; bf16_t* rowp = O + (size_t)row * ldc + col0;
                    const float rstd = rstd8[ai][m];
#pragma unroll
                    for (int bj = 0; bj < 2; ++bj) { const f32x4 v0 = acc[ai][bj][m][0] * rstd + sv[bj][0], v1 = acc[ai][bj][m][1] * rstd + sv[bj][1];
                        u32x4 w; w.x = pk2(v0[0], v0[1]); w.y = pk2(v0[2], v0[3]); w.z = pk2(v1[0], v1[1]); w.w = pk2(v1[2], v1[3]);
                        *(u32x4*)(rowp + bj * HALF) = w; } }
        } else {
            const int gi = (u.pn - 5) * 4 + wc, isk = gi >> 3, hd = (gi >> 1) & 3, hfh = gi & 1;
            const float* gg = isk ? gk : gq; bf16_t* dst = (isk ? KH : QH) + hd * 128 + hfh * 64 + 4 * fq;
            const float qs = isk ? 1.0f : LOG2E * 0.125f;
#pragma unroll
            for (int ai = 0; ai < 2; ++ai)
#pragma unroll
                for (int m = 0; m < 4; ++m) { const int row = row0 + ai * HALF + m * 16, spos = row & (SEQ - 1);
                    const float rstd = rstd8[ai][m];
                    f32x4 lo[2], hi[2]; float ss = 0.f;
#pragma unroll
                    for (int bj = 0; bj < 2; ++bj) { const f32x4 v0 = acc[ai][bj][m][0] * rstd + *(const f32x4*)(svp + bj * HALF), v1 = acc[ai][bj][m][1] * rstd + *(const f32x4*)(svp + bj * HALF + 4);
                        lo[bj] = (f32x4){v0[0], v0[2], v1[0], v1[2]}; hi[bj] = (f32x4){v0[1], v0[3], v1[1], v1[3]};
                        ss += ((v0[0] * v0[0] + v0[1] * v0[1]) + (v0[2] * v0[2] + v0[3] * v0[3])) + ((v1[0] * v1[0] + v1[1] * v1[1]) + (v1[2] * v1[2] + v1[3] * v1[3])); }
                    ss += __shfl_xor(ss, 16); ss += __shfl_xor(ss, 32);
                    const float rg = rsqrtf(ss * (1.f / 64.f) + EPS) * qs;
#pragma unroll
                    for (int bj = 0; bj < 2; ++bj) {
                        const f32x4 glo = *(const f32x4*)(gg + bj * 16 + fq * 4), ghi = *(const f32x4*)(gg + 32 + bj * 16 + fq * 4);
                        const f32x4 c4 = *(const f32x4*)(rc + spos * 32 + bj * 16 + fq * 4), s4 = *(const f32x4*)(rs + spos * 32 + bj * 16 + fq * 4);
                        const f32x4 a = lo[bj] * rg * glo, bb = hi[bj] * rg * ghi;
                        const f32x4 olo = a * c4 - bb * s4, ohi = bb * c4 + a * s4;
                        u32x2 w0, w1; w0.x = pk2(olo[0], olo[1]); w0.y = pk2(olo[2], olo[3]); w1.x = pk2(ohi[0], ohi[1]); w1.y = pk2(ohi[2], ohi[3]);
                        *(u32x2*)(dst + (size_t)row * 512 + bj * 16) = w0; *(u32x2*)(dst + (size_t)row * 512 + 32 + bj * 16) = w1; }
                    asm volatile("" ::: "memory"); }
        }
    }
};
struct EpiRes {
    static constexpr bool PERM = true;
    const _Float16* xin; _Float16* xout; float* xout32; const float* gate; const float* gm; bf16_t* Hout; float* rowss_out;
    DI void warm_phase(int, int) const {}
    DI void operator()(const f32x4 (&acc)[2][2][4][2], const Unit& u, int wr, int wc, int fr, int fq) const {
        const int row0 = u.pm * BM + wr * 64 + fr, col0 = u.pn * BM + wc * 64 + 8 * fq, b = (u.pm * BM) / SEQ;
        const bool nxt = gm != nullptr, o32 = xout32 != nullptr;
        f32x4 gv[2][2], gmv[2][2];
#pragma unroll
        for (int bj = 0; bj < 2; ++bj)
#pragma unroll
            for (int n = 0; n < 2; ++n) { gv[bj][n] = *(const f32x4*)(gate + (size_t)b * MODW + col0 + bj * 32 + 4 * n);
                gmv[bj][n] = nxt ? *(const f32x4*)(gm + (size_t)b * DM + col0 + bj * 32 + 4 * n) : (f32x4){0.f, 0.f, 0.f, 0.f}; }
        h16x8 xv[4][2];
#define ER_LOAD(rnd) do { const size_t off_ = (size_t)(row0 + ((rnd) >> 2) * HALF + ((rnd) & 3) * 16) * DM + col0; \
            _Pragma("unroll") for (int bj = 0; bj < 2; ++bj) xv[(rnd) & 3][bj] = *(const h16x8*)(xin + off_ + bj * 32); } while (0)
        ER_LOAD(0); ER_LOAD(1); ER_LOAD(2);
        float ssum[4] = {0.f, 0.f, 0.f, 0.f};
#pragma unroll
        for (int rnd = 0; rnd < 8; ++rnd) {
            const int ai = rnd >> 2, m = rnd & 3;
            const size_t off = (size_t)(row0 + ai * HALF + m * 16) * DM + col0;
            f32x4 x0[2], x1[2];
#pragma unroll
            for (int bj = 0; bj < 2; ++bj) { const f32x8 xf = __builtin_convertvector(xv[rnd & 3][bj], f32x8);
                x0[bj] = (f32x4){xf[0], xf[1], xf[2], xf[3]} + gv[bj][0] * acc[ai][bj][m][0]; x1[bj] = (f32x4){xf[4], xf[5], xf[6], xf[7]} + gv[bj][1] * acc[ai][bj][m][1]; }
            if (rnd + 3 < 8) ER_LOAD(rnd + 3);
#pragma unroll
            for (int bj = 0; bj < 2; ++bj) {
                if (o32) { *(f32x4*)(xout32 + off + bj * 32) = x0[bj]; *(f32x4*)(xout32 + off + bj * 32 + 4) = x1[bj]; }
                else { const f32x8 xf = {x0[bj][0], x0[bj][1], x0[bj][2], x0[bj][3], x1[bj][0], x1[bj][1], x1[bj][2], x1[bj][3]};
                    *(h16x8*)(xout + off + bj * 32) = __builtin_convertvector(xf, h16x8); }
                if (nxt) {
                    ssum[m] += ((x0[bj][0] * x0[bj][0] + x0[bj][1] * x0[bj][1]) + (x0[bj][2] * x0[bj][2] + x0[bj][3] * x0[bj][3])) + ((x1[bj][0] * x1[bj][0] + x1[bj][1] * x1[bj][1]) + (x1[bj][2] * x1[bj][2] + x1[bj][3] * x1[bj][3]));
                    const f32x4 h0 = x0[bj] * gmv[bj][0], h1 = x1[bj] * gmv[bj][1];
                    u32x4 w; w.x = pk2(h0[0], h0[1]); w.y = pk2(h0[2], h0[3]); w.z = pk2(h1[0], h1[1]); w.w = pk2(h1[2], h1[3]);
                    *(u32x4*)(Hout + off + bj * 32) = w; } }
            asm volatile("" ::: "memory");
            if (nxt && m == 3) {
                const bool hi2 = (fq & 2) != 0, hi1 = (fq & 1) != 0;
                const float t0 = hi2 ? ssum[0] : ssum[2], t1 = hi2 ? ssum[1] : ssum[3], k0 = hi2 ? ssum[2] : ssum[0], k1 = hi2 ? ssum[3] : ssum[1];
                const float a0 = k0 + __shfl_xor(t0, 32), a1 = k1 + __shfl_xor(t1, 32);
                const float t = hi1 ? a0 : a1, k = hi1 ? a1 : a0;
                const float rsum = k + __shfl_xor(t, 16);
                rowss_out[(size_t)(u.pm * BM + ai * HALF + wr * 64 + fq * 16 + fr) * 16 + u.pn * 4 + wc] = rsum;
#pragma unroll
                for (int i = 0; i < 4; ++i) ssum[i] = 0.f;
            }
        }
#undef ER_LOAD
    }
};
struct EpiSwiGLU {
    static constexpr bool PERM = true;
    bf16_t* O; const float* rowss; const float* shw;
    DI void warm_phase(int c, int tid) const { warm_panel(rowss, c, tid); warm_shw(shw, GU, c, tid); }
    DI void operator()(const f32x4 (&acc)[2][2][4][2], const Unit& u, int wr, int wc, int fr, int fq) const {
        const int row0 = u.pm * BM + wr * 64 + fr, colh = u.pn * 128 + wc * 16 + 4 * fq, b = (u.pm * BM) / SEQ;
        f32x4 sv[2][2];
#pragma unroll
        for (int bj = 0; bj < 2; ++bj)
#pragma unroll
            for (int n = 0; n < 2; ++n) sv[bj][n] = *(const f32x4*)(shw + (size_t)b * GU + 2 * colh + bj * HALF + 4 * n);
        float rstd8[2][4]; row_rstd8(rowss, row0, fq, rstd8);
#pragma unroll
        for (int ai = 0; ai < 2; ++ai)
#pragma unroll
            for (int m = 0; m < 4; ++m) { const int row = row0 + ai * HALF + m * 16; bf16_t* rowp = O + (size_t)row * DFF + colh;
                const float rstd = rstd8[ai][m];
#pragma unroll
                for (int bj = 0; bj < 2; ++bj) { const f32x4 g = acc[ai][bj][m][0] * rstd + sv[bj][0], uu = acc[ai][bj][m][1] * rstd + sv[bj][1];
                    float a[4];
#pragma unroll
                    for (int i = 0; i < 4; ++i) a[i] = g[i] * sigmoidf_fast(g[i]) * uu[i];
                    u32x2 w; w.x = pk2(a[0], a[1]); w.y = pk2(a[2], a[3]);
                    *(u32x2*)(rowp + bj * 64) = w; } }
    }
};

template <class Epi, class Sched>
DI void gemm_phase(LAS unsigned char* lds, const Gemm g, const Sched& S, const Epi& E) {
    const int tid = opq(threadIdx.x), wid = __builtin_amdgcn_readfirstlane(tid >> 6), lane = tid & 63, wr = wid >> 2, wc = wid & 3, fr = lane & 15, fq = lane >> 4;
    const int K = g.K, nt = K / BK;
    unsigned voffA[2], voffB[2];
#pragma unroll
    for (int i = 0; i < 2; ++i) { int R, C; stage_rc(tid * 16 + i * 8192, R, C); const int Rb = Epi::PERM ? ((R & ~31) + perm32(R & 31)) : R;
        voffA[i] = (unsigned)(R * K + C) * 2u; voffB[i] = (unsigned)(Rb * K + C) * 2u; }
    const size_t kstep = (size_t)(BK * 2);
    const size_t hstep = (size_t)HALF * K * 2;
    const size_t tstep = 2 * hstep;
    const unsigned ldsw = (unsigned)wid * 1024u;
    const int aoff = lds_byte(wr * 64 + fr, fq * 8), boff = lds_byte(wc * 32 + fr, fq * 8);
#define PG8_SA(b, h) (((b) * 2 + (h)) * HTB)
#define PG8_SB(b, h) ((4 + (b) * 2 + (h)) * HTB)
#define PG8_STAGE(bufoff, gbase, voff) do { _Pragma("unroll") for (int _i = 0; _i < 2; ++_i) \
        __builtin_amdgcn_global_load_lds((const unsigned*)((const char*)(gbase) + (voff)[_i]), (LAS unsigned*)(lds + (bufoff) + ldsw + _i * 8192), 16, 0, 0); } while (0)
#define PG8_LDA(dst, b, h) do { _Pragma("unroll") for (int m = 0; m < 4; ++m) _Pragma("unroll") for (int k = 0; k < 2; ++k) dst[m][k] = *(const LAS bf16x8*)(lds + PG8_SA(b, h) + aoff + m * 2048 + k * 1024); } while (0)
#define PG8_LDB(dst, b, h) do { _Pragma("unroll") for (int n = 0; n < 2; ++n) _Pragma("unroll") for (int k = 0; k < 2; ++k) dst[n][k] = *(const LAS bf16x8*)(lds + PG8_SB(b, h) + boff + n * 2048 + k * 1024); } while (0)
#define PG8_MMA(ai, bj, At, Bt) do { __builtin_amdgcn_s_setprio(1); _Pragma("unroll") for (int m = 0; m < 4; ++m) _Pragma("unroll") for (int n = 0; n < 2; ++n) _Pragma("unroll") for (int k = 0; k < 2; ++k) \
        acc[ai][bj][m][n] = __builtin_amdgcn_mfma_f32_16x16x32_bf16(Bt[n][k], At[m][k], acc[ai][bj][m][n], 0, 0, 0); __builtin_amdgcn_s_setprio(0); } while (0)
#define PG8_WAIT_V(n) asm volatile("s_waitcnt vmcnt(" #n ")" ::: "memory")
#define PG8_WAIT_L(n) asm volatile("s_waitcnt lgkmcnt(" #n ")" ::: "memory")
#define PG8_BAR __builtin_amdgcn_s_barrier()
#define PG8_SCHED __builtin_amdgcn_sched_barrier(0)
    Unit cur, nxt; int ui = 0;
    if (!S.next(0, cur)) return;
    E.warm_phase(S.c, tid);
    f32x4 acc[2][2][4][2];
#pragma unroll
    for (int a = 0; a < 2; ++a)
#pragma unroll
        for (int b = 0; b < 2; ++b)
#pragma unroll
            for (int m = 0; m < 4; ++m)
#pragma unroll
                for (int n = 0; n < 2; ++n) acc[a][b][m][n] = (f32x4){0.f, 0.f, 0.f, 0.f};
    bf16x8 At[4][2], B0[2][2], B1[2][2];
    const char* cA = (const char*)g.A + (size_t)cur.pm * tstep; const char* cB = (const char*)g.Bt + (size_t)cur.pn * tstep;
    PG8_STAGE(PG8_SB(0, 0), cB, voffB); PG8_STAGE(PG8_SA(0, 0), cA, voffA); PG8_STAGE(PG8_SB(0, 1), cB + hstep, voffB); PG8_STAGE(PG8_SA(0, 1), cA + hstep, voffA);
    if (wr == 1) PG8_BAR;
    PG8_WAIT_V(4); PG8_BAR;
    PG8_STAGE(PG8_SB(1, 0), cB + kstep, voffB); PG8_STAGE(PG8_SA(1, 0), cA + kstep, voffA); PG8_STAGE(PG8_SB(1, 1), cB + hstep + kstep, voffB);
    PG8_WAIT_V(6); PG8_BAR;
    for (;;) {
        const bool has_next = S.next(ui + 1, nxt);
        const char* nA = has_next ? (const char*)g.A + (size_t)nxt.pm * tstep : cA; const char* nB = has_next ? (const char*)g.Bt + (size_t)nxt.pn * tstep : cB;
        for (int t = 0; t < nt; t += 2) {
            const bool last = (t == nt - 2);
            const char* a1 = cA + (size_t)(t + 1) * kstep;
            const char* a2 = last ? nA : cA + (size_t)(t + 2) * kstep; const char* b2 = last ? nB : cB + (size_t)(t + 2) * kstep;
            const char* a3 = a2 + kstep; const char* b3 = b2 + kstep;
            PG8_LDB(B0, 0, 0); PG8_SCHED; PG8_LDA(At, 0, 0); PG8_STAGE(PG8_SA(1, 1), a1 + hstep, voffA);
            PG8_WAIT_L(8); PG8_BAR; PG8_WAIT_L(0); PG8_MMA(0, 0, At, B0); PG8_BAR; PG8_SCHED;
            PG8_LDB(B1, 0, 1); PG8_STAGE(PG8_SB(0, 0), b2, voffB);
            PG8_BAR; PG8_WAIT_L(0); PG8_MMA(0, 1, At, B1); PG8_BAR;
            PG8_LDA(At, 0, 1); PG8_STAGE(PG8_SA(0, 0), a2, voffA);
            PG8_BAR; PG8_WAIT_L(0); PG8_MMA(1, 0, At, B0); PG8_BAR; PG8_SCHED;
            PG8_STAGE(PG8_SB(0, 1), b2 + hstep, voffB);
            PG8_WAIT_V(6); PG8_BAR; PG8_MMA(1, 1, At, B1); PG8_BAR;
            PG8_LDB(B0, 1, 0); PG8_SCHED; PG8_LDA(At, 1, 0); PG8_STAGE(PG8_SA(0, 1), a2 + hstep, voffA);
            PG8_WAIT_L(8); PG8_BAR; PG8_WAIT_L(0); PG8_MMA(0, 0, At, B0); PG8_BAR; PG8_SCHED;
            PG8_LDB(B1, 1, 1); PG8_STAGE(PG8_SB(1, 0), b3, voffB);
            PG8_BAR; PG8_WAIT_L(0); PG8_MMA(0, 1, At, B1); PG8_BAR;
            PG8_LDA(At, 1, 1); PG8_STAGE(PG8_SA(1, 0), a3, voffA);
            PG8_BAR; PG8_WAIT_L(0); PG8_MMA(1, 0, At, B0); PG8_BAR; PG8_SCHED;
            PG8_STAGE(PG8_SB(1, 1), b3 + hstep, voffB);
            PG8_WAIT_V(6); PG8_BAR; PG8_MMA(1, 1, At, B1); PG8_BAR;
        }
        E(acc, cur, wr, wc, fr, fq);
        if (!has_next) break;
#pragma unroll
        for (int a = 0; a < 2; ++a)
#pragma unroll
            for (int b = 0; b < 2; ++b)
#pragma unroll
                for (int m = 0; m < 4; ++m)
#pragma unroll
                    for (int n = 0; n < 2; ++n) acc[a][b][m][n] = (f32x4){0.f, 0.f, 0.f, 0.f};
        cur = nxt; cA = nA; cB = nB; ++ui;
    }
    PG8_WAIT_V(0);
    if (wr == 0) PG8_BAR;
    PG8_BAR;
#undef PG8_SA
#undef PG8_SB
#undef PG8_STAGE
#undef PG8_LDA
#undef PG8_LDB
#undef PG8_MMA
#undef PG8_WAIT_V
#undef PG8_WAIT_L
#undef PG8_BAR
#undef PG8_SCHED
}
}

template <int MODE>
DI int wrow_map(int n) {
    if (MODE == 0) return n;
    if (MODE == 2) { if (n < 1280 || n >= 2304) return n;
        const int gi = (n - 1280) >> 6, d = (n - 1280) & 63, hi = d >> 5, f = d & 31, bj = f >> 4, fq = (f >> 2) & 3, jj = f & 3;
        return 256 * (5 + (gi >> 2)) + 128 * bj + 32 * (gi & 3) + 8 * fq + 2 * jj + hi; }
    if (MODE == 3) return (n & ~255) + 128 * ((n >> 5) & 1) + 32 * ((n >> 6) & 3) + (n & 31);
    const int isu = n >= DFF ? 1 : 0, j = n - isu * DFF; return 8 * (j >> 2) + 4 * isu + (j & 3); }
template <int MODE>
DI void p0_transpose_item(const float* W, int K, int N, bf16_t* WT, LAS float* scr, int item, int lane) {
    const int nblk = N / 32, kb = item / nblk, nb = item % nblk, k0 = 64 * kb, n0 = 32 * nb;
    float wv[32];
#pragma unroll
    for (int i = 0; i < 32; ++i) wv[i] = W[(size_t)(k0 + 2 * i + (lane >> 5)) * N + n0 + (lane & 31)];
#pragma unroll
    for (int i = 0; i < 32; ++i) scr[(2 * i + (lane >> 5)) * 33 + (lane & 31)] = wv[i];
    asm volatile("s_waitcnt lgkmcnt(0)" ::: "memory");
    const int c = lane & 7;
#pragma unroll
    for (int j = 0; j < 4; ++j) { const int n = (lane >> 3) + 8 * j; const LAS float* s = scr + (8 * c) * 33 + n;
        u32x4 o; o.x = pk2(s[0 * 33], s[1 * 33]); o.y = pk2(s[2 * 33], s[3 * 33]); o.z = pk2(s[4 * 33], s[5 * 33]); o.w = pk2(s[6 * 33], s[7 * 33]);
        *(u32x4*)(WT + (size_t)wrow_map<MODE>(n0 + n) * K + k0 + 8 * c) = o; }
    asm volatile("s_waitcnt lgkmcnt(0)" ::: "memory");
}

DI void phase0(const Params& p, LAS unsigned char* lds) {
    const int tid = opq(threadIdx.x), lane = tid & 63, wave = tid >> 6, G = gridDim.x;
    {
        LAS float* cact = (LAS float*)lds;
        float* mod = (float*)(p.ws + WS_MOD);
        constexpr int NITEM = NL * (MODW / 64);
        for (int it = blockIdx.x; it < NITEM; it += G) {
            const int l = it / (MODW / 64), n0 = (it % (MODW / 64)) * 64;
            for (int idx = tid; idx < NB * DM; idx += 512) { const int k = idx >> 5, b = idx & 31; const float v = p.c[b * DM + k]; cact[idx] = v * sigmoidf_fast(v); }
            __syncthreads();
            float acc[32];
#pragma unroll
            for (int b = 0; b < 32; ++b) acc[b] = 0.f;
            const float* wp = p.w_ada + ((size_t)l * DM + 128 * wave) * MODW + n0 + lane;
            const LAS f32x4* cp = (const LAS f32x4*)(cact + (128 * wave) * 32);
#pragma unroll 1
            for (int kk0 = 0; kk0 < 128; kk0 += 32) {
                float wv[32];
#pragma unroll
                for (int i = 0; i < 32; ++i) wv[i] = wp[(size_t)(kk0 + i) * MODW];
#pragma unroll
                for (int i = 0; i < 32; ++i) {
#pragma unroll
                    for (int q = 0; q < 8; ++q) { const f32x4 cv = cp[(kk0 + i) * 8 + q]; acc[4 * q] += cv[0] * wv[i]; acc[4 * q + 1] += cv[1] * wv[i]; acc[4 * q + 2] += cv[2] * wv[i]; acc[4 * q + 3] += cv[3] * wv[i]; }
                }
            }
            __syncthreads();
            LAS float* red = (LAS float*)lds;
#pragma unroll
            for (int b = 0; b < 32; ++b) red[(wave * 32 + b) * 64 + lane] = acc[b];
            __syncthreads();
#pragma unroll
            for (int j = 0; j < 4; ++j) { const int o = tid + 512 * j, b = o >> 6, n = o & 63; float s = p.b_ada[l * MODW + n0 + n];
#pragma unroll
                for (int w = 0; w < 8; ++w) s += red[(w * 32 + b) * 64 + n];
                mod[((size_t)l * NB + b) * MODW + n0 + n] = s; }
            __syncthreads();
        }
    }
    {
        LAS float* scr = (LAS float*)(lds + wave * 16384);
        const int gw = blockIdx.x * 8 + wave, NGW = G * 8;
        constexpr int I_IN = (DM / 64) * (INW / 32), I_OUT = (DM / 64) * (DM / 32), I_GU = (DM / 64) * (GU / 32), I_DN = (DFF / 64) * (DM / 32);
        constexpr int PER_L = I_IN + I_OUT + I_GU + I_DN;
        for (int it = gw; it < NL * PER_L; it += NGW) {
            const int l = it / PER_L; int r = it % PER_L;
            if (r < I_IN) { p0_transpose_item<2>(p.w_in + (size_t)l * DM * INW, DM, INW, (bf16_t*)(p.ws + WS_WT_IN) + (size_t)l * INW * DM, scr, r, lane); continue; } r -= I_IN;
            if (r < I_OUT) { p0_transpose_item<3>(p.w_out + (size_t)l * DM * DM, DM, DM, (bf16_t*)(p.ws + WS_WT_OUT) + (size_t)l * DM * DM, scr, r, lane); continue; } r -= I_OUT;
            if (r < I_GU) { p0_transpose_item<1>(p.w_gate_up + (size_t)l * DM * GU, DM, GU, (bf16_t*)(p.ws + WS_WT_GU) + (size_t)l * GU * DM, scr, r, lane); continue; } r -= I_GU;
            p0_transpose_item<3>(p.w_down + (size_t)l * DFF * DM, DFF, DM, (bf16_t*)(p.ws + WS_WT_DN) + (size_t)l * DM * DFF, scr, r, lane);
        }
    }
    {
        float* rc = (float*)(p.ws + WS_ROPE); float* rs = rc + SEQ * 32;
        for (int idx = blockIdx.x * 512 + tid; idx < SEQ * 32; idx += G * 512) {
            const int s = idx >> 5, i = idx & 31;
            double inv = 1.0, bpow = 0.7498942093324559;
#pragma unroll
            for (int bit = 0; bit < 5; ++bit) { if ((i >> bit) & 1) inv *= bpow; bpow *= bpow; }
            const double rev = (double)p.pos[s] * inv * 0.15915494309189535;
            const float fr = (float)(rev - floor(rev));
            rc[idx] = __builtin_amdgcn_cosf(fr); rs[idx] = __builtin_amdgcn_sinf(fr);
        }
    }
}

DI void phase_pre(const Params& p) {
    const int tid = opq(threadIdx.x), lane = tid & 63, wave = tid >> 6, G = gridDim.x, NGW = G * 8, gw = blockIdx.x * 8 + wave;
    const float* mod = (const float*)(p.ws + WS_MOD);
    {
        const int r = lane & 31, h = lane >> 5;
        constexpr int NBLK_IN = INW / 32, NBLK_GU = GU / 32, PER_L = NBLK_IN + NBLK_GU;
        for (int it = gw; it < NL * PER_L; it += NGW) {
            const int l = it / PER_L, q = it % PER_L; const bool isgu = q >= NBLK_IN; const int nb = isgu ? q - NBLK_IN : q;
            const bf16_t* W = isgu ? (const bf16_t*)(p.ws + WS_WT_GU) + ((size_t)l * GU + nb * 32 + r) * DM : (const bf16_t*)(p.ws + WS_WT_IN) + ((size_t)l * INW + nb * 32 + r) * DM;
            const float* sh = mod + ((size_t)l * NB + r) * MODW + (isgu ? 3 * DM : 0);
            f32x16 acc;
#pragma unroll
            for (int i = 0; i < 16; ++i) acc[i] = 0.f;
#pragma unroll 8
            for (int ks = 0; ks < DM / 16; ++ks) {
                const int k0 = ks * 16 + h * 8;
                const bf16x8 bfrag = *(const bf16x8*)(W + k0);
                const f32x4 s0 = *(const f32x4*)(sh + k0), s1 = *(const f32x4*)(sh + k0 + 4);
                u32x4 a; a.x = pk2(s0[0], s0[1]); a.y = pk2(s0[2], s0[3]); a.z = pk2(s1[0], s1[1]); a.w = pk2(s1[2], s1[3]);
                acc = __builtin_amdgcn_mfma_f32_32x32x16_bf16(__builtin_bit_cast(bf16x8, a), bfrag, acc, 0, 0, 0);
            }
            float* o = isgu ? (float*)(p.ws + WS_SHW_GU) + (size_t)l * NB * GU : (float*)(p.ws + WS_SHW_IN) + (size_t)l * NB * INW;
            const int ld = isgu ? GU : INW;
#pragma unroll
            for (int i = 0; i < 16; ++i) o[(size_t)((i & 3) + 8 * (i >> 2) + 4 * h) * ld + nb * 32 + r] = acc[i];
        }
    }
    {
        float* gm = (float*)(p.ws + WS_GM);
        for (int idx = blockIdx.x * 512 + tid; idx < NL * 2 * NB * DM; idx += G * 512) {
            const int k = idx & 1023, b = (idx >> 10) & 31, sx = (idx >> 15) & 1, l = idx >> 16;
            const float g = (sx ? p.norm2_g : p.norm1_g)[l * DM + k], sc = mod[((size_t)l * NB + b) * MODW + (sx ? 4 : 1) * DM + k];
            gm[idx] = g * (1.0f + sc);
        }
    }
    {
        bf16_t* H = (bf16_t*)(p.ws + WS_H); float* rowss = (float*)(p.ws + WS_ROWSS);
        for (int rb = gw; rb < MTOK / 32; rb += NGW) {
            const int b = (rb * 32) / SEQ;
            f32x4 gs[4];
#pragma unroll
            for (int j = 0; j < 4; ++j) { const int col = 4 * lane + 256 * j;
                const f32x4 gg = *(const f32x4*)(p.norm1_g + col), sc = *(const f32x4*)(mod + (size_t)b * MODW + DM + col);
                gs[j] = gg * (sc + 1.0f); }
            for (int r = 0; r < 32; r += 4) {
                const size_t row = (size_t)rb * 32 + r;
                const f32x4* xr = (const f32x4*)(p.x + row * DM) + lane;
                f32x4 v[4][4];
#pragma unroll
                for (int q = 0; q < 4; ++q)
#pragma unroll
                    for (int j = 0; j < 4; ++j) v[q][j] = xr[256 * q + 64 * j];
#pragma unroll
                for (int q = 0; q < 4; ++q) { float sq = 0.f;
#pragma unroll
                    for (int j = 0; j < 4; ++j) sq += (v[q][j][0] * v[q][j][0] + v[q][j][1] * v[q][j][1]) + (v[q][j][2] * v[q][j][2] + v[q][j][3] * v[q][j][3]);
                    sq = wave_sum(sq);
                    if (lane < 16) rowss[(row + q) * 16 + lane] = (lane == 0) ? sq : 0.f;
                    u32x2* o8 = (u32x2*)(H + (row + q) * DM) + lane; h16x4* x8 = (h16x4*)((_Float16*)(p.ws + WS_X16) + (row + q) * DM) + lane;
#pragma unroll
                    for (int j = 0; j < 4; ++j) { const f32x4 y = v[q][j] * gs[j]; u32x2 w; w.x = pk2(y[0], y[1]); w.y = pk2(y[2], y[3]); o8[64 * j] = w; x8[64 * j] = __builtin_convertvector(v[q][j], h16x4); } }
            }
        }
    }
}

DI void phase_prep(const Params& p, int l, LAS unsigned char* lds) {
    const int tid = opq(threadIdx.x), lane = tid & 63, wave = tid >> 6, G = gridDim.x;
    const bf16_t* Z = (const bf16_t*)(p.ws + WS_Z);
    bf16_t* MIX = (bf16_t*)(p.ws + WS_MIX);
    LAS float* U = (LAS float*)lds;
    LAS float* CV = (LAS float*)(lds + 65536);
    const int cch = tid & 255, th = tid >> 8;
    float cw[31];
#pragma unroll
    for (int j = 0; j < 31; ++j) cw[j] = p.conv_a_w[((size_t)l * 31 + j) * 256 + cch];
    const float cbias = p.conv_a_b[l * 256 + cch];
    const f32x4 ga = *(const f32x4*)(p.conv_a_norm_g + l * 256 + 4 * lane);
    const f32x4 gb = *(const f32x4*)(p.sc_norm_g + l * 256 + 4 * lane);
    f32x4 wb[3];
#pragma unroll
    for (int j = 0; j < 3; ++j) wb[j] = *(const f32x4*)(p.conv_b_w + ((size_t)l * 3 + j) * 256 + 4 * lane);

    const int pvcu = (G % 8 == 0) ? ((blockIdx.x & 7) * (G >> 3) + (blockIdx.x >> 3)) : blockIdx.x;
    for (int it = pvcu; it < MTOK / 32; it += G) {
        const int b = it >> 6, t0 = (it & 63) * 32;
        const size_t tokbase = (size_t)b * SEQ;
        u32x4 av[4], ag[4];
#pragma unroll
        for (int k4 = 0; k4 < 4; ++k4) { const int ci = tid + 512 * k4, row = ci >> 5, ch8 = ci & 31, tok = t0 - 15 + row;
            av[k4] = (u32x4){0u, 0u, 0u, 0u}; ag[k4] = av[k4];
            if (ci < 62 * 32 && tok >= 0 && tok < SEQ) { const bf16_t* zp = Z + (tokbase + tok) * INW + ch8 * 8; av[k4] = *(const u32x4*)zp; ag[k4] = *(const u32x4*)(zp + 256); } }
        const int tw = t0 + wave * 4;
        u32x2 bcg[6], bhv[6], bbg[4];
#pragma unroll
        for (int r = 0; r < 6; ++r) { const int tok = tw - 1 + r; bcg[r] = (u32x2){0u, 0u}; bhv[r] = bcg[r];
            if (tok >= 0 && tok < SEQ) { const bf16_t* zp = Z + (tokbase + tok) * INW + 512 + 4 * lane; bcg[r] = *(const u32x2*)(zp + 256); bhv[r] = *(const u32x2*)(zp + 512);
                if (r >= 1 && r <= 4) bbg[r - 1] = *(const u32x2*)zp; } }
#pragma unroll
        for (int k4 = 0; k4 < 4; ++k4) { const int ci = tid + 512 * k4, row = ci >> 5, ch8 = ci & 31;
            if (ci < 62 * 32) { const u32x4 v = av[k4], gt = ag[k4]; f32x4 o0, o1;
                o0[0] = bf_lo(v.x) * sigmoidf_fast(bf_lo(gt.x)); o0[1] = bf_hi(v.x) * sigmoidf_fast(bf_hi(gt.x));
                o0[2] = bf_lo(v.y) * sigmoidf_fast(bf_lo(gt.y)); o0[3] = bf_hi(v.y) * sigmoidf_fast(bf_hi(gt.y));
                o1[0] = bf_lo(v.z) * sigmoidf_fast(bf_lo(gt.z)); o1[1] = bf_hi(v.z) * sigmoidf_fast(bf_hi(gt.z));
                o1[2] = bf_lo(v.w) * sigmoidf_fast(bf_lo(gt.w)); o1[3] = bf_hi(v.w) * sigmoidf_fast(bf_hi(gt.w));
                *(LAS f32x4*)(U + row * 256 + ch8 * 8) = o0; *(LAS f32x4*)(U + row * 256 + ch8 * 8 + 4) = o1; } }
        __syncthreads();
#pragma unroll 1
        for (int chunk = 0; chunk < 2; ++chunk) {
            const int tb = th * 16 + chunk * 8;
            float uu[38];
#pragma unroll
            for (int i = 0; i < 38; ++i) uu[i] = U[(tb + i) * 256 + cch];
#pragma unroll
            for (int t = 0; t < 8; ++t) { float a = cbias;
#pragma unroll
                for (int j = 0; j < 31; ++j) a += cw[j] * uu[t + j];
                CV[(tb + t) * 256 + cch] = a; }
        }
        __syncthreads();
#pragma unroll
        for (int q = 0; q < 4; ++q) { const int t = wave * 4 + q;
            const f32x4 v = *(const LAS f32x4*)(CV + t * 256 + 4 * lane);
            const float ss = wave_sum((v[0] * v[0] + v[1] * v[1]) + (v[2] * v[2] + v[3] * v[3]));
            const f32x4 y = v * rsqrtf(ss * (1.f / 256.f) + EPS) * ga;
            f32x4 o;
#pragma unroll
            for (int i = 0; i < 4; ++i) o[i] = y[i] * sigmoidf_fast(y[i]);
            u32x2 w; w.x = pk2(o[0], o[1]); w.y = pk2(o[2], o[3]);
            *(u32x2*)(MIX + (tokbase + t0 + t) * DM + 4 * lane) = w; }
        {
            f32x4 mrow[6], bgv[4];
#pragma unroll
            for (int r = 0; r < 6; ++r) { mrow[r][0] = bf_lo(bcg[r].x) * bf_lo(bhv[r].x); mrow[r][1] = bf_hi(bcg[r].x) * bf_hi(bhv[r].x); mrow[r][2] = bf_lo(bcg[r].y) * bf_lo(bhv[r].y); mrow[r][3] = bf_hi(bcg[r].y) * bf_hi(bhv[r].y); }
#pragma unroll
            for (int q = 0; q < 4; ++q) { bgv[q][0] = bf_lo(bbg[q].x); bgv[q][1] = bf_hi(bbg[q].x); bgv[q][2] = bf_lo(bbg[q].y); bgv[q][3] = bf_hi(bbg[q].y); }
#pragma unroll
            for (int q = 0; q < 4; ++q) {
                const f32x4 y = bgv[q] * (wb[0] * mrow[q] + wb[1] * mrow[q + 1] + wb[2] * mrow[q + 2]);
                const float ss = wave_sum((y[0] * y[0] + y[1] * y[1]) + (y[2] * y[2] + y[3] * y[3]));
                const f32x4 o = y * rsqrtf(ss * (1.f / 256.f) + EPS) * gb;
                u32x2 w; w.x = pk2(o[0], o[1]); w.y = pk2(o[2], o[3]);
                *(u32x2*)(MIX + (tokbase + tw + q) * DM + 256 + 4 * lane) = w; }
        }
        __syncthreads();
    }
}

constexpr int KROW = 272, VROW = 320, KBYTES = 64 * KROW, VBYTES = 64 * VROW, ABUF = KBYTES + VBYTES;
typedef short s16x4 __attribute__((ext_vector_type(4)));
#define MFMA32(a, b, c) __builtin_amdgcn_mfma_f32_32x32x16_bf16((a), (b), (c), 0, 0, 0)

DI void phase_attn(const Params& p, int l, float lambda_init, LAS unsigned char* lds) {
    const int tid = opq(threadIdx.x), lane = tid & 63, wave = tid >> 6, G = gridDim.x, r = lane & 31, h = lane >> 5;
    const int rg = wave >> 1, hf = wave & 1;
    const bf16_t* Z = (const bf16_t*)(p.ws + WS_Z);
    const bf16_t* QH = (const bf16_t*)(p.ws + WS_QH); const bf16_t* KH = (const bf16_t*)(p.ws + WS_KH);
    bf16_t* MIX = (bf16_t*)(p.ws + WS_MIX);
    const float sa = wave_sum(p.lam_q1[l * 64 + lane] * p.lam_k1[l * 64 + lane]), sb = wave_sum(p.lam_q2[l * 64 + lane] * p.lam_k2[l * 64 + lane]);
    const float lam = expf(sa) - expf(sb) + lambda_init;
    const float oscale = 1.0f - lambda_init;
    const int kkey = tid >> 3, kch = tid & 7;
    const int vtr = (4 * (lane >> 5) + ((lane >> 2) & 3)) * VROW + (16 * ((lane >> 4) & 1) + 4 * (lane & 3)) * 2;
    const int vcu = (G % 8 == 0) ? ((blockIdx.x & 7) * (G >> 3) + (blockIdx.x >> 3)) : blockIdx.x;
    LAS float* X = (LAS float*)lds + rg * (128 * 32);

    bf16x8 qf[4]; u32x4 krA[2], vrA[2], krB[2], vrB[2];
#define ATT_ITEM_PTRS(it_) const int qblk = (it_) & 15, head = ((it_) >> 4) & 3, b = (it_) >> 6; const size_t tokb = (size_t)b * SEQ; \
        const size_t qtok = tokb + qblk * 128 + rg * 32 + r; \
        const bf16_t* kg = KH + (tokb + kkey) * 512 + head * 128 + kch * 8; const bf16_t* vg = Z + (tokb + kkey) * INW + 2304 + head * 128 + kch * 8;
#define ATT_LOAD(KR, VR, t_) do { const bf16_t* kg2_ = kg + (size_t)(t_) * 64 * 512; const bf16_t* vg2_ = vg + (size_t)(t_) * 64 * INW; \
            KR[0] = *(const u32x4*)kg2_; KR[1] = *(const u32x4*)(kg2_ + 64); VR[0] = *(const u32x4*)vg2_; VR[1] = *(const u32x4*)(vg2_ + 64); } while (0)
#define ATT_ITEM_PREFETCH() do { ATT_LOAD(krA, vrA, 0); ATT_LOAD(krB, vrB, 1); \
            _Pragma("unroll") for (int kk = 0; kk < 4; ++kk) qf[kk] = *(const bf16x8*)(QH + qtok * 512 + head * 128 + hf * 64 + kk * 16 + h * 8); } while (0)
    if (vcu < NB * 4 * 16) { ATT_ITEM_PTRS(vcu); ATT_ITEM_PREFETCH(); }
    for (int it = vcu; it < NB * 4 * 16; it += G) {
        ATT_ITEM_PTRS(it);
        f32x16 o[4];
#pragma unroll
        for (int eb = 0; eb < 4; ++eb)
#pragma unroll
            for (int i = 0; i < 16; ++i) o[eb][i] = 0.f;
        float lsum = 0.f;
#define ATT_WRITE(KR, VR, buf) do { LAS unsigned char* kb_ = lds + (buf) * ABUF; LAS unsigned char* vb_ = kb_ + KBYTES; \
            *(LAS u32x4*)(kb_ + kkey * KROW + kch * 16) = KR[0]; *(LAS u32x4*)(kb_ + kkey * KROW + kch * 16 + 128) = KR[1]; \
            *(LAS u32x4*)(vb_ + kkey * VROW + kch * 16) = VR[0]; *(LAS u32x4*)(vb_ + kkey * VROW + kch * 16 + 128) = VR[1]; } while (0)
#define ATT_COMPUTE(buf) do { const LAS unsigned char* kb = lds + (buf) * ABUF; LAS unsigned char* vb = lds + (buf) * ABUF + KBYTES; \
            _Pragma("unroll") for (int kbk = 0; kbk < 2; ++kbk) { \
                f32x16 s; \
                _Pragma("unroll") for (int i = 0; i < 16; ++i) s[i] = 0.f; \
                _Pragma("unroll") for (int kk = 0; kk < 4; ++kk) { const bf16x8 a = *(const LAS bf16x8*)(kb + (kbk * 32 + r) * KROW + hf * 128 + kk * 32 + h * 16); s = MFMA32(a, qf[kk], s); } \
                float ls = 0.f; \
                _Pragma("unroll") for (int i = 0; i < 16; ++i) { s[i] = __builtin_amdgcn_exp2f(s[i]); ls += s[i]; } \
                lsum += ls; \
                bf16x8 pf[2]; \
                _Pragma("unroll") for (int st = 0; st < 2; ++st) { u32x4 w; w.x = pk2(s[8 * st], s[8 * st + 1]); w.y = pk2(s[8 * st + 2], s[8 * st + 3]); w.z = pk2(s[8 * st + 4], s[8 * st + 5]); w.w = pk2(s[8 * st + 6], s[8 * st + 7]); \
                    pf[st] = __builtin_bit_cast(bf16x8, w); } \
                _Pragma("unroll") for (int st = 0; st < 2; ++st) \
                    _Pragma("unroll") for (int eb = 0; eb < 4; ++eb) { \
                        const s16x4 vlo = __builtin_amdgcn_ds_read_tr16_b64_v4i16((LAS s16x4*)(vb + vtr + (kbk * 32 + st * 16) * VROW + eb * 64)); \
                        const s16x4 vhi = __builtin_amdgcn_ds_read_tr16_b64_v4i16((LAS s16x4*)(vb + vtr + (kbk * 32 + st * 16 + 8) * VROW + eb * 64)); \
                        const bf16x8 vf = __builtin_shufflevector(vlo, vhi, 0, 1, 2, 3, 4, 5, 6, 7); \
                        o[eb] = MFMA32(vf, pf[st], o[eb]); } \
            } } while (0)
        ATT_WRITE(krA, vrA, 0);
        ATT_LOAD(krA, vrA, 2);
        __syncthreads();
#pragma unroll 1
        for (int t = 0; t < SEQ / 64; t += 2) {
            ATT_COMPUTE(0);
            ATT_WRITE(krB, vrB, 1);
            if (t + 3 < SEQ / 64) ATT_LOAD(krB, vrB, t + 3);
            __syncthreads();
            ATT_COMPUTE(1);
            if (t + 2 < SEQ / 64) { ATT_WRITE(krA, vrA, 0);
                if (t + 4 < SEQ / 64) ATT_LOAD(krA, vrA, t + 4); }
            __syncthreads();
        }
#undef ATT_COMPUTE
        bf16_t* orow = MIX + qtok * DM + 512 + head * 128;
        if (it + G < NB * 4 * 16) { ATT_ITEM_PTRS(it + G); ATT_ITEM_PREFETCH(); }
        const float lt = lsum + __shfl_xor(lsum, 32);
        if (hf == 1) {
            const float sc1 = lam / lt;
#pragma unroll
            for (int eb = 0; eb < 4; ++eb)
#pragma unroll
                for (int i = 0; i < 16; ++i) X[(eb * 32 + (i & 3) + 8 * (i >> 2) + 4 * h) * 32 + r] = o[eb][i] * sc1;
        }
        __syncthreads();
        if (hf == 0) {
            const float i0 = 1.0f / lt;
            float ss = 0.f;
#pragma unroll
            for (int eb = 0; eb < 4; ++eb)
#pragma unroll
                for (int i = 0; i < 16; ++i) { const float v = o[eb][i] * i0 - X[(eb * 32 + (i & 3) + 8 * (i >> 2) + 4 * h) * 32 + r]; o[eb][i] = v; ss += v * v; }
            ss += __shfl_xor(ss, 32);
            const float rn = rsqrtf(ss * (1.f / 128.f) + EPS) * oscale;
#pragma unroll
            for (int eb = 0; eb < 4; ++eb)
#pragma unroll
                for (int g4 = 0; g4 < 4; ++g4) { const int e = eb * 32 + 8 * g4 + 4 * h;
                    const f32x4 gg = *(const f32x4*)(p.attn_norm_g + l * 128 + e);
                    u32x2 w; w.x = pk2(o[eb][4 * g4] * rn * gg[0], o[eb][4 * g4 + 1] * rn * gg[1]); w.y = pk2(o[eb][4 * g4 + 2] * rn * gg[2], o[eb][4 * g4 + 3] * rn * gg[3]);
                    *(u32x2*)(orow + e) = w; }
        }
        __syncthreads();
    }
#undef ATT_WRITE
#undef ATT_LOAD
#undef ATT_ITEM_PTRS
#undef ATT_ITEM_PREFETCH
}

#define XB_TMO      128
#define XB_XCNT(j)  (256  + 64 * (j))
#define XB_XSUB(j)  (1280 + 64 * (j))
#define XB_XGEN(j)  (2304 + 64 * (j))
#define XB_TOP      3328
#define XB_TOPGEN   3392
#define XCD_BAR_WORDS 3456
#define XB_SPIN_CAP (1u << 20)
DI unsigned xb_ld(unsigned* p)              { return __hip_atomic_load(p, __ATOMIC_RELAXED, __HIP_MEMORY_SCOPE_AGENT); }
DI unsigned xb_add(unsigned* p, unsigned v) { return __hip_atomic_fetch_add(p, v, __ATOMIC_RELAXED, __HIP_MEMORY_SCOPE_AGENT); }
DI unsigned xb_xcc_id() { return (unsigned)__builtin_amdgcn_s_getreg((3 << 11) | 20) & 0xFu; }
#define XB_SPIN(cond, bar) do { unsigned _sp = 0; while (cond) { __builtin_amdgcn_s_sleep(1); \
    if ((++_sp & 255u) == 0u) { if (xb_ld(&(bar)[XB_TMO])) break; if (_sp > XB_SPIN_CAP) { atomicAdd(&(bar)[XB_TMO], 1u); break; } } } } while (0)
struct XcdBarrier { unsigned* bar; unsigned x; volatile LAS unsigned* st; };
DI XcdBarrier xcd_barrier_post(unsigned* bar, volatile LAS unsigned* st) {
    XcdBarrier b; b.bar = bar; b.x = xb_xcc_id(); b.st = st;
    if (threadIdx.x == 0) (void)xb_add(&bar[XB_XCNT(b.x)], 1u);
    return b;
}
DI void xcd_barrier_complete(unsigned* bar, unsigned x, unsigned& nloc, unsigned& nx) {
    const unsigned G = gridDim.x * gridDim.y * gridDim.z;
    unsigned sum, cnt, mine, sp = 0u;
    for (;;) {
        sum = 0u; cnt = 0u; mine = 0u;
#pragma unroll
        for (unsigned j = 0; j < 16; ++j) { const unsigned c = xb_ld(&bar[XB_XCNT(j)]); sum += c; cnt += (c > 0u) ? 1u : 0u; mine = (j == x) ? c : mine; }
        if (sum == G) break;
        __builtin_amdgcn_s_sleep(1);
        if ((++sp & 255u) == 0u) { if (xb_ld(&bar[XB_TMO])) break; if (sp > XB_SPIN_CAP) { atomicAdd(&bar[XB_TMO], 1u); break; } }
    }
    nloc = mine > 0u ? mine : 1u; nx = cnt > 0u ? cnt : 1u;
}
DI void xcd_barrier(const XcdBarrier& b) {
    asm volatile("s_waitcnt vmcnt(0)" ::: "memory");
    __syncthreads();
    if (threadIdx.x == 0) {
        unsigned* bar = b.bar;
        __builtin_amdgcn_s_waitcnt(0);
        unsigned nloc = b.st[0], nx = b.st[1];
        if (nloc == 0u) { xcd_barrier_complete(bar, b.x, nloc, nx); b.st[0] = nloc; b.st[1] = nx; }
        const unsigned old = xb_add(&bar[XB_XSUB(b.x)], 1u);
        const unsigned gen = old / nloc;
        if (old + 1u == (gen + 1u) * nloc) {
            __builtin_amdgcn_fence(__ATOMIC_RELEASE, "agent");
            asm volatile("s_waitcnt vmcnt(0)" ::: "memory");
            const unsigned og = xb_add(&bar[XB_TOP], 1u);
            const unsigned tg = og / nx;
            if (og + 1u == (tg + 1u) * nx) xb_add(&bar[XB_TOPGEN], 1u);
            else XB_SPIN(xb_ld(&bar[XB_TOPGEN]) == tg, bar);
            __builtin_amdgcn_fence(__ATOMIC_ACQUIRE, "agent");
            xb_add(&bar[XB_XGEN(b.x)], 1u);
            asm volatile("s_waitcnt vmcnt(0)" ::: "memory");
        } else {
            XB_SPIN(xb_ld(&bar[XB_XGEN(b.x)]) == gen, bar);
            __builtin_amdgcn_fence(__ATOMIC_ACQUIRE, "agent");
            asm volatile("s_waitcnt vmcnt(0)" ::: "memory");
        }
    }
    __syncthreads();
}

__global__ void __launch_bounds__(512, 2) fwd_megakernel(Params p) {
    extern __shared__ __attribute__((aligned(16))) unsigned char shm[];
    LAS unsigned char* lds = (LAS unsigned char*)shm;
    cg::grid_group grid = cg::this_grid();
    const int G = gridDim.x, c = blockIdx.x;
    float* mod = (float*)(p.ws + WS_MOD);
    bf16_t* H = (bf16_t*)(p.ws + WS_H); bf16_t* Zb = (bf16_t*)(p.ws + WS_Z); bf16_t* MIX = (bf16_t*)(p.ws + WS_MIX);
    volatile LAS unsigned* bst = (volatile LAS unsigned*)(lds + 131072);
    if (threadIdx.x < 4) bst[threadIdx.x] = 0u;
    __syncthreads();
    const XcdBarrier xb = xcd_barrier_post((unsigned*)(p.ws + WS_BAR), bst);
    float* rowss = (float*)(p.ws + WS_ROWSS);
    for (int ph = p.ph_lo; ph < p.ph_hi; ++ph) {
        if (ph > p.ph_lo) { if (ph == p.ph_lo + 1) grid.sync(); else xcd_barrier(xb); }
        if (ph == 0) { phase0(p, lds); continue; }
        if (ph == 1) { phase_pre(p); continue; }
        const int l = (ph - 2) / 5, s5 = (ph - 2) % 5, sub = s5 + (s5 >= 2 ? 1 : 0);
        const float* modl = mod + (size_t)l * NB * MODW;
        float* rs1 = rowss + (size_t)(2 * l) * MTOK * 16; float* rs2 = rs1 + (size_t)MTOK * 16;
        const float* gml = (const float*)(p.ws + WS_GM) + (size_t)l * 2 * NB * DM;
        if (sub == 0) { pg8::StaticOrder S; S.init(MTOK, INW, G, c); pg8::Gemm g{H, (const bf16_t*)(p.ws + WS_WT_IN) + (size_t)l * INW * DM, MTOK, INW, DM};
            pg8::EpiZ E{Zb, INW, rs1, (const float*)(p.ws + WS_SHW_IN) + (size_t)l * NB * INW, (bf16_t*)(p.ws + WS_QH), (bf16_t*)(p.ws + WS_KH), p.q_norm_g + l * 64, p.k_norm_g + l * 64, (const float*)(p.ws + WS_ROPE), (const float*)(p.ws + WS_ROPE) + SEQ * 32}; pg8::gemm_phase(lds, g, S, E); }
        else if (sub == 1) { phase_prep(p, l, lds); const float lambda_init = 0.8f - 0.6f * expf(-0.3f * (float)l); phase_attn(p, l, lambda_init, lds); }
        else if (sub == 3 || sub == 5) {
            pg8::StaticOrder S; S.init(MTOK, DM, G, c);
            pg8::Gemm g; pg8::EpiRes E;
            _Float16* X16 = (_Float16*)(p.ws + WS_X16);
            if (sub == 3) { g = pg8::Gemm{MIX, (const bf16_t*)(p.ws + WS_WT_OUT) + (size_t)l * DM * DM, MTOK, DM, DM}; E = pg8::EpiRes{X16, X16, nullptr, modl + 2 * DM, gml + NB * DM, H, rs2}; }
            else { const bool lastl = (l == NL - 1);
                g = pg8::Gemm{Zb, (const bf16_t*)(p.ws + WS_WT_DN) + (size_t)l * DM * DFF, MTOK, DM, DFF};
                E = pg8::EpiRes{X16, X16, lastl ? p.out : nullptr, modl + 5 * DM, lastl ? nullptr : gml + 2 * NB * DM, H, lastl ? nullptr : rs1 + (size_t)2 * MTOK * 16}; }
            pg8::gemm_phase(lds, g, S, E); }
        else { pg8::StaticOrder S; S.init(MTOK, GU, G, c); pg8::Gemm g{H, (const bf16_t*)(p.ws + WS_WT_GU) + (size_t)l * GU * DM, MTOK, GU, DM};
            pg8::EpiSwiGLU E{Zb, rs2, (const float*)(p.ws + WS_SHW_GU) + (size_t)l * NB * GU}; pg8::gemm_phase(lds, g, S, E); }
    }
}

extern "C" void kernel_launch(void* const* d_in, const int* in_sizes, int n_in, void* d_out, int out_size, void* d_ws, size_t ws_size, hipStream_t stream) {
    static int grid = 0;
    if (grid == 0) {
        if (n_in != 23 || ws_size < WS_END) { fprintf(stderr, "kernel_launch: unexpected n_in %d or ws_size %zu < %zu\n", n_in, ws_size, (size_t)WS_END); grid = -1; return; }
        int dev = 0, cus = 0, per_cu = 0;
        if (hipGetDevice(&dev) != hipSuccess || hipDeviceGetAttribute(&cus, hipDeviceAttributeMultiprocessorCount, dev) != hipSuccess) { grid = -1; return; }
        if (hipFuncSetAttribute((const void*)fwd_megakernel, hipFuncAttributeMaxDynamicSharedMemorySize, LDS_BYTES) != hipSuccess) { fprintf(stderr, "kernel_launch: hipFuncSetAttribute failed\n"); grid = -1; return; }
        if (hipOccupancyMaxActiveBlocksPerMultiprocessor(&per_cu, (const void*)fwd_megakernel, 512, LDS_BYTES) != hipSuccess || per_cu < 1) { fprintf(stderr, "kernel_launch: occupancy query says %d\n", per_cu); per_cu = 1; }
        (void)hipGetLastError();
        grid = cus;
    }
    if (grid < 0) return;
    if (hipMemsetAsync((char*)d_ws + WS_BAR, 0, 16384, stream) != hipSuccess) { fprintf(stderr, "kernel_launch: memset of the barrier word failed\n"); return; }
    Params p{};
    p.x = (const float*)d_in[0]; p.c = (const float*)d_in[1]; p.pos = (const int*)d_in[2];
    p.norm1_g = (const float*)d_in[3]; p.norm2_g = (const float*)d_in[4]; p.w_ada = (const float*)d_in[5]; p.b_ada = (const float*)d_in[6];
    p.w_in = (const float*)d_in[7]; p.conv_a_w = (const float*)d_in[8]; p.conv_a_b = (const float*)d_in[9]; p.conv_a_norm_g = (const float*)d_in[10];
    p.conv_b_w = (const float*)d_in[11]; p.sc_norm_g = (const float*)d_in[12]; p.q_norm_g = (const float*)d_in[13]; p.k_norm_g = (const float*)d_in[14];
    p.lam_q1 = (const float*)d_in[15]; p.lam_k1 = (const float*)d_in[16]; p.lam_q2 = (const float*)d_in[17]; p.lam_k2 = (const float*)d_in[18];
    p.attn_norm_g = (const float*)d_in[19]; p.w_out = (const float*)d_in[20]; p.w_gate_up = (const float*)d_in[21]; p.w_down = (const float*)d_in[22];
    p.out = (float*)d_out; p.ws = (unsigned char*)d_ws;
#if MK_MULTI
    for (int ph = 0; ph < NPHASE; ++ph) {
        p.ph_lo = ph; p.ph_hi = ph + 1;
        hipLaunchKernelGGL(fwd_megakernel, dim3(grid), dim3(512), LDS_BYTES, stream, p);
    }
#else
    p.ph_lo = 0; p.ph_hi = NPHASE;
    void* args[] = {&p};
    hipError_t e = hipLaunchCooperativeKernel((const void*)fwd_megakernel, dim3(grid), dim3(512), args, LDS_BYTES, stream);
    if (e != hipSuccess) fprintf(stderr, "kernel_launch: cooperative launch failed: %s (grid %d)\n", hipGetErrorString(e), grid);
#endif
}
```

```cpp
#include <hip/hip_runtime.h>
#include <hip/hip_cooperative_groups.h>
#include <cstdio>
namespace cg = cooperative_groups;

#ifndef MK_MULTI
#define MK_MULTI 0
#endif

#define LAS __attribute__((address_space(3)))
#define DI __device__ __forceinline__
typedef unsigned short bf16_t;
typedef short bf16x8 __attribute__((ext_vector_type(8)));
typedef float f32x4 __attribute__((ext_vector_type(4)));
typedef float f32x2 __attribute__((ext_vector_type(2)));
typedef float f32x16 __attribute__((ext_vector_type(16)));
typedef unsigned u32x4 __attribute__((ext_vector_type(4)));
typedef unsigned u32x2 __attribute__((ext_vector_type(2)));
typedef __bf16 bf16x2n __attribute__((ext_vector_type(2)));
typedef _Float16 h16x8 __attribute__((ext_vector_type(8)));
typedef _Float16 h16x4 __attribute__((ext_vector_type(4)));
typedef float f32x8 __attribute__((ext_vector_type(8)));

constexpr int NB = 32, SEQ = 2048, DM = 1024, MTOK = NB * SEQ, NL = 4, INW = 2816, DFF = 2816, GU = 2 * DFF;
constexpr int MODW = 6 * DM;
constexpr float EPS = 1e-6f;
constexpr float LOG2E = 1.4426950408889634f;
constexpr int LDS_BYTES = 131072 + 16;
constexpr int NPHASE = 2 + 5 * NL;

constexpr size_t WS_WT_IN = 0;
constexpr size_t WS_WT_OUT = WS_WT_IN + (size_t)NL * INW * DM * 2;
constexpr size_t WS_WT_GU = WS_WT_OUT + (size_t)NL * DM * DM * 2;
constexpr size_t WS_WT_DN = WS_WT_GU + (size_t)NL * GU * DM * 2;
constexpr size_t WS_MOD = WS_WT_DN + (size_t)NL * DM * DFF * 2;
constexpr size_t WS_ROPE = WS_MOD + (size_t)NL * NB * MODW * 4;
constexpr size_t WS_H = WS_ROPE + (size_t)2 * SEQ * 32 * 4;
constexpr size_t WS_Z = WS_H + (size_t)MTOK * DM * 2;
constexpr size_t WS_QH = WS_Z + (size_t)MTOK * INW * 2;
constexpr size_t WS_KH = WS_QH + (size_t)MTOK * 512 * 2;
constexpr size_t WS_MIX = WS_KH + (size_t)MTOK * 512 * 2;
constexpr size_t WS_ROWSS = WS_MIX + (size_t)MTOK * DM * 2;
constexpr size_t WS_SHW_IN = WS_ROWSS + (size_t)NL * 2 * MTOK * 16 * 4;
constexpr size_t WS_SHW_GU = WS_SHW_IN + (size_t)NL * NB * INW * 4;
constexpr size_t WS_GM = WS_SHW_GU + (size_t)NL * NB * GU * 4;
constexpr size_t WS_X16 = WS_GM + (size_t)NL * 2 * NB * DM * 4;
constexpr size_t WS_BAR = WS_X16 + (size_t)MTOK * DM * 2;
constexpr size_t WS_END = WS_BAR + 16384;

struct Params {
    const float* x; const float* c; const int* pos;
    const float *norm1_g, *norm2_g, *w_ada, *b_ada, *w_in, *conv_a_w, *conv_a_b, *conv_a_norm_g, *conv_b_w, *sc_norm_g,
        *q_norm_g, *k_norm_g, *lam_q1, *lam_k1, *lam_q2, *lam_k2, *attn_norm_g, *w_out, *w_gate_up, *w_down;
    float* out; unsigned char* ws;
    int ph_lo, ph_hi;
};

DI unsigned pk2(float lo, float hi) { f32x2 v = {lo, hi}; return __builtin_bit_cast(unsigned, __builtin_convertvector(v, bf16x2n)); }
DI float bf_lo(unsigned u) { return __uint_as_float(u << 16); }
DI float bf_hi(unsigned u) { return __uint_as_float(u & 0xffff0000u); }
DI float wave_sum(float v) {
#pragma unroll
    for (int o = 1; o < 64; o <<= 1) v += __shfl_xor(v, o);
    return v;
}
DI float wave_max(float v) {
#pragma unroll
    for (int o = 1; o < 64; o <<= 1) v = fmaxf(v, __shfl_xor(v, o));
    return v;
}
DI int opq(int v) { asm volatile("" : "+v"(v)); return v; }
DI float sigmoidf_fast(float v) { return __builtin_amdgcn_rcpf(1.0f + __builtin_amdgcn_exp2f(-v * LOG2E)); }

namespace pg8 {
constexpr int BM = 256, BK = 64, HALF = 128, HTB = HALF * BK * 2, NXCD = 8, WGM = 8;
DI int lds_byte(int r, int c) { const int st = (r >> 4) * 2 + (c >> 5), rr = r & 15, cc = c & 31, ob = rr * 64 + cc * 2; return st * 1024 + (ob ^ (((ob >> 9) & 1) << 5)); }
DI void stage_rc(int b, int& R, int& C) { const int st = b / 1024, sb = b % 1024, swz = sb ^ (((sb >> 9) & 1) << 5); R = (st >> 1) * 16 + swz / 64; C = (st & 1) * 32 + (swz % 64) / 2; }
DI int perm32(int rho) { const int n = rho >> 4, i = rho & 15; return 8 * (i >> 2) + 4 * n + (i & 3); }
struct Unit { int pm, pn; };
struct Gemm { const bf16_t* A; const bf16_t* Bt; int M, N, K; };
struct StaticOrder {
    int nM, nN, nwg, G, c;
    DI void init(int M, int N, int G_, int c_) { nM = M / BM; nN = N / BM; nwg = nM * nN; G = G_; c = c_; }
    DI bool next(int i, Unit& u) const {
        const long L = (long)i * G + c; if (L >= nwg) return false;
        int wgid = (int)L; { const int q = nwg / NXCD, r = nwg % NXCD, xcd = wgid % NXCD, off = wgid / NXCD; wgid = (xcd < r ? xcd * (q + 1) : r * (q + 1) + (xcd - r) * q) + off; }
        const int nig = WGM * nN, gid = wgid / nig, fm = gid * WGM, gsz = (nM - fm) < WGM ? (nM - fm) : WGM;
        u.pm = fm + ((wgid % nig) % gsz); u.pn = (wgid % nig) / gsz; return true;
    }
};

DI void row_rstd8(const float* rowss, int row0, int fq, float (&rstd)[2][4]) {
    f32x4 pr[2][4];
#pragma unroll
    for (int ai = 0; ai < 2; ++ai)
#pragma unroll
        for (int m = 0; m < 4; ++m) pr[ai][m] = *(const f32x4*)(rowss + (size_t)(row0 + ai * HALF + m * 16) * 16 + 4 * fq);
#pragma unroll
    for (int ai = 0; ai < 2; ++ai)
#pragma unroll
        for (int m = 0; m < 4; ++m) { float t = (pr[ai][m][0] + pr[ai][m][1]) + (pr[ai][m][2] + pr[ai][m][3]);
            t += __shfl_xor(t, 16); t += __shfl_xor(t, 32);
            rstd[ai][m] = rsqrtf(t * (1.f / DM) + EPS); }
}
DI void warm_panel(const float* rowss, int c, int tid) {
    const int panel = 32 * (c & 7) + ((c >> 3) & 31);
    const u32x4* src = (const u32x4*)(rowss + (size_t)panel * 256 * 16) + tid;
    const u32x4 a = src[0], b = src[512];
    asm volatile("" :: "v"(a), "v"(b));
}
DI void warm_shw(const float* shw, int ldc, int c, int tid) {
    const int per = ldc / 32;
    if (tid < per) { const u32x4 a = *((const u32x4*)(shw + (size_t)(4 * (c & 7)) * ldc) + ((c >> 3) & 31) * per + tid); asm volatile("" :: "v"(a)); }
}
DI void warm_rope(const float* rc, int c, int tid) {
    const u32x4* src = (const u32x4*)rc + ((c >> 3) & 31) * 1024 + tid;
    const u32x4 a = src[0], b = src[512];
    asm volatile("" :: "v"(a), "v"(b));
}
struct EpiZ {
    static constexpr bool PERM = true;
    bf16_t* O; int ldc; const float* rowss; const float* shw;
    bf16_t* QH; bf16_t* KH; const float* gq; const float* gk; const float* rc; const float* rs;
    DI void warm_phase(int c, int tid) const { warm_panel(rowss, c, tid); warm_shw(shw, ldc, c, tid); warm_rope(rc, c, tid); }
    DI void operator()(const f32x4 (&acc)[2][2][4][2], const Unit& u, int wr, int wc, int fr, int fq) const {
        const int row0 = u.pm * BM + wr * 64 + fr, col0 = u.pn * BM + wc * 32 + 8 * fq, b = (u.pm * BM) / SEQ;
        float rstd8[2][4]; row_rstd8(rowss, row0, fq, rstd8);
        const float* svp = shw + (size_t)b * ldc + col0;
        if (u.pn < 2) {
            f32x4 sv[2][2];
#pragma unroll
            for (int bj = 0; bj < 2; ++bj)
#pragma unroll
                for (int n = 0; n < 2; ++n) sv[bj][n] = *(const f32x4*)(svp + bj * HALF + 4 * n);
            const int ch0 = u.pn * 128 + wc * 16 + 4 * fq;
#pragma unroll
            for (int ai = 0; ai < 2; ++ai)
#pragma unroll
                for (int m = 0; m < 4; ++m) { const int row = row0 + ai * HALF + m * 16; bf16_t* rowp = O + (size_t)row * ldc + ch0;
                    const float rstd = rstd8[ai][m];
#pragma unroll
                    for (int bj = 0; bj < 2; ++bj) { const f32x4 vv = acc[ai][bj][m][0] * rstd + sv[bj][0], gg = acc[ai][bj][m][1] * rstd + sv[bj][1];
                        float a[4];
#pragma unroll
                        for (int i = 0; i < 4; ++i) a[i] = vv[i] * sigmoidf_fast(gg[i]);
                        u32x2 w; w.x = pk2(a[0], a[1]); w.y = pk2(a[2], a[3]);
                        *(u32x2*)(rowp + bj * 64) = w; } }
        } else if (u.pn < 5 || u.pn > 8) {
            f32x4 sv[2][2];
#pragma unroll
            for (int bj = 0; bj < 2; ++bj)
#pragma unroll
                for (int n = 0; n < 2; ++n) sv[bj][n] = *(const f32x4*)(svp + bj * HALF + 4 * n);
#pragma unroll
            for (int ai = 0; ai < 2; ++ai)
#pragma unroll
                for (int m = 0; m < 4; ++m) { const int row = row0 + ai * HALF + m * 16; bf16_t* rowp = O + (size_t)row * ldc + col0;
                    const float rstd = rstd8[ai][m];
#pragma unroll
                    for (int bj = 0; bj < 2; ++bj) { const f32x4 v0 = acc[ai][bj][m][0] * rstd + sv[bj][0], v1 = acc[ai][bj][m][1] * rstd + sv[bj][1];
                        u32x4 w; w.x = pk2(v0[0], v0[1]); w.y = pk2(v0[2], v0[3]); w.z = pk2(v1[0], v1[1]); w.w = pk2(v1[2], v1[3]);
                        *(u32x4*)(rowp + bj * HALF) = w; } }
        } else {
            const int gi = (u.pn - 5) * 4 + wc, isk = gi >> 3, hd = (gi >> 1) & 3, hfh = gi & 1;
            const float* gg = isk ? gk : gq; bf16_t* dst = (isk ? KH : QH) + hd * 128 + hfh * 64 + 4 * fq;
            const float qs = isk ? 1.0f : LOG2E * 0.125f;
#pragma unroll
            for (int ai = 0; ai < 2; ++ai)
#pragma unroll
                for (int m = 0; m < 4; ++m) { const int row = row0 + ai * HALF + m * 16, spos = row & (SEQ - 1);
                    const float rstd = rstd8[ai][m];
                    f32x4 lo[2], hi[2]; float ss = 0.f;
#pragma unroll
                    for (int bj = 0; bj < 2; ++bj) { const f32x4 v0 = acc[ai][bj][m][0] * rstd + *(const f32x4*)(svp + bj * HALF), v1 = acc[ai][bj][m][1] * rstd + *(const f32x4*)(svp + bj * HALF + 4);
                        lo[bj] = (f32x4){v0[0], v0[2], v1[0], v1[2]}; hi[bj] = (f32x4){v0[1], v0[3], v1[1], v1[3]};
                        ss += ((v0[0] * v0[0] + v0[1] * v0[1]) + (v0[2] * v0[2] + v0[3] * v0[3])) + ((v1[0] * v1[0] + v1[1] * v1[1]) + (v1[2] * v1[2] + v1[3] * v1[3])); }
                    ss += __shfl_xor(ss, 16); ss += __shfl_xor(ss, 32);
                    const float rg = rsqrtf(ss * (1.f / 64.f) + EPS) * qs;
#pragma unroll
                    for (int bj = 0; bj < 2; ++bj) {
                        const f32x4 glo = *(const f32x4*)(gg + bj * 16 + fq * 4), ghi = *(const f32x4*)(gg + 32 + bj * 16 + fq * 4);
                        const f32x4 c4 = *(const f32x4*)(rc + spos * 32 + bj * 16 + fq * 4), s4 = *(const f32x4*)(rs + spos * 32 + bj * 16 + fq * 4);
                        const f32x4 a = lo[bj] * rg * glo, bb = hi[bj] * rg * ghi;
                        const f32x4 olo = a * c4 - bb * s4, ohi = bb * c4 + a * s4;
                        u32x2 w0, w1; w0.x = pk2(olo[0], olo[1]); w0.y = pk2(olo[2], olo[3]); w1.x = pk2(ohi[0], ohi[1]); w1.y = pk2(ohi[2], ohi[3]);
                        *(u32x2*)(dst + (size_t)row * 512 + bj * 16) = w0; *(u32x2*)(dst + (size_t)row * 512 + 32 + bj * 16) = w1; }
                    asm volatile("" ::: "memory"); }
        }
    }
};
struct EpiRes {
    static constexpr bool PERM = true;
    const _Float16* xin; _Float16* xout; float* xout32; const float* gate; const float* gm; bf16_t* Hout; float* rowss_out;
    DI void warm_phase(int, int) const {}
    DI void operator()(const f32x4 (&acc)[2][2][4][2], const Unit& u, int wr, int wc, int fr, int fq) const {
        const int row0 = u.pm * BM + wr * 64 + fr, col0 = u.pn * BM + wc * 64 + 8 * fq, b = (u.pm * BM) / SEQ;
        const bool nxt = gm != nullptr, o32 = xout32 != nullptr;
        f32x4 gv[2][2], gmv[2][2];
#pragma unroll
        for (int bj = 0; bj < 2; ++bj)
#pragma unroll
            for (int n = 0; n < 2; ++n) { gv[bj][n] = *(const f32x4*)(gate + (size_t)b * MODW + col0 + bj * 32 + 4 * n);
                gmv[bj][n] = nxt ? *(const f32x4*)(gm + (size_t)b * DM + col0 + bj * 32 + 4 * n) : (f32x4){0.f, 0.f, 0.f, 0.f}; }
        h16x8 xv[4][2];
#define ER_LOAD(rnd) do { const size_t off_ = (size_t)(row0 + ((rnd) >> 2) * HALF + ((rnd) & 3) * 16) * DM + col0; \
            _Pragma("unroll") for (int bj = 0; bj < 2; ++bj) xv[(rnd) & 3][bj] = *(const h16x8*)(xin + off_ + bj * 32); } while (0)
        ER_LOAD(0); ER_LOAD(1); ER_LOAD(2);
        float ssum[4] = {0.f, 0.f, 0.f, 0.f};
#pragma unroll
        for (int rnd = 0; rnd < 8; ++rnd) {
            const int ai = rnd >> 2, m = rnd & 3;
            const size_t off = (size_t)(row0 + ai * HALF + m * 16) * DM + col0;
            f32x4 x0[2], x1[2];
#pragma unroll
            for (int bj = 0; bj < 2; ++bj) { const f32x8 xf = __builtin_convertvector(xv[rnd & 3][bj], f32x8);
                x0[bj] = (f32x4){xf[0], xf[1], xf[2], xf[3]} + gv[bj][0] * acc[ai][bj][m][0]; x1[bj] = (f32x4){xf[4], xf[5], xf[6], xf[7]} + gv[bj][1] * acc[ai][bj][m][1]; }
            if (rnd + 3 < 8) ER_LOAD(rnd + 3);
#pragma unroll
            for (int bj = 0; bj < 2; ++bj) {
                if (o32) { *(f32x4*)(xout32 + off + bj * 32) = x0[bj]; *(f32x4*)(xout32 + off + bj * 32 + 4) = x1[bj]; }
                else { const f32x8 xf = {x0[bj][0], x0[bj][1], x0[bj][2], x0[bj][3], x1[bj][0], x1[bj][1], x1[bj][2], x1[bj][3]};
                    *(h16x8*)(xout + off + bj * 32) = __builtin_convertvector(xf, h16x8); }
                if (nxt) {
                    ssum[m] += ((x0[bj][0] * x0[bj][0] + x0[bj][1] * x0[bj][1]) + (x0[bj][2] * x0[bj][2] + x0[bj][3] * x0[bj][3])) + ((x1[bj][0] * x1[bj][0] + x1[bj][1] * x1[bj][1]) + (x1[bj][2] * x1[bj][2] + x1[bj][3] * x1[bj][3]));
                    const f32x4 h0 = x0[bj] * gmv[bj][0], h1 = x1[bj] * gmv[bj][1];
                    u32x4 w; w.x = pk2(h0[0], h0[1]); w.y = pk2(h0[2], h0[3]); w.z = pk2(h1[0], h1[1]); w.w = pk2(h1[2], h1[3]);
                    *(u32x4*)(Hout + off + bj * 32) = w; } }
            asm volatile("" ::: "memory");
            if (nxt && m == 3) {
                const bool hi2 = (fq & 2) != 0, hi1 = (fq & 1) != 0;
                const float t0 = hi2 ? ssum[0] : ssum[2], t1 = hi2 ? ssum[1] : ssum[3], k0 = hi2 ? ssum[2] : ssum[0], k1 = hi2 ? ssum[3] : ssum[1];
                const float a0 = k0 + __shfl_xor(t0, 32), a1 = k1 + __shfl_xor(t1, 32);
                const float t = hi1 ? a0 : a1, k = hi1 ? a1 : a0;
                const float rsum = k + __shfl_xor(t, 16);
                rowss_out[(size_t)(u.pm * BM + ai * HALF + wr * 64 + fq * 16 + fr) * 16 + u.pn * 4 + wc] = rsum;
#pragma unroll
                for (int i = 0; i < 4; ++i) ssum[i] = 0.f;
            }
        }
#undef ER_LOAD
    }
};
struct EpiSwiGLU {
    static constexpr bool PERM = true;
    bf16_t* O; const float* rowss; const float* shw;
    DI void warm_phase(int c, int tid) const { warm_panel(rowss, c, tid); warm_shw(shw, GU, c, tid); }
    DI void operator()(const f32x4 (&acc)[2][2][4][2], const Unit& u, int wr, int wc, int fr, int fq) const {
        const int row0 = u.pm * BM + wr * 64 + fr, colh = u.pn * 128 + wc * 16 + 4 * fq, b = (u.pm * BM) / SEQ;
        f32x4 sv[2][2];
#pragma unroll
        for (int bj = 0; bj < 2; ++bj)
#pragma unroll
            for (int n = 0; n < 2; ++n) sv[bj][n] = *(const f32x4*)(shw + (size_t)b * GU + 2 * colh + bj * HALF + 4 * n);
        float rstd8[2][4]; row_rstd8(rowss, row0, fq, rstd8);
#pragma unroll
        for (int ai = 0; ai < 2; ++ai)
#pragma unroll
            for (int m = 0; m < 4; ++m) { const int row = row0 + ai * HALF + m * 16; bf16_t* rowp = O + (size_t)row * DFF + colh;
                const float rstd = rstd8[ai][m];
#pragma unroll
                for (int bj = 0; bj < 2; ++bj) { const f32x4 g = acc[ai][bj][m][0] * rstd + sv[bj][0], uu = acc[ai][bj][m][1] * rstd + sv[bj][1];
                    float a[4];
#pragma unroll
                    for (int i = 0; i < 4; ++i) a[i] = g[i] * sigmoidf_fast(g[i]) * uu[i];
                    u32x2 w; w.x = pk2(a[0], a[1]); w.y = pk2(a[2], a[3]);
                    *(u32x2*)(rowp + bj * 64) = w; } }
    }
};

template <class Epi, class Sched>
DI void gemm_phase(LAS unsigned char* lds, const Gemm g, const Sched& S, const Epi& E) {
    const int tid = opq(threadIdx.x), wid = __builtin_amdgcn_readfirstlane(tid >> 6), lane = tid & 63, wr = wid >> 2, wc = wid & 3, fr = lane & 15, fq = lane >> 4;
    const int K = g.K, nt = K / BK;
    unsigned voffA[2], voffB[2];
#pragma unroll
    for (int i = 0; i < 2; ++i) { int R, C; stage_rc(tid * 16 + i * 8192, R, C); const int Rb = Epi::PERM ? ((R & ~31) + perm32(R & 31)) : R;
        voffA[i] = (unsigned)(R * K + C) * 2u; voffB[i] = (unsigned)(Rb * K + C) * 2u; }
    const size_t kstep = (size_t)(BK * 2);
    const size_t hstep = (size_t)HALF * K * 2;
    const size_t tstep = 2 * hstep;
    const unsigned ldsw = (unsigned)wid * 1024u;
    const int aoff = lds_byte(wr * 64 + fr, fq * 8), boff = lds_byte(wc * 32 + fr, fq * 8);
#define PG8_SA(b, h) (((b) * 2 + (h)) * HTB)
#define PG8_SB(b, h) ((4 + (b) * 2 + (h)) * HTB)
#define PG8_STAGE(bufoff, gbase, voff) do { _Pragma("unroll") for (int _i = 0; _i < 2; ++_i) \
        __builtin_amdgcn_global_load_lds((const unsigned*)((const char*)(gbase) + (voff)[_i]), (LAS unsigned*)(lds + (bufoff) + ldsw + _i * 8192), 16, 0, 0); } while (0)
#define PG8_LDA(dst, b, h) do { _Pragma("unroll") for (int m = 0; m < 4; ++m) _Pragma("unroll") for (int k = 0; k < 2; ++k) dst[m][k] = *(const LAS bf16x8*)(lds + PG8_SA(b, h) + aoff + m * 2048 + k * 1024); } while (0)
#define PG8_LDB(dst, b, h) do { _Pragma("unroll") for (int n = 0; n < 2; ++n) _Pragma("unroll") for (int k = 0; k < 2; ++k) dst[n][k] = *(const LAS bf16x8*)(lds + PG8_SB(b, h) + boff + n * 2048 + k * 1024); } while (0)
#define PG8_MMA(ai, bj, At, Bt) do { __builtin_amdgcn_s_setprio(1); _Pragma("unroll") for (int m = 0; m < 4; ++m) _Pragma("unroll") for (int n = 0; n < 2; ++n) _Pragma("unroll") for (int k = 0; k < 2; ++k) \
        acc[ai][bj][m][n] = __builtin_amdgcn_mfma_f32_16x16x32_bf16(Bt[n][k], At[m][k], acc[ai][bj][m][n], 0, 0, 0); __builtin_amdgcn_s_setprio(0); } while (0)
#define PG8_WAIT_V(n) asm volatile("s_waitcnt vmcnt(" #n ")" ::: "memory")
#define PG8_WAIT_L(n) asm volatile("s_waitcnt lgkmcnt(" #n ")" ::: "memory")
#define PG8_BAR __builtin_amdgcn_s_barrier()
#define PG8_SCHED __builtin_amdgcn_sched_barrier(0)
    Unit cur, nxt; int ui = 0;
    if (!S.next(0, cur)) return;
    E.warm_phase(S.c, tid);
    f32x4 acc[2][2][4][2];
#pragma unroll
    for (int a = 0; a < 2; ++a)
#pragma unroll
        for (int b = 0; b < 2; ++b)
#pragma unroll
            for (int m = 0; m < 4; ++m)
#pragma unroll
                for (int n = 0; n < 2; ++n) acc[a][b][m][n] = (f32x4){0.f, 0.f, 0.f, 0.f};
    bf16x8 At[4][2], B0[2][2], B1[2][2];
    const char* cA = (const char*)g.A + (size_t)cur.pm * tstep; const char* cB = (const char*)g.Bt + (size_t)cur.pn * tstep;
    PG8_STAGE(PG8_SB(0, 0), cB, voffB); PG8_STAGE(PG8_SA(0, 0), cA, voffA); PG8_STAGE(PG8_SB(0, 1), cB + hstep, voffB); PG8_STAGE(PG8_SA(0, 1), cA + hstep, voffA);
    if (wr == 1) PG8_BAR;
    PG8_WAIT_V(4); PG8_BAR;
    PG8_STAGE(PG8_SB(1, 0), cB + kstep, voffB); PG8_STAGE(PG8_SA(1, 0), cA + kstep, voffA); PG8_STAGE(PG8_SB(1, 1), cB + hstep + kstep, voffB);
    PG8_WAIT_V(6); PG8_BAR;
    for (;;) {
        const bool has_next = S.next(ui + 1, nxt);
        const char* nA = has_next ? (const char*)g.A + (size_t)nxt.pm * tstep : cA; const char* nB = has_next ? (const char*)g.Bt + (size_t)nxt.pn * tstep : cB;
        for (int t = 0; t < nt; t += 2) {
            const bool last = (t == nt - 2);
            const char* a1 = cA + (size_t)(t + 1) * kstep;
            const char* a2 = last ? nA : cA + (size_t)(t + 2) * kstep; const char* b2 = last ? nB : cB + (size_t)(t + 2) * kstep;
            const char* a3 = a2 + kstep; const char* b3 = b2 + kstep;
            PG8_LDB(B0, 0, 0); PG8_SCHED; PG8_LDA(At, 0, 0); PG8_STAGE(PG8_SA(1, 1), a1 + hstep, voffA);
            PG8_WAIT_L(8); PG8_BAR; PG8_WAIT_L(0); PG8_MMA(0, 0, At, B0); PG8_BAR; PG8_SCHED;
            PG8_LDB(B1, 0, 1); PG8_STAGE(PG8_SB(0, 0), b2, voffB);
            PG8_BAR; PG8_WAIT_L(0); PG8_MMA(0, 1, At, B1); PG8_BAR;
            PG8_LDA(At, 0, 1); PG8_STAGE(PG8_SA(0, 0), a2, voffA);
            PG8_BAR; PG8_WAIT_L(0); PG8_MMA(1, 0, At, B0); PG8_BAR; PG8_SCHED;
            PG8_STAGE(PG8_SB(0, 1), b2 + hstep, voffB);
            PG8_WAIT_V(6); PG8_BAR; PG8_MMA(1, 1, At, B1); PG8_BAR;
            PG8_LDB(B0, 1, 0); PG8_SCHED; PG8_LDA(At, 1, 0); PG8_STAGE(PG8_SA(0, 1), a2 + hstep, voffA);
            PG8_WAIT_L(8); PG8_BAR; PG8_WAIT_L(0); PG8_MMA(0, 0, At, B0); PG8_BAR; PG8_SCHED;
            PG8_LDB(B1, 1, 1); PG8_STAGE(PG8_SB(1, 0), b3, voffB);
            PG8_BAR; PG8_WAIT_L(0); PG8_MMA(0, 1, At, B1); PG8_BAR;
            PG8_LDA(At, 1, 1); PG8_STAGE(PG8_SA(1, 0), a3, voffA);
            PG8_BAR; PG8_WAIT_L(0); PG8_MMA(1, 0, At, B0); PG8_BAR; PG8_SCHED;
            PG8_STAGE(PG8_SB(1, 1), b3 + hstep, voffB);
            PG8_WAIT_V(6); PG8_BAR; PG8_MMA(1, 1, At, B1); PG8_BAR;
        }
        E(acc, cur, wr, wc, fr, fq);
        if (!has_next) break;
#pragma unroll
        for (int a = 0; a < 2; ++a)
#pragma unroll
            for (int b = 0; b < 2; ++b)
#pragma unroll
                for (int m = 0; m < 4; ++m)
#pragma unroll
                    for (int n = 0; n < 2; ++n) acc[a][b][m][n] = (f32x4){0.f, 0.f, 0.f, 0.f};
        cur = nxt; cA = nA; cB = nB; ++ui;
    }
    PG8_WAIT_V(0);
    if (wr == 0) PG8_BAR;
    PG8_BAR;
#undef PG8_SA
#undef PG8_SB
#undef PG8_STAGE
#undef PG8_LDA
#undef PG8_LDB
#undef PG8_MMA
#undef PG8_WAIT_V
#undef PG8_WAIT_L
#undef PG8_BAR
#undef PG8_SCHED
}
}

template <int MODE>
DI int wrow_map(int n) {
    if (MODE == 0) return n;
    if (MODE == 2) { if (n < 512) { const int isg = n >> 8, j = n & 255; return 8 * (j >> 2) + 4 * isg + (j & 3); }
        if (n < 1280 || n >= 2304) return n;
        const int gi = (n - 1280) >> 6, d = (n - 1280) & 63, hi = d >> 5, f = d & 31, bj = f >> 4, fq = (f >> 2) & 3, jj = f & 3;
        return 256 * (5 + (gi >> 2)) + 128 * bj + 32 * (gi & 3) + 8 * fq + 2 * jj + hi; }
    if (MODE == 3) return (n & ~255) + 128 * ((n >> 5) & 1) + 32 * ((n >> 6) & 3) + (n & 31);
    const int isu = n >= DFF ? 1 : 0, j = n - isu * DFF; return 8 * (j >> 2) + 4 * isu + (j & 3); }
template <int MODE>
DI void p0_transpose_item(const float* W, int K, int N, bf16_t* WT, LAS float* scr, int item, int lane) {
    const int nblk = N / 32, kb = item / nblk, nb = item % nblk, k0 = 64 * kb, n0 = 32 * nb;
    float wv[32];
#pragma unroll
    for (int i = 0; i < 32; ++i) wv[i] = W[(size_t)(k0 + 2 * i + (lane >> 5)) * N + n0 + (lane & 31)];
#pragma unroll
    for (int i = 0; i < 32; ++i) scr[(2 * i + (lane >> 5)) * 33 + (lane & 31)] = wv[i];
    asm volatile("s_waitcnt lgkmcnt(0)" ::: "memory");
    const int c = lane & 7;
#pragma unroll
    for (int j = 0; j < 4; ++j) { const int n = (lane >> 3) + 8 * j; const LAS float* s = scr + (8 * c) * 33 + n;
        u32x4 o; o.x = pk2(s[0 * 33], s[1 * 33]); o.y = pk2(s[2 * 33], s[3 * 33]); o.z = pk2(s[4 * 33], s[5 * 33]); o.w = pk2(s[6 * 33], s[7 * 33]);
        *(u32x4*)(WT + (size_t)wrow_map<MODE>(n0 + n) * K + k0 + 8 * c) = o; }
    asm volatile("s_waitcnt lgkmcnt(0)" ::: "memory");
}

DI void phase0(const Params& p, LAS unsigned char* lds) {
    const int tid = opq(threadIdx.x), lane = tid & 63, wave = tid >> 6, G = gridDim.x;
    {
        LAS float* cact = (LAS float*)lds;
        float* mod = (float*)(p.ws + WS_MOD);
        constexpr int NITEM = NL * (MODW / 64);
        for (int it = blockIdx.x; it < NITEM; it += G) {
            const int l = it / (MODW / 64), n0 = (it % (MODW / 64)) * 64;
            for (int idx = tid; idx < NB * DM; idx += 512) { const int k = idx >> 5, b = idx & 31; const float v = p.c[b * DM + k]; cact[idx] = v * sigmoidf_fast(v); }
            __syncthreads();
            float acc[32];
#pragma unroll
            for (int b = 0; b < 32; ++b) acc[b] = 0.f;
            const float* wp = p.w_ada + ((size_t)l * DM + 128 * wave) * MODW + n0 + lane;
            const LAS f32x4* cp = (const LAS f32x4*)(cact + (128 * wave) * 32);
#pragma unroll 1
            for (int kk0 = 0; kk0 < 128; kk0 += 32) {
                float wv[32];
#pragma unroll
                for (int i = 0; i < 32; ++i) wv[i] = wp[(size_t)(kk0 + i) * MODW];
#pragma unroll
                for (int i = 0; i < 32; ++i) {
#pragma unroll
                    for (int q = 0; q < 8; ++q) { const f32x4 cv = cp[(kk0 + i) * 8 + q]; acc[4 * q] += cv[0] * wv[i]; acc[4 * q + 1] += cv[1] * wv[i]; acc[4 * q + 2] += cv[2] * wv[i]; acc[4 * q + 3] += cv[3] * wv[i]; }
                }
            }
            __syncthreads();
            LAS float* red = (LAS float*)lds;
#pragma unroll
            for (int b = 0; b < 32; ++b) red[(wave * 32 + b) * 64 + lane] = acc[b];
            __syncthreads();
#pragma unroll
            for (int j = 0; j < 4; ++j) { const int o = tid + 512 * j, b = o >> 6, n = o & 63; float s = p.b_ada[l * MODW + n0 + n];
#pragma unroll
                for (int w = 0; w < 8; ++w) s += red[(w * 32 + b) * 64 + n];
                mod[((size_t)l * NB + b) * MODW + n0 + n] = s; }
            __syncthreads();
        }
    }
    {
        LAS float* scr = (LAS float*)(lds + wave * 16384);
        const int gw = blockIdx.x * 8 + wave, NGW = G * 8;
        constexpr int I_IN = (DM / 64) * (INW / 32), I_OUT = (DM / 64) * (DM / 32), I_GU = (DM / 64) * (GU / 32), I_DN = (DFF / 64) * (DM / 32);
        constexpr int PER_L = I_IN + I_OUT + I_GU + I_DN;
        for (int it = gw; it < NL * PER_L; it += NGW) {
            const int l = it / PER_L; int r = it % PER_L;
            if (r < I_IN) { p0_transpose_item<2>(p.w_in + (size_t)l * DM * INW, DM, INW, (bf16_t*)(p.ws + WS_WT_IN) + (size_t)l * INW * DM, scr, r, lane); continue; } r -= I_IN;
            if (r < I_OUT) { p0_transpose_item<3>(p.w_out + (size_t)l * DM * DM, DM, DM, (bf16_t*)(p.ws + WS_WT_OUT) + (size_t)l * DM * DM, scr, r, lane); continue; } r -= I_OUT;
            if (r < I_GU) { p0_transpose_item<1>(p.w_gate_up + (size_t)l * DM * GU, DM, GU, (bf16_t*)(p.ws + WS_WT_GU) + (size_t)l * GU * DM, scr, r, lane); continue; } r -= I_GU;
            p0_transpose_item<3>(p.w_down + (size_t)l * DFF * DM, DFF, DM, (bf16_t*)(p.ws + WS_WT_DN) + (size_t)l * DM * DFF, scr, r, lane);
        }
    }
    {
        float* rc = (float*)(p.ws + WS_ROPE); float* rs = rc + SEQ * 32;
        for (int idx = blockIdx.x * 512 + tid; idx < SEQ * 32; idx += G * 512) {
            const int s = idx >> 5, i = idx & 31;
            double inv = 1.0, bpow = 0.7498942093324559;
#pragma unroll
            for (int bit = 0; bit < 5; ++bit) { if ((i >> bit) & 1) inv *= bpow; bpow *= bpow; }
            const double rev = (double)p.pos[s] * inv * 0.15915494309189535;
            const float fr = (float)(rev - floor(rev));
            rc[idx] = __builtin_amdgcn_cosf(fr); rs[idx] = __builtin_amdgcn_sinf(fr);
        }
    }
}

DI void phase_pre(const Params& p) {
    const int tid = opq(threadIdx.x), lane = tid & 63, wave = tid >> 6, G = gridDim.x, NGW = G * 8, gw = blockIdx.x * 8 + wave;
    const float* mod = (const float*)(p.ws + WS_MOD);
    {
        const int r = lane & 31, h = lane >> 5;
        constexpr int NBLK_IN = INW / 32, NBLK_GU = GU / 32, PER_L = NBLK_IN + NBLK_GU;
        for (int it = gw; it < NL * PER_L; it += NGW) {
            const int l = it / PER_L, q = it % PER_L; const bool isgu = q >= NBLK_IN; const int nb = isgu ? q - NBLK_IN : q;
            const bf16_t* W = isgu ? (const bf16_t*)(p.ws + WS_WT_GU) + ((size_t)l * GU + nb * 32 + r) * DM : (const bf16_t*)(p.ws + WS_WT_IN) + ((size_t)l * INW + nb * 32 + r) * DM;
            const float* sh = mod + ((size_t)l * NB + r) * MODW + (isgu ? 3 * DM : 0);
            f32x16 acc;
#pragma unroll
            for (int i = 0; i < 16; ++i) acc[i] = 0.f;
#pragma unroll 8
            for (int ks = 0; ks < DM / 16; ++ks) {
                const int k0 = ks * 16 + h * 8;
                const bf16x8 bfrag = *(const bf16x8*)(W + k0);
                const f32x4 s0 = *(const f32x4*)(sh + k0), s1 = *(const f32x4*)(sh + k0 + 4);
                u32x4 a; a.x = pk2(s0[0], s0[1]); a.y = pk2(s0[2], s0[3]); a.z = pk2(s1[0], s1[1]); a.w = pk2(s1[2], s1[3]);
                acc = __builtin_amdgcn_mfma_f32_32x32x16_bf16(__builtin_bit_cast(bf16x8, a), bfrag, acc, 0, 0, 0);
            }
            float* o = isgu ? (float*)(p.ws + WS_SHW_GU) + (size_t)l * NB * GU : (float*)(p.ws + WS_SHW_IN) + (size_t)l * NB * INW;
            const int ld = isgu ? GU : INW;
#pragma unroll
            for (int i = 0; i < 16; ++i) o[(size_t)((i & 3) + 8 * (i >> 2) + 4 * h) * ld + nb * 32 + r] = acc[i];
        }
    }
    {
        float* gm = (float*)(p.ws + WS_GM);
        for (int idx = blockIdx.x * 512 + tid; idx < NL * 2 * NB * DM; idx += G * 512) {
            const int k = idx & 1023, b = (idx >> 10) & 31, sx = (idx >> 15) & 1, l = idx >> 16;
            const float g = (sx ? p.norm2_g : p.norm1_g)[l * DM + k], sc = mod[((size_t)l * NB + b) * MODW + (sx ? 4 : 1) * DM + k];
            gm[idx] = g * (1.0f + sc);
        }
    }
    {
        bf16_t* H = (bf16_t*)(p.ws + WS_H); float* rowss = (float*)(p.ws + WS_ROWSS);
        for (int rb = gw; rb < MTOK / 32; rb += NGW) {
            const int b = (rb * 32) / SEQ;
            f32x4 gs[4];
#pragma unroll
            for (int j = 0; j < 4; ++j) { const int col = 4 * lane + 256 * j;
                const f32x4 gg = *(const f32x4*)(p.norm1_g + col), sc = *(const f32x4*)(mod + (size_t)b * MODW + DM + col);
                gs[j] = gg * (sc + 1.0f); }
            for (int r = 0; r < 32; r += 4) {
                const size_t row = (size_t)rb * 32 + r;
                const f32x4* xr = (const f32x4*)(p.x + row * DM) + lane;
                f32x4 v[4][4];
#pragma unroll
                for (int q = 0; q < 4; ++q)
#pragma unroll
                    for (int j = 0; j < 4; ++j) v[q][j] = xr[256 * q + 64 * j];
#pragma unroll
                for (int q = 0; q < 4; ++q) { float sq = 0.f;
#pragma unroll
                    for (int j = 0; j < 4; ++j) sq += (v[q][j][0] * v[q][j][0] + v[q][j][1] * v[q][j][1]) + (v[q][j][2] * v[q][j][2] + v[q][j][3] * v[q][j][3]);
                    sq = wave_sum(sq);
                    if (lane < 16) rowss[(row + q) * 16 + lane] = (lane == 0) ? sq : 0.f;
                    u32x2* o8 = (u32x2*)(H + (row + q) * DM) + lane; h16x4* x8 = (h16x4*)((_Float16*)(p.ws + WS_X16) + (row + q) * DM) + lane;
#pragma unroll
                    for (int j = 0; j < 4; ++j) { const f32x4 y = v[q][j] * gs[j]; u32x2 w; w.x = pk2(y[0], y[1]); w.y = pk2(y[2], y[3]); o8[64 * j] = w; x8[64 * j] = __builtin_convertvector(v[q][j], h16x4); } }
            }
        }
    }
}

DI void phase_prep(const Params& p, int l, LAS unsigned char* lds) {
    const int tid = opq(threadIdx.x), lane = tid & 63, wave = tid >> 6, G = gridDim.x;
    const bf16_t* Z = (const bf16_t*)(p.ws + WS_Z);
    bf16_t* MIX = (bf16_t*)(p.ws + WS_MIX);
    LAS float* U = (LAS float*)lds;
    LAS float* CV = (LAS float*)(lds + 65536);
    const int cch = tid & 255, th = tid >> 8;
    float cw[31];
#pragma unroll
    for (int j = 0; j < 31; ++j) cw[j] = p.conv_a_w[((size_t)l * 31 + j) * 256 + cch];
    const float cbias = p.conv_a_b[l * 256 + cch];
    const f32x4 ga = *(const f32x4*)(p.conv_a_norm_g + l * 256 + 4 * lane);
    const f32x4 gb = *(const f32x4*)(p.sc_norm_g + l * 256 + 4 * lane);
    f32x4 wb[3];
#pragma unroll
    for (int j = 0; j < 3; ++j) wb[j] = *(const f32x4*)(p.conv_b_w + ((size_t)l * 3 + j) * 256 + 4 * lane);

    const int pvcu = (G % 8 == 0) ? ((blockIdx.x & 7) * (G >> 3) + (blockIdx.x >> 3)) : blockIdx.x;
    for (int it = pvcu; it < MTOK / 32; it += G) {
        const int b = it >> 6, t0 = (it & 63) * 32;
        const size_t tokbase = (size_t)b * SEQ;
        u32x4 av[4];
#pragma unroll
        for (int k4 = 0; k4 < 4; ++k4) { const int ci = tid + 512 * k4, row = ci >> 5, ch8 = ci & 31, tok = t0 - 15 + row;
            av[k4] = (u32x4){0u, 0u, 0u, 0u};
            if (ci < 62 * 32 && tok >= 0 && tok < SEQ) av[k4] = *(const u32x4*)(Z + (tokbase + tok) * INW + ch8 * 8); }
        const int tw = t0 + wave * 4;
        u32x2 bcg[6], bhv[6], bbg[4];
#pragma unroll
        for (int r = 0; r < 6; ++r) { const int tok = tw - 1 + r; bcg[r] = (u32x2){0u, 0u}; bhv[r] = bcg[r];
            if (tok >= 0 && tok < SEQ) { const bf16_t* zp = Z + (tokbase + tok) * INW + 512 + 4 * lane; bcg[r] = *(const u32x2*)(zp + 256); bhv[r] = *(const u32x2*)(zp + 512);
                if (r >= 1 && r <= 4) bbg[r - 1] = *(const u32x2*)zp; } }
#pragma unroll
        for (int k4 = 0; k4 < 4; ++k4) { const int ci = tid + 512 * k4, row = ci >> 5, ch8 = ci & 31;
            if (ci < 62 * 32) { const u32x4 v = av[k4]; f32x4 o0, o1;
                o0[0] = bf_lo(v.x); o0[1] = bf_hi(v.x); o0[2] = bf_lo(v.y); o0[3] = bf_hi(v.y);
                o1[0] = bf_lo(v.z); o1[1] = bf_hi(v.z); o1[2] = bf_lo(v.w); o1[3] = bf_hi(v.w);
                *(LAS f32x4*)(U + row * 256 + ch8 * 8) = o0; *(LAS f32x4*)(U + row * 256 + ch8 * 8 + 4) = o1; } }
        __syncthreads();
#pragma unroll 1
        for (int chunk = 0; chunk < 2; ++chunk) {
            const int tb = th * 16 + chunk * 8;
            float uu[38];
#pragma unroll
            for (int i = 0; i < 38; ++i) uu[i] = U[(tb + i) * 256 + cch];
#pragma unroll
            for (int t = 0; t < 8; ++t) { float a = cbias;
#pragma unroll
                for (int j = 0; j < 31; ++j) a += cw[j] * uu[t + j];
                CV[(tb + t) * 256 + cch] = a; }
        }
        __syncthreads();
#pragma unroll
        for (int q = 0; q < 4; ++q) { const int t = wave * 4 + q;
            const f32x4 v = *(const LAS f32x4*)(CV + t * 256 + 4 * lane);
            const float ss = wave_sum((v[0] * v[0] + v[1] * v[1]) + (v[2] * v[2] + v[3] * v[3]));
            const f32x4 y = v * rsqrtf(ss * (1.f / 256.f) + EPS) * ga;
            f32x4 o;
#pragma unroll
            for (int i = 0; i < 4; ++i) o[i] = y[i] * sigmoidf_fast(y[i]);
            u32x2 w; w.x = pk2(o[0], o[1]); w.y = pk2(o[2], o[3]);
            *(u32x2*)(MIX + (tokbase + t0 + t) * DM + 4 * lane) = w; }
        {
            f32x4 mrow[6], bgv[4];
#pragma unroll
            for (int r = 0; r < 6; ++r) { mrow[r][0] = bf_lo(bcg[r].x) * bf_lo(bhv[r].x); mrow[r][1] = bf_hi(bcg[r].x) * bf_hi(bhv[r].x); mrow[r][2] = bf_lo(bcg[r].y) * bf_lo(bhv[r].y); mrow[r][3] = bf_hi(bcg[r].y) * bf_hi(bhv[r].y); }
#pragma unroll
            for (int q = 0; q < 4; ++q) { bgv[q][0] = bf_lo(bbg[q].x); bgv[q][1] = bf_hi(bbg[q].x); bgv[q][2] = bf_lo(bbg[q].y); bgv[q][3] = bf_hi(bbg[q].y); }
#pragma unroll
            for (int q = 0; q < 4; ++q) {
                const f32x4 y = bgv[q] * (wb[0] * mrow[q] + wb[1] * mrow[q + 1] + wb[2] * mrow[q + 2]);
                const float ss = wave_sum((y[0] * y[0] + y[1] * y[1]) + (y[2] * y[2] + y[3] * y[3]));
                const f32x4 o = y * rsqrtf(ss * (1.f / 256.f) + EPS) * gb;
                u32x2 w; w.x = pk2(o[0], o[1]); w.y = pk2(o[2], o[3]);
                *(u32x2*)(MIX + (tokbase + tw + q) * DM + 256 + 4 * lane) = w; }
        }
        __syncthreads();
    }
}

constexpr int KROW = 272, VROW = 320, KBYTES = 64 * KROW, VBYTES = 64 * VROW, ABUF = KBYTES + VBYTES;
typedef short s16x4 __attribute__((ext_vector_type(4)));
#define MFMA32(a, b, c) __builtin_amdgcn_mfma_f32_32x32x16_bf16((a), (b), (c), 0, 0, 0)

DI void phase_attn(const Params& p, int l, float lambda_init, LAS unsigned char* lds) {
    const int tid = opq(threadIdx.x), lane = tid & 63, wave = tid >> 6, G = gridDim.x, r = lane & 31, h = lane >> 5;
    const int rg = wave >> 1, hf = wave & 1;
    const bf16_t* Z = (const bf16_t*)(p.ws + WS_Z);
    const bf16_t* QH = (const bf16_t*)(p.ws + WS_QH); const bf16_t* KH = (const bf16_t*)(p.ws + WS_KH);
    bf16_t* MIX = (bf16_t*)(p.ws + WS_MIX);
    const float sa = wave_sum(p.lam_q1[l * 64 + lane] * p.lam_k1[l * 64 + lane]), sb = wave_sum(p.lam_q2[l * 64 + lane] * p.lam_k2[l * 64 + lane]);
    const float lam = expf(sa) - expf(sb) + lambda_init;
    const float oscale = 1.0f - lambda_init;
    const int kkey = tid >> 3, kch = tid & 7;
    const int vtr = (4 * (lane >> 5) + ((lane >> 2) & 3)) * VROW + (16 * ((lane >> 4) & 1) + 4 * (lane & 3)) * 2;
    const int vcu = (G % 8 == 0) ? ((blockIdx.x & 7) * (G >> 3) + (blockIdx.x >> 3)) : blockIdx.x;
    LAS float* X = (LAS float*)lds + rg * (128 * 32);

    bf16x8 qf[4]; u32x4 krA[2], vrA[2], krB[2], vrB[2];
#define ATT_ITEM_PTRS(it_) const int qblk = (it_) & 15, head = ((it_) >> 4) & 3, b = (it_) >> 6; const size_t tokb = (size_t)b * SEQ; \
        const size_t qtok = tokb + qblk * 128 + rg * 32 + r; \
        const bf16_t* kg = KH + (tokb + kkey) * 512 + head * 128 + kch * 8; const bf16_t* vg = Z + (tokb + kkey) * INW + 2304 + head * 128 + kch * 8;
#define ATT_LOAD(KR, VR, t_) do { const bf16_t* kg2_ = kg + (size_t)(t_) * 64 * 512; const bf16_t* vg2_ = vg + (size_t)(t_) * 64 * INW; \
            KR[0] = *(const u32x4*)kg2_; KR[1] = *(const u32x4*)(kg2_ + 64); VR[0] = *(const u32x4*)vg2_; VR[1] = *(const u32x4*)(vg2_ + 64); } while (0)
#define ATT_ITEM_PREFETCH() do { ATT_LOAD(krA, vrA, 0); ATT_LOAD(krB, vrB, 1); \
            _Pragma("unroll") for (int kk = 0; kk < 4; ++kk) qf[kk] = *(const bf16x8*)(QH + qtok * 512 + head * 128 + hf * 64 + kk * 16 + h * 8); } while (0)
    if (vcu < NB * 4 * 16) { ATT_ITEM_PTRS(vcu); ATT_ITEM_PREFETCH(); }
    for (int it = vcu; it < NB * 4 * 16; it += G) {
        ATT_ITEM_PTRS(it);
        f32x16 o[4];
#pragma unroll
        for (int eb = 0; eb < 4; ++eb)
#pragma unroll
            for (int i = 0; i < 16; ++i) o[eb][i] = 0.f;
        float lsum = 0.f;
#define ATT_WRITE(KR, VR, buf) do { LAS unsigned char* kb_ = lds + (buf) * ABUF; LAS unsigned char* vb_ = kb_ + KBYTES; \
            *(LAS u32x4*)(kb_ + kkey * KROW + kch * 16) = KR[0]; *(LAS u32x4*)(kb_ + kkey * KROW + kch * 16 + 128) = KR[1]; \
            *(LAS u32x4*)(vb_ + kkey * VROW + kch * 16) = VR[0]; *(LAS u32x4*)(vb_ + kkey * VROW + kch * 16 + 128) = VR[1]; } while (0)
#define ATT_COMPUTE(buf) do { const LAS unsigned char* kb = lds + (buf) * ABUF; LAS unsigned char* vb = lds + (buf) * ABUF + KBYTES; \
            _Pragma("unroll") for (int kbk = 0; kbk < 2; ++kbk) { \
                f32x16 s; \
                _Pragma("unroll") for (int i = 0; i < 16; ++i) s[i] = 0.f; \
                _Pragma("unroll") for (int kk = 0; kk < 4; ++kk) { const bf16x8 a = *(const LAS bf16x8*)(kb + (kbk * 32 + r) * KROW + hf * 128 + kk * 32 + h * 16); s = MFMA32(a, qf[kk], s); } \
                float ls = 0.f; \
                _Pragma("unroll") for (int i = 0; i < 16; ++i) { s[i] = __builtin_amdgcn_exp2f(s[i]); ls += s[i]; } \
                lsum += ls; \
                bf16x8 pf[2]; \
                _Pragma("unroll") for (int st = 0; st < 2; ++st) { u32x4 w; w.x = pk2(s[8 * st], s[8 * st + 1]); w.y = pk2(s[8 * st + 2], s[8 * st + 3]); w.z = pk2(s[8 * st + 4], s[8 * st + 5]); w.w = pk2(s[8 * st + 6], s[8 * st + 7]); \
                    pf[st] = __builtin_bit_cast(bf16x8, w); } \
                _Pragma("unroll") for (int st = 0; st < 2; ++st) \
                    _Pragma("unroll") for (int eb = 0; eb < 4; ++eb) { \
                        const s16x4 vlo = __builtin_amdgcn_ds_read_tr16_b64_v4i16((LAS s16x4*)(vb + vtr + (kbk * 32 + st * 16) * VROW + eb * 64)); \
                        const s16x4 vhi = __builtin_amdgcn_ds_read_tr16_b64_v4i16((LAS s16x4*)(vb + vtr + (kbk * 32 + st * 16 + 8) * VROW + eb * 64)); \
                        const bf16x8 vf = __builtin_shufflevector(vlo, vhi, 0, 1, 2, 3, 4, 5, 6, 7); \
                        o[eb] = MFMA32(vf, pf[st], o[eb]); } \
            } } while (0)
        ATT_WRITE(krA, vrA, 0);
        ATT_LOAD(krA, vrA, 2);
        __syncthreads();
#pragma unroll 1
        for (int t = 0; t < SEQ / 64; t += 2) {
            ATT_COMPUTE(0);
            ATT_WRITE(krB, vrB, 1);
            if (t + 3 < SEQ / 64) ATT_LOAD(krB, vrB, t + 3);
            __syncthreads();
            ATT_COMPUTE(1);
            if (t + 2 < SEQ / 64) { ATT_WRITE(krA, vrA, 0);
                if (t + 4 < SEQ / 64) ATT_LOAD(krA, vrA, t + 4); }
            __syncthreads();
        }
#undef ATT_COMPUTE
        bf16_t* orow = MIX + qtok * DM + 512 + head * 128;
        if (it + G < NB * 4 * 16) { ATT_ITEM_PTRS(it + G); ATT_ITEM_PREFETCH(); }
        const float lt = lsum + __shfl_xor(lsum, 32);
        if (hf == 1) {
            const float sc1 = lam / lt;
#pragma unroll
            for (int eb = 0; eb < 4; ++eb)
#pragma unroll
                for (int i = 0; i < 16; ++i) X[(eb * 32 + (i & 3) + 8 * (i >> 2) + 4 * h) * 32 + r] = o[eb][i] * sc1;
        }
        __syncthreads();
        if (hf == 0) {
            const float i0 = 1.0f / lt;
            float ss = 0.f;
#pragma unroll
            for (int eb = 0; eb < 4; ++eb)
#pragma unroll
                for (int i = 0; i < 16; ++i) { const float v = o[eb][i] * i0 - X[(eb * 32 + (i & 3) + 8 * (i >> 2) + 4 * h) * 32 + r]; o[eb][i] = v; ss += v * v; }
            ss += __shfl_xor(ss, 32);
            const float rn = rsqrtf(ss * (1.f / 128.f) + EPS) * oscale;
#pragma unroll
            for (int eb = 0; eb < 4; ++eb)
#pragma unroll
                for (int g4 = 0; g4 < 4; ++g4) { const int e = eb * 32 + 8 * g4 + 4 * h;
                    const f32x4 gg = *(const f32x4*)(p.attn_norm_g + l * 128 + e);
                    u32x2 w; w.x = pk2(o[eb][4 * g4] * rn * gg[0], o[eb][4 * g4 + 1] * rn * gg[1]); w.y = pk2(o[eb][4 * g4 + 2] * rn * gg[2], o[eb][4 * g4 + 3] * rn * gg[3]);
                    *(u32x2*)(orow + e) = w; }
        }
        __syncthreads();
    }
#undef ATT_WRITE
#undef ATT_LOAD
#undef ATT_ITEM_PTRS
#undef ATT_ITEM_PREFETCH
}

#define XB_TMO      128
#define XB_XCNT(j)  (256  + 64 * (j))
#define XB_XSUB(j)  (1280 + 64 * (j))
#define XB_XGEN(j)  (2304 + 64 * (j))
#define XB_TOP      3328
#define XB_TOPGEN   3392
#define XCD_BAR_WORDS 3456
#define XB_SPIN_CAP (1u << 20)
DI unsigned xb_ld(unsigned* p)              { return __hip_atomic_load(p, __ATOMIC_RELAXED, __HIP_MEMORY_SCOPE_AGENT); }
DI unsigned xb_add(unsigned* p, unsigned v) { return __hip_atomic_fetch_add(p, v, __ATOMIC_RELAXED, __HIP_MEMORY_SCOPE_AGENT); }
DI unsigned xb_xcc_id() { return (unsigned)__builtin_amdgcn_s_getreg((3 << 11) | 20) & 0xFu; }
#define XB_SPIN(cond, bar) do { unsigned _sp = 0; while (cond) { __builtin_amdgcn_s_sleep(1); \
    if ((++_sp & 255u) == 0u) { if (xb_ld(&(bar)[XB_TMO])) break; if (_sp > XB_SPIN_CAP) { atomicAdd(&(bar)[XB_TMO], 1u); break; } } } } while (0)
struct XcdBarrier { unsigned* bar; unsigned x; volatile LAS unsigned* st; };
DI XcdBarrier xcd_barrier_post(unsigned* bar, volatile LAS unsigned* st) {
    XcdBarrier b; b.bar = bar; b.x = xb_xcc_id(); b.st = st;
    if (threadIdx.x == 0) (void)xb_add(&bar[XB_XCNT(b.x)], 1u);
    return b;
}
DI void xcd_barrier_complete(unsigned* bar, unsigned x, unsigned& nloc, unsigned& nx) {
    const unsigned G = gridDim.x * gridDim.y * gridDim.z;
    unsigned sum, cnt, mine, sp = 0u;
    for (;;) {
        sum = 0u; cnt = 0u; mine = 0u;
#pragma unroll
        for (unsigned j = 0; j < 16; ++j) { const unsigned c = xb_ld(&bar[XB_XCNT(j)]); sum += c; cnt += (c > 0u) ? 1u : 0u; mine = (j == x) ? c : mine; }
        if (sum == G) break;
        __builtin_amdgcn_s_sleep(1);
        if ((++sp & 255u) == 0u) { if (xb_ld(&bar[XB_TMO])) break; if (sp > XB_SPIN_CAP) { atomicAdd(&bar[XB_TMO], 1u); break; } }
    }
    nloc = mine > 0u ? mine : 1u; nx = cnt > 0u ? cnt : 1u;
}
DI void xcd_barrier(const XcdBarrier& b) {
    asm volatile("s_waitcnt vmcnt(0)" ::: "memory");
    __syncthreads();
    if (threadIdx.x == 0) {
        unsigned* bar = b.bar;
        __builtin_amdgcn_s_waitcnt(0);
        unsigned nloc = b.st[0], nx = b.st[1];
        if (nloc == 0u) { xcd_barrier_complete(bar, b.x, nloc, nx); b.st[0] = nloc; b.st[1] = nx; }
        const unsigned old = xb_add(&bar[XB_XSUB(b.x)], 1u);
        const unsigned gen = old / nloc;
        if (old + 1u == (gen + 1u) * nloc) {
            __builtin_amdgcn_fence(__ATOMIC_RELEASE, "agent");
            asm volatile("s_waitcnt vmcnt(0)" ::: "memory");
            const unsigned og = xb_add(&bar[XB_TOP], 1u);
            const unsigned tg = og / nx;
            if (og + 1u == (tg + 1u) * nx) xb_add(&bar[XB_TOPGEN], 1u);
            else XB_SPIN(xb_ld(&bar[XB_TOPGEN]) == tg, bar);
            __builtin_amdgcn_fence(__ATOMIC_ACQUIRE, "agent");
            xb_add(&bar[XB_XGEN(b.x)], 1u);
            asm volatile("s_waitcnt vmcnt(0)" ::: "memory");
        } else {
            XB_SPIN(xb_ld(&bar[XB_XGEN(b.x)]) == gen, bar);
            __builtin_amdgcn_fence(__ATOMIC_ACQUIRE, "agent");
            asm volatile("s_waitcnt vmcnt(0)" ::: "memory");
        }
    }
    __syncthreads();
}

__global__ void __launch_bounds__(512, 2) fwd_megakernel(Params p) {
    extern __shared__ __attribute__((aligned(16))) unsigned char shm[];
    LAS unsigned char* lds = (LAS unsigned char*)shm;
    cg::grid_group grid = cg::this_grid();
    const int G = gridDim.x, c = blockIdx.x;
    float* mod = (float*)(p.ws + WS_MOD);
    bf16_t* H = (bf16_t*)(p.ws + WS_H); bf16_t* Zb = (bf16_t*)(p.ws + WS_Z); bf16_t* MIX = (bf16_t*)(p.ws + WS_MIX);
    volatile LAS unsigned* bst = (volatile LAS unsigned*)(lds + 131072);
    if (threadIdx.x < 4) bst[threadIdx.x] = 0u;
    __syncthreads();
    const XcdBarrier xb = xcd_barrier_post((unsigned*)(p.ws + WS_BAR), bst);
    float* rowss = (float*)(p.ws + WS_ROWSS);
    for (int ph = p.ph_lo; ph < p.ph_hi; ++ph) {
        if (ph > p.ph_lo) { if (ph == p.ph_lo + 1) grid.sync(); else xcd_barrier(xb); }
        if (ph == 0) { phase0(p, lds); continue; }
        if (ph == 1) { phase_pre(p); continue; }
        const int l = (ph - 2) / 5, s5 = (ph - 2) % 5, sub = s5 + (s5 >= 2 ? 1 : 0);
        const float* modl = mod + (size_t)l * NB * MODW;
        float* rs1 = rowss + (size_t)(2 * l) * MTOK * 16; float* rs2 = rs1 + (size_t)MTOK * 16;
        const float* gml = (const float*)(p.ws + WS_GM) + (size_t)l * 2 * NB * DM;
        if (sub == 0) { pg8::StaticOrder S; S.init(MTOK, INW, G, c); pg8::Gemm g{H, (const bf16_t*)(p.ws + WS_WT_IN) + (size_t)l * INW * DM, MTOK, INW, DM};
            pg8::EpiZ E{Zb, INW, rs1, (const float*)(p.ws + WS_SHW_IN) + (size_t)l * NB * INW, (bf16_t*)(p.ws + WS_QH), (bf16_t*)(p.ws + WS_KH), p.q_norm_g + l * 64, p.k_norm_g + l * 64, (const float*)(p.ws + WS_ROPE), (const float*)(p.ws + WS_ROPE) + SEQ * 32}; pg8::gemm_phase(lds, g, S, E); }
        else if (sub == 1) { phase_prep(p, l, lds); const float lambda_init = 0.8f - 0.6f * expf(-0.3f * (float)l); phase_attn(p, l, lambda_init, lds); }
        else if (sub == 3 || sub == 5) {
            pg8::StaticOrder S; S.init(MTOK, DM, G, c);
            pg8::Gemm g; pg8::EpiRes E;
            _Float16* X16 = (_Float16*)(p.ws + WS_X16);
            if (sub == 3) { g = pg8::Gemm{MIX, (const bf16_t*)(p.ws + WS_WT_OUT) + (size_t)l * DM * DM, MTOK, DM, DM}; E = pg8::EpiRes{X16, X16, nullptr, modl + 2 * DM, gml + NB * DM, H, rs2}; }
            else { const bool lastl = (l == NL - 1);
                g = pg8::Gemm{Zb, (const bf16_t*)(p.ws + WS_WT_DN) + (size_t)l * DM * DFF, MTOK, DM, DFF};
                E = pg8::EpiRes{X16, X16, lastl ? p.out : nullptr, modl + 5 * DM, lastl ? nullptr : gml + 2 * NB * DM, H, lastl ? nullptr : rs1 + (size_t)2 * MTOK * 16}; }
            pg8::gemm_phase(lds, g, S, E); }
        else { pg8::StaticOrder S; S.init(MTOK, GU, G, c); pg8::Gemm g{H, (const bf16_t*)(p.ws + WS_WT_GU) + (size_t)l * GU * DM, MTOK, GU, DM};
            pg8::EpiSwiGLU E{Zb, rs2, (const float*)(p.ws + WS_SHW_GU) + (size_t)l * NB * GU}; pg8::gemm_phase(lds, g, S, E); }
    }
}

extern "C" void kernel_launch(void* const* d_in, const int* in_sizes, int n_in, void* d_out, int out_size, void* d_ws, size_t ws_size, hipStream_t stream) {
    static int grid = 0;
    if (grid == 0) {
        if (n_in != 23 || ws_size < WS_END) { fprintf(stderr, "kernel_launch: unexpected n_in %d or ws_size %zu < %zu\n", n_in, ws_size, (size_t)WS_END); grid = -1; return; }
        int dev = 0, cus = 0, per_cu = 0;
        if (hipGetDevice(&dev) != hipSuccess || hipDeviceGetAttribute(&cus, hipDeviceAttributeMultiprocessorCount, dev) != hipSuccess) { grid = -1; return; }
        if (hipFuncSetAttribute((const void*)fwd_megakernel, hipFuncAttributeMaxDynamicSharedMemorySize, LDS_BYTES) != hipSuccess) { fprintf(stderr, "kernel_launch: hipFuncSetAttribute failed\n"); grid = -1; return; }
        if (hipOccupancyMaxActiveBlocksPerMultiprocessor(&per_cu, (const void*)fwd_megakernel, 512, LDS_BYTES) != hipSuccess || per_cu < 1) { fprintf(stderr, "kernel_launch: occupancy query says %d\n", per_cu); per_cu = 1; }
        (void)hipGetLastError();
        grid = cus;
    }
    if (grid < 0) return;
    if (hipMemsetAsync((char*)d_ws + WS_BAR, 0, 16384, stream) != hipSuccess) { fprintf(stderr, "kernel_launch: memset of the barrier word failed\n"); return; }
    Params p{};
    p.x = (const float*)d_in[0]; p.c = (const float*)d_in[1]; p.pos = (const int*)d_in[2];
    p.norm1_g = (const float*)d_in[3]; p.norm2_g = (const float*)d_in[4]; p.w_ada = (const float*)d_in[5]; p.b_ada = (const float*)d_in[6];
    p.w_in = (const float*)d_in[7]; p.conv_a_w = (const float*)d_in[8]; p.conv_a_b = (const float*)d_in[9]; p.conv_a_norm_g = (const float*)d_in[10];
    p.conv_b_w = (const float*)d_in[11]; p.sc_norm_g = (const float*)d_in[12]; p.q_norm_g = (const float*)d_in[13]; p.k_norm_g = (const float*)d_in[14];
    p.lam_q1 = (const float*)d_in[15]; p.lam_k1 = (const float*)d_in[16]; p.lam_q2 = (const float*)d_in[17]; p.lam_k2 = (const float*)d_in[18];
    p.attn_norm_g = (const float*)d_in[19]; p.w_out = (const float*)d_in[20]; p.w_gate_up = (const float*)d_in[21]; p.w_down = (const float*)d_in[22];
    p.out = (float*)d_out; p.ws = (unsigned char*)d_ws;
#if MK_MULTI
    for (int ph = 0; ph < NPHASE; ++ph) {
        p.ph_lo = ph; p.ph_hi = ph + 1;
        hipLaunchKernelGGL(fwd_megakernel, dim3(grid), dim3(512), LDS_BYTES, stream, p);
    }
#else
    p.ph_lo = 0; p.ph_hi = NPHASE;
    void* args[] = {&p};
    hipError_t e = hipLaunchCooperativeKernel((const void*)fwd_megakernel, dim3(grid), dim3(512), args, LDS_BYTES, stream);
    if (e != hipSuccess) fprintf(stderr, "kernel_launch: cooperative launch failed: %s (grid %d)\n", hipGetErrorString(e), grid);
#endif
}
```

```cpp
#include <hip/hip_runtime.h>
#include <hip/hip_cooperative_groups.h>
#include <cstdio>
namespace cg = cooperative_groups;

#ifndef MK_MULTI
#define MK_MULTI 0
#endif

#define LAS __attribute__((address_space(3)))
#define DI __device__ __forceinline__
typedef unsigned short bf16_t;
typedef short bf16x8 __attribute__((ext_vector_type(8)));
typedef float f32x4 __attribute__((ext_vector_type(4)));
typedef float f32x2 __attribute__((ext_vector_type(2)));
typedef float f32x16 __attribute__((ext_vector_type(16)));
typedef unsigned u32x4 __attribute__((ext_vector_type(4)));
typedef unsigned u32x2 __attribute__((ext_vector_type(2)));
typedef __bf16 bf16x2n __attribute__((ext_vector_type(2)));
typedef _Float16 h16x8 __attribute__((ext_vector_type(8)));
typedef _Float16 h16x4 __attribute__((ext_vector_type(4)));
typedef float f32x8 __attribute__((ext_vector_type(8)));

constexpr int NB = 32, SEQ = 2048, DM = 1024, MTOK = NB * SEQ, NL = 4, INW = 2816, DFF = 2816, GU = 2 * DFF;
constexpr int MODW = 6 * DM;
constexpr float EPS = 1e-6f;
constexpr float LOG2E = 1.4426950408889634f;
constexpr int LDS_BYTES = 131072 + 16;
constexpr int NPHASE = 2 + 5 * NL;

constexpr size_t WS_WT_IN = 0;
constexpr size_t WS_WT_OUT = WS_WT_IN + (size_t)NL * INW * DM * 2;
constexpr size_t WS_WT_GU = WS_WT_OUT + (size_t)NL * DM * DM * 2;
constexpr size_t WS_WT_DN = WS_WT_GU + (size_t)NL * GU * DM * 2;
constexpr size_t WS_MOD = WS_WT_DN + (size_t)NL * DM * DFF * 2;
constexpr size_t WS_ROPE = WS_MOD + (size_t)NL * NB * MODW * 4;
constexpr size_t WS_H = WS_ROPE + (size_t)2 * SEQ * 32 * 4;
constexpr size_t WS_Z = WS_H + (size_t)MTOK * DM * 2;
constexpr size_t WS_QH = WS_Z + (size_t)MTOK * INW * 2;
constexpr size_t WS_KH = WS_QH + (size_t)MTOK * 512 * 2;
constexpr size_t WS_MIX = WS_KH + (size_t)MTOK * 512 * 2;
constexpr size_t WS_ROWSS = WS_MIX + (size_t)MTOK * DM * 2;
constexpr size_t WS_SHW_IN = WS_ROWSS + (size_t)NL * 2 * MTOK * 16 * 4;
constexpr size_t WS_SHW_GU = WS_SHW_IN + (size_t)NL * NB * INW * 4;
constexpr size_t WS_GM = WS_SHW_GU + (size_t)NL * NB * GU * 4;
constexpr size_t WS_X16 = WS_GM + (size_t)NL * 2 * NB * DM * 4;
constexpr size_t WS_BAR = WS_X16 + (size_t)MTOK * DM * 2;
constexpr size_t WS_END = WS_BAR + 16384;

struct Params {
    const float* x; const float* c; const int* pos;
    const float *norm1_g, *norm2_g, *w_ada, *b_ada, *w_in, *conv_a_w, *conv_a_b, *conv_a_norm_g, *conv_b_w, *sc_norm_g,
        *q_norm_g, *k_norm_g, *lam_q1, *lam_k1, *lam_q2, *lam_k2, *attn_norm_g, *w_out, *w_gate_up, *w_down;
    float* out; unsigned char* ws;
    int ph_lo, ph_hi;
};

DI unsigned pk2(float lo, float hi) { f32x2 v = {lo, hi}; return __builtin_bit_cast(unsigned, __builtin_convertvector(v, bf16x2n)); }
DI float bf_lo(unsigned u) { return __uint_as_float(u << 16); }
DI float bf_hi(unsigned u) { return __uint_as_float(u & 0xffff0000u); }
DI float wave_sum(float v) {
#pragma unroll
    for (int o = 1; o < 64; o <<= 1) v += __shfl_xor(v, o);
    return v;
}
DI float wave_max(float v) {
#pragma unroll
    for (int o = 1; o < 64; o <<= 1) v = fmaxf(v, __shfl_xor(v, o));
    return v;
}
DI int opq(int v) { asm volatile("" : "+v"(v)); return v; }
DI float sigmoidf_fast(float v) { return __builtin_amdgcn_rcpf(1.0f + __builtin_amdgcn_exp2f(-v * LOG2E)); }

namespace pg8 {
constexpr int BM = 256, BK = 64, HALF = 128, HTB = HALF * BK * 2, NXCD = 8, WGM = 8;
DI int lds_byte(int r, int c) { const int st = (r >> 4) * 2 + (c >> 5), rr = r & 15, cc = c & 31, ob = rr * 64 + cc * 2; return st * 1024 + (ob ^ (((ob >> 9) & 1) << 5)); }
DI void stage_rc(int b, int& R, int& C) { const int st = b / 1024, sb = b % 1024, swz = sb ^ (((sb >> 9) & 1) << 5); R = (st >> 1) * 16 + swz / 64; C = (st & 1) * 32 + (swz % 64) / 2; }
DI int perm32(int rho) { const int n = rho >> 4, i = rho & 15; return 8 * (i >> 2) + 4 * n + (i & 3); }
struct Unit { int pm, pn; };
struct Gemm { const bf16_t* A; const bf16_t* Bt; int M, N, K; };
struct StaticOrder {
    int nM, nN, nwg, G, c;
    DI void init(int M, int N, int G_, int c_) { nM = M / BM; nN = N / BM; nwg = nM * nN; G = G_; c = c_; }
    DI bool next(int i, Unit& u) const {
        const long L = (long)i * G + c; if (L >= nwg) return false;
        int wgid = (int)L; { const int q = nwg / NXCD, r = nwg % NXCD, xcd = wgid % NXCD, off = wgid / NXCD; wgid = (xcd < r ? xcd * (q + 1) : r * (q + 1) + (xcd - r) * q) + off; }
        const int nig = WGM * nN, gid = wgid / nig, fm = gid * WGM, gsz = (nM - fm) < WGM ? (nM - fm) : WGM;
        u.pm = fm + ((wgid % nig) % gsz); u.pn = (wgid % nig) / gsz; return true;
    }
};

DI void row_rstd8(const float* rowss, int row0, int fq, float (&rstd)[2][4]) {
    f32x4 pr[2][4];
#pragma unroll
    for (int ai = 0; ai < 2; ++ai)
#pragma unroll
        for (int m = 0; m < 4; ++m) pr[ai][m] = *(const f32x4*)(rowss + (size_t)(row0 + ai * HALF + m * 16) * 16 + 4 * fq);
#pragma unroll
    for (int ai = 0; ai < 2; ++ai)
#pragma unroll
        for (int m = 0; m < 4; ++m) { float t = (pr[ai][m][0] + pr[ai][m][1]) + (pr[ai][m][2] + pr[ai][m][3]);
            t += __shfl_xor(t, 16); t += __shfl_xor(t, 32);
            rstd[ai][m] = rsqrtf(t * (1.f / DM) + EPS); }
}
DI void warm_panel(const float* rowss, int c, int tid) {
    const int panel = 32 * (c & 7) + ((c >> 3) & 31);
    const u32x4* src = (const u32x4*)(rowss + (size_t)panel * 256 * 16) + tid;
    const u32x4 a = src[0], b = src[512];
    asm volatile("" :: "v"(a), "v"(b));
}
DI void warm_shw(const float* shw, int ldc, int c, int tid) {
    const int per = ldc / 32;
    if (tid < per) { const u32x4 a = *((const u32x4*)(shw + (size_t)(4 * (c & 7)) * ldc) + ((c >> 3) & 31) * per + tid); asm volatile("" :: "v"(a)); }
}
DI void warm_rope(const float* rc, int c, int tid) {
    const u32x4* src = (const u32x4*)rc + ((c >> 3) & 31) * 1024 + tid;
    const u32x4 a = src[0], b = src[512];
    asm volatile("" :: "v"(a), "v"(b));
}
struct EpiZ {
    static constexpr bool PERM = true;
    bf16_t* O; int ldc; const float* rowss; const float* shw;
    bf16_t* QH; bf16_t* KH; const float* gq; const float* gk; const float* rc; const float* rs;
    DI void warm_phase(int c, int tid) const { warm_panel(rowss, c, tid); warm_shw(shw, ldc, c, tid); warm_rope(rc, c, tid); }
    DI void operator()(const f32x4 (&acc)[2][2][4][2], const Unit& u, int wr, int wc, int fr, int fq) const {
        const int row0 = u.pm * BM + wr * 64 + fr, col0 = u.pn * BM + wc * 32 + 8 * fq, b = (u.pm * BM) / SEQ;
        float rstd8[2][4]; row_rstd8(rowss, row0, fq, rstd8);
        const float* svp = shw + (size_t)b * ldc + col0;
        if (u.pn < 2 || u.pn == 3 || u.pn == 4) {
            const bool glu = u.pn < 2;
            f32x4 sv[2][2];
#pragma unroll
            for (int bj = 0; bj < 2; ++bj)
#pragma unroll
                for (int n = 0; n < 2; ++n) sv[bj][n] = *(const f32x4*)(svp + bj * HALF + 4 * n);
            const int ch0 = (glu ? u.pn * 128 : 768 + (u.pn - 3) * 128) + wc * 16 + 4 * fq;
#pragma unroll
            for (int ai = 0; ai < 2; ++ai)
#pragma unroll
                for (int m = 0; m < 4; ++m) { const int row = row0 + ai * HALF + m * 16; bf16_t* rowp = O + (size_t)row * ldc + ch0;
                    const float rstd = rstd8[ai][m];
#pragma unroll
                    for (int bj = 0; bj < 2; ++bj) { const f32x4 vv = acc[ai][bj][m][0] * rstd + sv[bj][0], gg = acc[ai][bj][m][1] * rstd + sv[bj][1];
                        float a[4];
#pragma unroll
                        for (int i = 0; i < 4; ++i) a[i] = vv[i] * (glu ? sigmoidf_fast(gg[i]) : gg[i]);
                        u32x2 w; w.x = pk2(a[0], a[1]); w.y = pk2(a[2], a[3]);
                        *(u32x2*)(rowp + bj * 64) = w; } }
        } else if (u.pn < 5 || u.pn > 8) {
            f32x4 sv[2][2];
#pragma unroll
            for (int bj = 0; bj < 2; ++bj)
#pragma unroll
                for (int n = 0; n < 2; ++n) sv[bj][n] = *(const f32x4*)(svp + bj * HALF + 4 * n);
#pragma unroll
            for (int ai = 0; ai < 2; ++ai)
#pragma unroll
                for (int m = 0; m < 4; ++m) { const int row = row0 + ai * HALF + m * 16; bf16_t* rowp = O + (size_t)row * ldc + col0;
                    const float rstd = rstd8[ai][m];
#pragma unroll
                    for (int bj = 0; bj < 2; ++bj) { const f32x4 v0 = acc[ai][bj][m][0] * rstd + sv[bj][0], v1 = acc[ai][bj][m][1] * rstd + sv[bj][1];
                        u32x4 w; w.x = pk2(v0[0], v0[1]); w.y = pk2(v0[2], v0[3]); w.z = pk2(v1[0], v1[1]); w.w = pk2(v1[2], v1[3]);
                        *(u32x4*)(rowp + bj * HALF) = w; } }
        } else {
            const int gi = (u.pn - 5) * 4 + wc, isk = gi >> 3, hd = (gi >> 1) & 3, hfh = gi & 1;
            const float* gg = isk ? gk : gq; bf16_t* dst = (isk ? KH : QH) + hd * 128 + hfh * 64 + 4 * fq;
            const float qs = isk ? 1.0f : LOG2E * 0.125f;
#pragma unroll
            for (int ai = 0; ai < 2; ++ai)
#pragma unroll
                for (int m = 0; m < 4; ++m) { const int row = row0 + ai * HALF + m * 16, spos = row & (SEQ - 1);
                    const float rstd = rstd8[ai][m];
                    f32x4 lo[2], hi[2]; float ss = 0.f;
#pragma unroll
                    for (int bj = 0; bj < 2; ++bj) { const f32x4 v0 = acc[ai][bj][m][0] * rstd + *(const f32x4*)(svp + bj * HALF), v1 = acc[ai][bj][m][1] * rstd + *(const f32x4*)(svp + bj * HALF + 4);
                        lo[bj] = (f32x4){v0[0], v0[2], v1[0], v1[2]}; hi[bj] = (f32x4){v0[1], v0[3], v1[1], v1[3]};
                        ss += ((v0[0] * v0[0] + v0[1] * v0[1]) + (v0[2] * v0[2] + v0[3] * v0[3])) + ((v1[0] * v1[0] + v1[1] * v1[1]) + (v1[2] * v1[2] + v1[3] * v1[3])); }
                    ss += __shfl_xor(ss, 16); ss += __shfl_xor(ss, 32);
                    const float rg = rsqrtf(ss * (1.f / 64.f) + EPS) * qs;
#pragma unroll
                    for (int bj = 0; bj < 2; ++bj) {
                        const f32x4 glo = *(const f32x4*)(gg + bj * 16 + fq * 4), ghi = *(const f32x4*)(gg + 32 + bj * 16 + fq * 4);
                        const f32x4 c4 = *(const f32x4*)(rc + spos * 32 + bj * 16 + fq * 4), s4 = *(const f32x4*)(rs + spos * 32 + bj * 16 + fq * 4);
                        const f32x4 a = lo[bj] * rg * glo, bb = hi[bj] * rg * ghi;
                        const f32x4 olo = a * c4 - bb * s4, ohi = bb * c4 + a * s4;
                        u32x2 w0, w1; w0.x = pk2(olo[0], olo[1]); w0.y = pk2(olo[2], olo[3]); w1.x = pk2(ohi[0], ohi[1]); w1.y = pk2(ohi[2], ohi[3]);
                        *(u32x2*)(dst + (size_t)row * 512 + bj * 16) = w0; *(u32x2*)(dst + (size_t)row * 512 + 32 + bj * 16) = w1; }
                    asm volatile("" ::: "memory"); }
        }
    }
};
struct EpiRes {
    static constexpr bool PERM = true;
    const _Float16* xin; _Float16* xout; float* xout32; const float* gate; const float* gm; bf16_t* Hout; float* rowss_out;
    DI void warm_phase(int, int) const {}
    DI void operator()(const f32x4 (&acc)[2][2][4][2], const Unit& u, int wr, int wc, int fr, int fq) const {
        const int row0 = u.pm * BM + wr * 64 + fr, col0 = u.pn * BM + wc * 64 + 8 * fq, b = (u.pm * BM) / SEQ;
        const bool nxt = gm != nullptr, o32 = xout32 != nullptr;
        f32x4 gv[2][2], gmv[2][2];
#pragma unroll
        for (int bj = 0; bj < 2; ++bj)
#pragma unroll
            for (int n = 0; n < 2; ++n) { gv[bj][n] = *(const f32x4*)(gate + (size_t)b * MODW + col0 + bj * 32 + 4 * n);
                gmv[bj][n] = nxt ? *(const f32x4*)(gm + (size_t)b * DM + col0 + bj * 32 + 4 * n) : (f32x4){0.f, 0.f, 0.f, 0.f}; }
        h16x8 xv[4][2];
#define ER_LOAD(rnd) do { const size_t off_ = (size_t)(row0 + ((rnd) >> 2) * HALF + ((rnd) & 3) * 16) * DM + col0; \
            _Pragma("unroll") for (int bj = 0; bj < 2; ++bj) xv[(rnd) & 3][bj] = *(const h16x8*)(xin + off_ + bj * 32); } while (0)
        ER_LOAD(0); ER_LOAD(1); ER_LOAD(2);
        float ssum[4] = {0.f, 0.f, 0.f, 0.f};
#pragma unroll
        for (int rnd = 0; rnd < 8; ++rnd) {
            const int ai = rnd >> 2, m = rnd & 3;
            const size_t off = (size_t)(row0 + ai * HALF + m * 16) * DM + col0;
            f32x4 x0[2], x1[2];
#pragma unroll
            for (int bj = 0; bj < 2; ++bj) { const f32x8 xf = __builtin_convertvector(xv[rnd & 3][bj], f32x8);
                x0[bj] = (f32x4){xf[0], xf[1], xf[2], xf[3]} + gv[bj][0] * acc[ai][bj][m][0]; x1[bj] = (f32x4){xf[4], xf[5], xf[6], xf[7]} + gv[bj][1] * acc[ai][bj][m][1]; }
            if (rnd + 3 < 8) ER_LOAD(rnd + 3);
#pragma unroll
            for (int bj = 0; bj < 2; ++bj) {
                if (o32) { *(f32x4*)(xout32 + off + bj * 32) = x0[bj]; *(f32x4*)(xout32 + off + bj * 32 + 4) = x1[bj]; }
                else { const f32x8 xf = {x0[bj][0], x0[bj][1], x0[bj][2], x0[bj][3], x1[bj][0], x1[bj][1], x1[bj][2], x1[bj][3]};
                    *(h16x8*)(xout + off + bj * 32) = __builtin_convertvector(xf, h16x8); }
                if (nxt) {
                    ssum[m] += ((x0[bj][0] * x0[bj][0] + x0[bj][1] * x0[bj][1]) + (x0[bj][2] * x0[bj][2] + x0[bj][3] * x0[bj][3])) + ((x1[bj][0] * x1[bj][0] + x1[bj][1] * x1[bj][1]) + (x1[bj][2] * x1[bj][2] + x1[bj][3] * x1[bj][3]));
                    const f32x4 h0 = x0[bj] * gmv[bj][0], h1 = x1[bj] * gmv[bj][1];
                    u32x4 w; w.x = pk2(h0[0], h0[1]); w.y = pk2(h0[2], h0[3]); w.z = pk2(h1[0], h1[1]); w.w = pk2(h1[2], h1[3]);
                    *(u32x4*)(Hout + off + bj * 32) = w; } }
            asm volatile("" ::: "memory");
            if (nxt && m == 3) {
                const bool hi2 = (fq & 2) != 0, hi1 = (fq & 1) != 0;
                const float t0 = hi2 ? ssum[0] : ssum[2], t1 = hi2 ? ssum[1] : ssum[3], k0 = hi2 ? ssum[2] : ssum[0], k1 = hi2 ? ssum[3] : ssum[1];
                const float a0 = k0 + __shfl_xor(t0, 32), a1 = k1 + __shfl_xor(t1, 32);
                const float t = hi1 ? a0 : a1, k = hi1 ? a1 : a0;
                const float rsum = k + __shfl_xor(t, 16);
                rowss_out[(size_t)(u.pm * BM + ai * HALF + wr * 64 + fq * 16 + fr) * 16 + u.pn * 4 + wc] = rsum;
#pragma unroll
                for (int i = 0; i < 4; ++i) ssum[i] = 0.f;
            }
        }
#undef ER_LOAD
    }
};
struct EpiSwiGLU {
    static constexpr bool PERM = true;
    bf16_t* O; const float* rowss; const float* shw;
    DI void warm_phase(int c, int tid) const { warm_panel(rowss, c, tid); warm_shw(shw, GU, c, tid); }
    DI void operator()(const f32x4 (&acc)[2][2][4][2], const Unit& u, int wr, int wc, int fr, int fq) const {
        const int row0 = u.pm * BM + wr * 64 + fr, colh = u.pn * 128 + wc * 16 + 4 * fq, b = (u.pm * BM) / SEQ;
        f32x4 sv[2][2];
#pragma unroll
        for (int bj = 0; bj < 2; ++bj)
#pragma unroll
            for (int n = 0; n < 2; ++n) sv[bj][n] = *(const f32x4*)(shw + (size_t)b * GU + 2 * colh + bj * HALF + 4 * n);
        float rstd8[2][4]; row_rstd8(rowss, row0, fq, rstd8);
#pragma unroll
        for (int ai = 0; ai < 2; ++ai)
#pragma unroll
            for (int m = 0; m < 4; ++m) { const int row = row0 + ai * HALF + m * 16; bf16_t* rowp = O + (size_t)row * DFF + colh;
                const float rstd = rstd8[ai][m];
#pragma unroll
                for (int bj = 0; bj < 2; ++bj) { const f32x4 g = acc[ai][bj][m][0] * rstd + sv[bj][0], uu = acc[ai][bj][m][1] * rstd + sv[bj][1];
                    float a[4];
#pragma unroll
                    for (int i = 0; i < 4; ++i) a[i] = g[i] * sigmoidf_fast(g[i]) * uu[i];
                    u32x2 w; w.x = pk2(a[0], a[1]); w.y = pk2(a[2], a[3]);
                    *(u32x2*)(rowp + bj * 64) = w; } }
    }
};

template <class Epi, class Sched>
DI void gemm_phase(LAS unsigned char* lds, const Gemm g, const Sched& S, const Epi& E) {
    const int tid = opq(threadIdx.x), wid = __builtin_amdgcn_readfirstlane(tid >> 6), lane = tid & 63, wr = wid >> 2, wc = wid & 3, fr = lane & 15, fq = lane >> 4;
    const int K = g.K, nt = K / BK;
    unsigned voffA[2], voffB[2];
#pragma unroll
    for (int i = 0; i < 2; ++i) { int R, C; stage_rc(tid * 16 + i * 8192, R, C); const int Rb = Epi::PERM ? ((R & ~31) + perm32(R & 31)) : R;
        voffA[i] = (unsigned)(R * K + C) * 2u; voffB[i] = (unsigned)(Rb * K + C) * 2u; }
    const size_t kstep = (size_t)(BK * 2);
    const size_t hstep = (size_t)HALF * K * 2;
    const size_t tstep = 2 * hstep;
    const unsigned ldsw = (unsigned)wid * 1024u;
    const int aoff = lds_byte(wr * 64 + fr, fq * 8), boff = lds_byte(wc * 32 + fr, fq * 8);
#define PG8_SA(b, h) (((b) * 2 + (h)) * HTB)
#define PG8_SB(b, h) ((4 + (b) * 2 + (h)) * HTB)
#define PG8_STAGE(bufoff, gbase, voff) do { _Pragma("unroll") for (int _i = 0; _i < 2; ++_i) \
        __builtin_amdgcn_global_load_lds((const unsigned*)((const char*)(gbase) + (voff)[_i]), (LAS unsigned*)(lds + (bufoff) + ldsw + _i * 8192), 16, 0, 0); } while (0)
#define PG8_LDA(dst, b, h) do { _Pragma("unroll") for (int m = 0; m < 4; ++m) _Pragma("unroll") for (int k = 0; k < 2; ++k) dst[m][k] = *(const LAS bf16x8*)(lds + PG8_SA(b, h) + aoff + m * 2048 + k * 1024); } while (0)
#define PG8_LDB(dst, b, h) do { _Pragma("unroll") for (int n = 0; n < 2; ++n) _Pragma("unroll") for (int k = 0; k < 2; ++k) dst[n][k] = *(const LAS bf16x8*)(lds + PG8_SB(b, h) + boff + n * 2048 + k * 1024); } while (0)
#define PG8_MMA(ai, bj, At, Bt) do { __builtin_amdgcn_s_setprio(1); _Pragma("unroll") for (int m = 0; m < 4; ++m) _Pragma("unroll") for (int n = 0; n < 2; ++n) _Pragma("unroll") for (int k = 0; k < 2; ++k) \
        acc[ai][bj][m][n] = __builtin_amdgcn_mfma_f32_16x16x32_bf16(Bt[n][k], At[m][k], acc[ai][bj][m][n], 0, 0, 0); __builtin_amdgcn_s_setprio(0); } while (0)
#define PG8_WAIT_V(n) asm volatile("s_waitcnt vmcnt(" #n ")" ::: "memory")
#define PG8_WAIT_L(n) asm volatile("s_waitcnt lgkmcnt(" #n ")" ::: "memory")
#define PG8_BAR __builtin_amdgcn_s_barrier()
#define PG8_SCHED __builtin_amdgcn_sched_barrier(0)
    Unit cur, nxt; int ui = 0;
    if (!S.next(0, cur)) return;
    E.warm_phase(S.c, tid);
    f32x4 acc[2][2][4][2];
#pragma unroll
    for (int a = 0; a < 2; ++a)
#pragma unroll
        for (int b = 0; b < 2; ++b)
#pragma unroll
            for (int m = 0; m < 4; ++m)
#pragma unroll
                for (int n = 0; n < 2; ++n) acc[a][b][m][n] = (f32x4){0.f, 0.f, 0.f, 0.f};
    bf16x8 At[4][2], B0[2][2], B1[2][2];
    const char* cA = (const char*)g.A + (size_t)cur.pm * tstep; const char* cB = (const char*)g.Bt + (size_t)cur.pn * tstep;
    PG8_STAGE(PG8_SB(0, 0), cB, voffB); PG8_STAGE(PG8_SA(0, 0), cA, voffA); PG8_STAGE(PG8_SB(0, 1), cB + hstep, voffB); PG8_STAGE(PG8_SA(0, 1), cA + hstep, voffA);
    if (wr == 1) PG8_BAR;
    PG8_WAIT_V(4); PG8_BAR;
    PG8_STAGE(PG8_SB(1, 0), cB + kstep, voffB); PG8_STAGE(PG8_SA(1, 0), cA + kstep, voffA); PG8_STAGE(PG8_SB(1, 1), cB + hstep + kstep, voffB);
    PG8_WAIT_V(6); PG8_BAR;
    for (;;) {
        const bool has_next = S.next(ui + 1, nxt);
        const char* nA = has_next ? (const char*)g.A + (size_t)nxt.pm * tstep : cA; const char* nB = has_next ? (const char*)g.Bt + (size_t)nxt.pn * tstep : cB;
        for (int t = 0; t < nt; t += 2) {
            const bool last = (t == nt - 2);
            const char* a1 = cA + (size_t)(t + 1) * kstep;
            const char* a2 = last ? nA : cA + (size_t)(t + 2) * kstep; const char* b2 = last ? nB : cB + (size_t)(t + 2) * kstep;
            const char* a3 = a2 + kstep; const char* b3 = b2 + kstep;
            PG8_LDB(B0, 0, 0); PG8_SCHED; PG8_LDA(At, 0, 0); PG8_STAGE(PG8_SA(1, 1), a1 + hstep, voffA);
            PG8_WAIT_L(8); PG8_BAR; PG8_WAIT_L(0); PG8_MMA(0, 0, At, B0); PG8_BAR; PG8_SCHED;
            PG8_LDB(B1, 0, 1); PG8_STAGE(PG8_SB(0, 0), b2, voffB);
            PG8_BAR; PG8_WAIT_L(0); PG8_MMA(0, 1, At, B1); PG8_BAR;
            PG8_LDA(At, 0, 1); PG8_STAGE(PG8_SA(0, 0), a2, voffA);
            PG8_BAR; PG8_WAIT_L(0); PG8_MMA(1, 0, At, B0); PG8_BAR; PG8_SCHED;
            PG8_STAGE(PG8_SB(0, 1), b2 + hstep, voffB);
            PG8_WAIT_V(6); PG8_BAR; PG8_MMA(1, 1, At, B1); PG8_BAR;
            PG8_LDB(B0, 1, 0); PG8_SCHED; PG8_LDA(At, 1, 0); PG8_STAGE(PG8_SA(0, 1), a2 + hstep, voffA);
            PG8_WAIT_L(8); PG8_BAR; PG8_WAIT_L(0); PG8_MMA(0, 0, At, B0); PG8_BAR; PG8_SCHED;
            PG8_LDB(B1, 1, 1); PG8_STAGE(PG8_SB(1, 0), b3, voffB);
            PG8_BAR; PG8_WAIT_L(0); PG8_MMA(0, 1, At, B1); PG8_BAR;
            PG8_LDA(At, 1, 1); PG8_STAGE(PG8_SA(1, 0), a3, voffA);
            PG8_BAR; PG8_WAIT_L(0); PG8_MMA(1, 0, At, B0); PG8_BAR; PG8_SCHED;
            PG8_STAGE(PG8_SB(1, 1), b3 + hstep, voffB);
            PG8_WAIT_V(6); PG8_BAR; PG8_MMA(1, 1, At, B1); PG8_BAR;
        }
        E(acc, cur, wr, wc, fr, fq);
        if (!has_next) break;
#pragma unroll
        for (int a = 0; a < 2; ++a)
#pragma unroll
            for (int b = 0; b < 2; ++b)
#pragma unroll
                for (int m = 0; m < 4; ++m)
#pragma unroll
                    for (int n = 0; n < 2; ++n) acc[a][b][m][n] = (f32x4){0.f, 0.f, 0.f, 0.f};
        cur = nxt; cA = nA; cB = nB; ++ui;
    }
    PG8_WAIT_V(0);
    if (wr == 0) PG8_BAR;
    PG8_BAR;
#undef PG8_SA
#undef PG8_SB
#undef PG8_STAGE
#undef PG8_LDA
#undef PG8_LDB
#undef PG8_MMA
#undef PG8_WAIT_V
#undef PG8_WAIT_L
#undef PG8_BAR
#undef PG8_SCHED
}
}

template <int MODE>
DI int wrow_map(int n) {
    if (MODE == 0) return n;
    if (MODE == 2) { if (n < 512) { const int isg = n >> 8, j = n & 255; return 8 * (j >> 2) + 4 * isg + (j & 3); }
        if (n >= 768 && n < 1280) { const int ish = (n - 768) >> 8, j = (n - 768) & 255; return 768 + 8 * (j >> 2) + 4 * ish + (j & 3); }
        if (n < 1280 || n >= 2304) return n;
        const int gi = (n - 1280) >> 6, d = (n - 1280) & 63, hi = d >> 5, f = d & 31, bj = f >> 4, fq = (f >> 2) & 3, jj = f & 3;
        return 256 * (5 + (gi >> 2)) + 128 * bj + 32 * (gi & 3) + 8 * fq + 2 * jj + hi; }
    if (MODE == 3) return (n & ~255) + 128 * ((n >> 5) & 1) + 32 * ((n >> 6) & 3) + (n & 31);
    const int isu = n >= DFF ? 1 : 0, j = n - isu * DFF; return 8 * (j >> 2) + 4 * isu + (j & 3); }
template <int MODE>
DI void p0_transpose_item(const float* W, int K, int N, bf16_t* WT, LAS float* scr, int item, int lane) {
    const int nblk = N / 32, kb = item / nblk, nb = item % nblk, k0 = 64 * kb, n0 = 32 * nb;
    float wv[32];
#pragma unroll
    for (int i = 0; i < 32; ++i) wv[i] = W[(size_t)(k0 + 2 * i + (lane >> 5)) * N + n0 + (lane & 31)];
#pragma unroll
    for (int i = 0; i < 32; ++i) scr[(2 * i + (lane >> 5)) * 33 + (lane & 31)] = wv[i];
    asm volatile("s_waitcnt lgkmcnt(0)" ::: "memory");
    const int c = lane & 7;
#pragma unroll
    for (int j = 0; j < 4; ++j) { const int n = (lane >> 3) + 8 * j; const LAS float* s = scr + (8 * c) * 33 + n;
        u32x4 o; o.x = pk2(s[0 * 33], s[1 * 33]); o.y = pk2(s[2 * 33], s[3 * 33]); o.z = pk2(s[4 * 33], s[5 * 33]); o.w = pk2(s[6 * 33], s[7 * 33]);
        *(u32x4*)(WT + (size_t)wrow_map<MODE>(n0 + n) * K + k0 + 8 * c) = o; }
    asm volatile("s_waitcnt lgkmcnt(0)" ::: "memory");
}

DI void phase0(const Params& p, LAS unsigned char* lds) {
    const int tid = opq(threadIdx.x), lane = tid & 63, wave = tid >> 6, G = gridDim.x;
    {
        LAS float* cact = (LAS float*)lds;
        float* mod = (float*)(p.ws + WS_MOD);
        constexpr int NITEM = NL * (MODW / 64);
        for (int it = blockIdx.x; it < NITEM; it += G) {
            const int l = it / (MODW / 64), n0 = (it % (MODW / 64)) * 64;
            for (int idx = tid; idx < NB * DM; idx += 512) { const int k = idx >> 5, b = idx & 31; const float v = p.c[b * DM + k]; cact[idx] = v * sigmoidf_fast(v); }
            __syncthreads();
            float acc[32];
#pragma unroll
            for (int b = 0; b < 32; ++b) acc[b] = 0.f;
            const float* wp = p.w_ada + ((size_t)l * DM + 128 * wave) * MODW + n0 + lane;
            const LAS f32x4* cp = (const LAS f32x4*)(cact + (128 * wave) * 32);
#pragma unroll 1
            for (int kk0 = 0; kk0 < 128; kk0 += 32) {
                float wv[32];
#pragma unroll
                for (int i = 0; i < 32; ++i) wv[i] = wp[(size_t)(kk0 + i) * MODW];
#pragma unroll
                for (int i = 0; i < 32; ++i) {
#pragma unroll
                    for (int q = 0; q < 8; ++q) { const f32x4 cv = cp[(kk0 + i) * 8 + q]; acc[4 * q] += cv[0] * wv[i]; acc[4 * q + 1] += cv[1] * wv[i]; acc[4 * q + 2] += cv[2] * wv[i]; acc[4 * q + 3] += cv[3] * wv[i]; }
                }
            }
            __syncthreads();
            LAS float* red = (LAS float*)lds;
#pragma unroll
            for (int b = 0; b < 32; ++b) red[(wave * 32 + b) * 64 + lane] = acc[b];
            __syncthreads();
#pragma unroll
            for (int j = 0; j < 4; ++j) { const int o = tid + 512 * j, b = o >> 6, n = o & 63; float s = p.b_ada[l * MODW + n0 + n];
#pragma unroll
                for (int w = 0; w < 8; ++w) s += red[(w * 32 + b) * 64 + n];
                mod[((size_t)l * NB + b) * MODW + n0 + n] = s; }
            __syncthreads();
        }
    }
    {
        LAS float* scr = (LAS float*)(lds + wave * 16384);
        const int gw = blockIdx.x * 8 + wave, NGW = G * 8;
        constexpr int I_IN = (DM / 64) * (INW / 32), I_OUT = (DM / 64) * (DM / 32), I_GU = (DM / 64) * (GU / 32), I_DN = (DFF / 64) * (DM / 32);
        constexpr int PER_L = I_IN + I_OUT + I_GU + I_DN;
        for (int it = gw; it < NL * PER_L; it += NGW) {
            const int l = it / PER_L; int r = it % PER_L;
            if (r < I_IN) { p0_transpose_item<2>(p.w_in + (size_t)l * DM * INW, DM, INW, (bf16_t*)(p.ws + WS_WT_IN) + (size_t)l * INW * DM, scr, r, lane); continue; } r -= I_IN;
            if (r < I_OUT) { p0_transpose_item<3>(p.w_out + (size_t)l * DM * DM, DM, DM, (bf16_t*)(p.ws + WS_WT_OUT) + (size_t)l * DM * DM, scr, r, lane); continue; } r -= I_OUT;
            if (r < I_GU) { p0_transpose_item<1>(p.w_gate_up + (size_t)l * DM * GU, DM, GU, (bf16_t*)(p.ws + WS_WT_GU) + (size_t)l * GU * DM, scr, r, lane); continue; } r -= I_GU;
            p0_transpose_item<3>(p.w_down + (size_t)l * DFF * DM, DFF, DM, (bf16_t*)(p.ws + WS_WT_DN) + (size_t)l * DM * DFF, scr, r, lane);
        }
    }
    {
        float* rc = (float*)(p.ws + WS_ROPE); float* rs = rc + SEQ * 32;
        for (int idx = blockIdx.x * 512 + tid; idx < SEQ * 32; idx += G * 512) {
            const int s = idx >> 5, i = idx & 31;
            double inv = 1.0, bpow = 0.7498942093324559;
#pragma unroll
            for (int bit = 0; bit < 5; ++bit) { if ((i >> bit) & 1) inv *= bpow; bpow *= bpow; }
            const double rev = (double)p.pos[s] * inv * 0.15915494309189535;
            const float fr = (float)(rev - floor(rev));
            rc[idx] = __builtin_amdgcn_cosf(fr); rs[idx] = __builtin_amdgcn_sinf(fr);
        }
    }
}

DI void phase_pre(const Params& p) {
    const int tid = opq(threadIdx.x), lane = tid & 63, wave = tid >> 6, G = gridDim.x, NGW = G * 8, gw = blockIdx.x * 8 + wave;
    const float* mod = (const float*)(p.ws + WS_MOD);
    {
        const int r = lane & 31, h = lane >> 5;
        constexpr int NBLK_IN = INW / 32, NBLK_GU = GU / 32, PER_L = NBLK_IN + NBLK_GU;
        for (int it = gw; it < NL * PER_L; it += NGW) {
            const int l = it / PER_L, q = it % PER_L; const bool isgu = q >= NBLK_IN; const int nb = isgu ? q - NBLK_IN : q;
            const bf16_t* W = isgu ? (const bf16_t*)(p.ws + WS_WT_GU) + ((size_t)l * GU + nb * 32 + r) * DM : (const bf16_t*)(p.ws + WS_WT_IN) + ((size_t)l * INW + nb * 32 + r) * DM;
            const float* sh = mod + ((size_t)l * NB + r) * MODW + (isgu ? 3 * DM : 0);
            f32x16 acc;
#pragma unroll
            for (int i = 0; i < 16; ++i) acc[i] = 0.f;
#pragma unroll 8
            for (int ks = 0; ks < DM / 16; ++ks) {
                const int k0 = ks * 16 + h * 8;
                const bf16x8 bfrag = *(const bf16x8*)(W + k0);
                const f32x4 s0 = *(const f32x4*)(sh + k0), s1 = *(const f32x4*)(sh + k0 + 4);
                u32x4 a; a.x = pk2(s0[0], s0[1]); a.y = pk2(s0[2], s0[3]); a.z = pk2(s1[0], s1[1]); a.w = pk2(s1[2], s1[3]);
                acc = __builtin_amdgcn_mfma_f32_32x32x16_bf16(__builtin_bit_cast(bf16x8, a), bfrag, acc, 0, 0, 0);
            }
            float* o = isgu ? (float*)(p.ws + WS_SHW_GU) + (size_t)l * NB * GU : (float*)(p.ws + WS_SHW_IN) + (size_t)l * NB * INW;
            const int ld = isgu ? GU : INW;
#pragma unroll
            for (int i = 0; i < 16; ++i) o[(size_t)((i & 3) + 8 * (i >> 2) + 4 * h) * ld + nb * 32 + r] = acc[i];
        }
    }
    {
        float* gm = (float*)(p.ws + WS_GM);
        for (int idx = blockIdx.x * 512 + tid; idx < NL * 2 * NB * DM; idx += G * 512) {
            const int k = idx & 1023, b = (idx >> 10) & 31, sx = (idx >> 15) & 1, l = idx >> 16;
            const float g = (sx ? p.norm2_g : p.norm1_g)[l * DM + k], sc = mod[((size_t)l * NB + b) * MODW + (sx ? 4 : 1) * DM + k];
            gm[idx] = g * (1.0f + sc);
        }
    }
    {
        bf16_t* H = (bf16_t*)(p.ws + WS_H); float* rowss = (float*)(p.ws + WS_ROWSS);
        for (int rb = gw; rb < MTOK / 32; rb += NGW) {
            const int b = (rb * 32) / SEQ;
            f32x4 gs[4];
#pragma unroll
            for (int j = 0; j < 4; ++j) { const int col = 4 * lane + 256 * j;
                const f32x4 gg = *(const f32x4*)(p.norm1_g + col), sc = *(const f32x4*)(mod + (size_t)b * MODW + DM + col);
                gs[j] = gg * (sc + 1.0f); }
            for (int r = 0; r < 32; r += 4) {
                const size_t row = (size_t)rb * 32 + r;
                const f32x4* xr = (const f32x4*)(p.x + row * DM) + lane;
                f32x4 v[4][4];
#pragma unroll
                for (int q = 0; q < 4; ++q)
#pragma unroll
                    for (int j = 0; j < 4; ++j) v[q][j] = xr[256 * q + 64 * j];
#pragma unroll
                for (int q = 0; q < 4; ++q) { float sq = 0.f;
#pragma unroll
                    for (int j = 0; j < 4; ++j) sq += (v[q][j][0] * v[q][j][0] + v[q][j][1] * v[q][j][1]) + (v[q][j][2] * v[q][j][2] + v[q][j][3] * v[q][j][3]);
                    sq = wave_sum(sq);
                    if (lane < 16) rowss[(row + q) * 16 + lane] = (lane == 0) ? sq : 0.f;
                    u32x2* o8 = (u32x2*)(H + (row + q) * DM) + lane; h16x4* x8 = (h16x4*)((_Float16*)(p.ws + WS_X16) + (row + q) * DM) + lane;
#pragma unroll
                    for (int j = 0; j < 4; ++j) { const f32x4 y = v[q][j] * gs[j]; u32x2 w; w.x = pk2(y[0], y[1]); w.y = pk2(y[2], y[3]); o8[64 * j] = w; x8[64 * j] = __builtin_convertvector(v[q][j], h16x4); } }
            }
        }
    }
}

DI void phase_prep(const Params& p, int l, LAS unsigned char* lds) {
    const int tid = opq(threadIdx.x), lane = tid & 63, wave = tid >> 6, G = gridDim.x;
    const bf16_t* Z = (const bf16_t*)(p.ws + WS_Z);
    bf16_t* MIX = (bf16_t*)(p.ws + WS_MIX);
    LAS float* U = (LAS float*)lds;
    LAS float* CV = (LAS float*)(lds + 65536);
    const int cch = tid & 255, th = tid >> 8;
    float cw[31];
#pragma unroll
    for (int j = 0; j < 31; ++j) cw[j] = p.conv_a_w[((size_t)l * 31 + j) * 256 + cch];
    const float cbias = p.conv_a_b[l * 256 + cch];
    const f32x4 ga = *(const f32x4*)(p.conv_a_norm_g + l * 256 + 4 * lane);
    const f32x4 gb = *(const f32x4*)(p.sc_norm_g + l * 256 + 4 * lane);
    f32x4 wb[3];
#pragma unroll
    for (int j = 0; j < 3; ++j) wb[j] = *(const f32x4*)(p.conv_b_w + ((size_t)l * 3 + j) * 256 + 4 * lane);

    const int pvcu = (G % 8 == 0) ? ((blockIdx.x & 7) * (G >> 3) + (blockIdx.x >> 3)) : blockIdx.x;
    for (int it = pvcu; it < MTOK / 32; it += G) {
        const int b = it >> 6, t0 = (it & 63) * 32;
        const size_t tokbase = (size_t)b * SEQ;
        u32x4 av[4];
#pragma unroll
        for (int k4 = 0; k4 < 4; ++k4) { const int ci = tid + 512 * k4, row = ci >> 5, ch8 = ci & 31, tok = t0 - 15 + row;
            av[k4] = (u32x4){0u, 0u, 0u, 0u};
            if (ci < 62 * 32 && tok >= 0 && tok < SEQ) av[k4] = *(const u32x4*)(Z + (tokbase + tok) * INW + ch8 * 8); }
        const int tw = t0 + wave * 4;
        u32x2 bcg[6], bbg[4];
#pragma unroll
        for (int r = 0; r < 6; ++r) { const int tok = tw - 1 + r; bcg[r] = (u32x2){0u, 0u};
            if (tok >= 0 && tok < SEQ) { const bf16_t* zp = Z + (tokbase + tok) * INW + 512 + 4 * lane; bcg[r] = *(const u32x2*)(zp + 256);
                if (r >= 1 && r <= 4) bbg[r - 1] = *(const u32x2*)zp; } }
#pragma unroll
        for (int k4 = 0; k4 < 4; ++k4) { const int ci = tid + 512 * k4, row = ci >> 5, ch8 = ci & 31;
            if (ci < 62 * 32) { const u32x4 v = av[k4]; f32x4 o0, o1;
                o0[0] = bf_lo(v.x); o0[1] = bf_hi(v.x); o0[2] = bf_lo(v.y); o0[3] = bf_hi(v.y);
                o1[0] = bf_lo(v.z); o1[1] = bf_hi(v.z); o1[2] = bf_lo(v.w); o1[3] = bf_hi(v.w);
                *(LAS f32x4*)(U + row * 256 + ch8 * 8) = o0; *(LAS f32x4*)(U + row * 256 + ch8 * 8 + 4) = o1; } }
        __syncthreads();
#pragma unroll 1
        for (int chunk = 0; chunk < 2; ++chunk) {
            const int tb = th * 16 + chunk * 8;
            float uu[38];
#pragma unroll
            for (int i = 0; i < 38; ++i) uu[i] = U[(tb + i) * 256 + cch];
#pragma unroll
            for (int t = 0; t < 8; ++t) { float a = cbias;
#pragma unroll
                for (int j = 0; j < 31; ++j) a += cw[j] * uu[t + j];
                CV[(tb + t) * 256 + cch] = a; }
        }
        __syncthreads();
#pragma unroll
        for (int q = 0; q < 4; ++q) { const int t = wave * 4 + q;
            const f32x4 v = *(const LAS f32x4*)(CV + t * 256 + 4 * lane);
            const float ss = wave_sum((v[0] * v[0] + v[1] * v[1]) + (v[2] * v[2] + v[3] * v[3]));
            const f32x4 y = v * rsqrtf(ss * (1.f / 256.f) + EPS) * ga;
            f32x4 o;
#pragma unroll
            for (int i = 0; i < 4; ++i) o[i] = y[i] * sigmoidf_fast(y[i]);
            u32x2 w; w.x = pk2(o[0], o[1]); w.y = pk2(o[2], o[3]);
            *(u32x2*)(MIX + (tokbase + t0 + t) * DM + 4 * lane) = w; }
        {
            f32x4 mrow[6], bgv[4];
#pragma unroll
            for (int r = 0; r < 6; ++r) { mrow[r][0] = bf_lo(bcg[r].x); mrow[r][1] = bf_hi(bcg[r].x); mrow[r][2] = bf_lo(bcg[r].y); mrow[r][3] = bf_hi(bcg[r].y); }
#pragma unroll
            for (int q = 0; q < 4; ++q) { bgv[q][0] = bf_lo(bbg[q].x); bgv[q][1] = bf_hi(bbg[q].x); bgv[q][2] = bf_lo(bbg[q].y); bgv[q][3] = bf_hi(bbg[q].y); }
#pragma unroll
            for (int q = 0; q < 4; ++q) {
                const f32x4 y = bgv[q] * (wb[0] * mrow[q] + wb[1] * mrow[q + 1] + wb[2] * mrow[q + 2]);
                const float ss = wave_sum((y[0] * y[0] + y[1] * y[1]) + (y[2] * y[2] + y[3] * y[3]));
                const f32x4 o = y * rsqrtf(ss * (1.f / 256.f) + EPS) * gb;
                u32x2 w; w.x = pk2(o[0], o[1]); w.y = pk2(o[2], o[3]);
                *(u32x2*)(MIX + (tokbase + tw + q) * DM + 256 + 4 * lane) = w; }
        }
        __syncthreads();
    }
}

constexpr int KROW = 272, VROW = 320, KBYTES = 64 * KROW, VBYTES = 64 * VROW, ABUF = KBYTES + VBYTES;
typedef short s16x4 __attribute__((ext_vector_type(4)));
#define MFMA32(a, b, c) __builtin_amdgcn_mfma_f32_32x32x16_bf16((a), (b), (c), 0, 0, 0)

DI void phase_attn(const Params& p, int l, float lambda_init, LAS unsigned char* lds) {
    const int tid = opq(threadIdx.x), lane = tid & 63, wave = tid >> 6, G = gridDim.x, r = lane & 31, h = lane >> 5;
    const int rg = wave >> 1, hf = wave & 1;
    const bf16_t* Z = (const bf16_t*)(p.ws + WS_Z);
    const bf16_t* QH = (const bf16_t*)(p.ws + WS_QH); const bf16_t* KH = (const bf16_t*)(p.ws + WS_KH);
    bf16_t* MIX = (bf16_t*)(p.ws + WS_MIX);
    const float sa = wave_sum(p.lam_q1[l * 64 + lane] * p.lam_k1[l * 64 + lane]), sb = wave_sum(p.lam_q2[l * 64 + lane] * p.lam_k2[l * 64 + lane]);
    const float lam = expf(sa) - expf(sb) + lambda_init;
    const float oscale = 1.0f - lambda_init;
    const int kkey = tid >> 3, kch = tid & 7;
    const int vtr = (4 * (lane >> 5) + ((lane >> 2) & 3)) * VROW + (16 * ((lane >> 4) & 1) + 4 * (lane & 3)) * 2;
    const int vcu = (G % 8 == 0) ? ((blockIdx.x & 7) * (G >> 3) + (blockIdx.x >> 3)) : blockIdx.x;
    LAS float* X = (LAS float*)lds + rg * (128 * 32);

    bf16x8 qf[4]; u32x4 krA[2], vrA[2], krB[2], vrB[2];
#define ATT_ITEM_PTRS(it_) const int qblk = (it_) & 15, head = ((it_) >> 4) & 3, b = (it_) >> 6; const size_t tokb = (size_t)b * SEQ; \
        const size_t qtok = tokb + qblk * 128 + rg * 32 + r; \
        const bf16_t* kg = KH + (tokb + kkey) * 512 + head * 128 + kch * 8; const bf16_t* vg = Z + (tokb + kkey) * INW + 2304 + head * 128 + kch * 8;
#define ATT_LOAD(KR, VR, t_) do { const bf16_t* kg2_ = kg + (size_t)(t_) * 64 * 512; const bf16_t* vg2_ = vg + (size_t)(t_) * 64 * INW; \
            KR[0] = *(const u32x4*)kg2_; KR[1] = *(const u32x4*)(kg2_ + 64); VR[0] = *(const u32x4*)vg2_; VR[1] = *(const u32x4*)(vg2_ + 64); } while (0)
#define ATT_ITEM_PREFETCH() do { ATT_LOAD(krA, vrA, 0); ATT_LOAD(krB, vrB, 1); \
            _Pragma("unroll") for (int kk = 0; kk < 4; ++kk) qf[kk] = *(const bf16x8*)(QH + qtok * 512 + head * 128 + hf * 64 + kk * 16 + h * 8); } while (0)
    if (vcu < NB * 4 * 16) { ATT_ITEM_PTRS(vcu); ATT_ITEM_PREFETCH(); }
    for (int it = vcu; it < NB * 4 * 16; it += G) {
        ATT_ITEM_PTRS(it);
        f32x16 o[4];
#pragma unroll
        for (int eb = 0; eb < 4; ++eb)
#pragma unroll
            for (int i = 0; i < 16; ++i) o[eb][i] = 0.f;
        float lsum = 0.f;
#define ATT_WRITE(KR, VR, buf) do { LAS unsigned char* kb_ = lds + (buf) * ABUF; LAS unsigned char* vb_ = kb_ + KBYTES; \
            *(LAS u32x4*)(kb_ + kkey * KROW + kch * 16) = KR[0]; *(LAS u32x4*)(kb_ + kkey * KROW + kch * 16 + 128) = KR[1]; \
            *(LAS u32x4*)(vb_ + kkey * VROW + kch * 16) = VR[0]; *(LAS u32x4*)(vb_ + kkey * VROW + kch * 16 + 128) = VR[1]; } while (0)
#define ATT_COMPUTE(buf) do { const LAS unsigned char* kb = lds + (buf) * ABUF; LAS unsigned char* vb = lds + (buf) * ABUF + KBYTES; \
            _Pragma("unroll") for (int kbk = 0; kbk < 2; ++kbk) { \
                f32x16 s; \
                _Pragma("unroll") for (int i = 0; i < 16; ++i) s[i] = 0.f; \
                _Pragma("unroll") for (int kk = 0; kk < 4; ++kk) { const bf16x8 a = *(const LAS bf16x8*)(kb + (kbk * 32 + r) * KROW + hf * 128 + kk * 32 + h * 16); s = MFMA32(a, qf[kk], s); } \
                float ls = 0.f; \
                _Pragma("unroll") for (int i = 0; i < 16; ++i) { s[i] = __builtin_amdgcn_exp2f(s[i]); ls += s[i]; } \
                lsum += ls; \
                bf16x8 pf[2]; \
                _Pragma("unroll") for (int st = 0; st < 2; ++st) { u32x4 w; w.x = pk2(s[8 * st], s[8 * st + 1]); w.y = pk2(s[8 * st + 2], s[8 * st + 3]); w.z = pk2(s[8 * st + 4], s[8 * st + 5]); w.w = pk2(s[8 * st + 6], s[8 * st + 7]); \
                    pf[st] = __builtin_bit_cast(bf16x8, w); } \
                _Pragma("unroll") for (int st = 0; st < 2; ++st) \
                    _Pragma("unroll") for (int eb = 0; eb < 4; ++eb) { \
                        const s16x4 vlo = __builtin_amdgcn_ds_read_tr16_b64_v4i16((LAS s16x4*)(vb + vtr + (kbk * 32 + st * 16) * VROW + eb * 64)); \
                        const s16x4 vhi = __builtin_amdgcn_ds_read_tr16_b64_v4i16((LAS s16x4*)(vb + vtr + (kbk * 32 + st * 16 + 8) * VROW + eb * 64)); \
                        const bf16x8 vf = __builtin_shufflevector(vlo, vhi, 0, 1, 2, 3, 4, 5, 6, 7); \
                        o[eb] = MFMA32(vf, pf[st], o[eb]); } \
            } } while (0)
        ATT_WRITE(krA, vrA, 0);
        ATT_LOAD(krA, vrA, 2);
        __syncthreads();
#pragma unroll 1
        for (int t = 0; t < SEQ / 64; t += 2) {
            ATT_COMPUTE(0);
            ATT_WRITE(krB, vrB, 1);
            if (t + 3 < SEQ / 64) ATT_LOAD(krB, vrB, t + 3);
            __syncthreads();
            ATT_COMPUTE(1);
            if (t + 2 < SEQ / 64) { ATT_WRITE(krA, vrA, 0);
                if (t + 4 < SEQ / 64) ATT_LOAD(krA, vrA, t + 4); }
            __syncthreads();
        }
#undef ATT_COMPUTE
        bf16_t* orow = MIX + qtok * DM + 512 + head * 128;
        if (it + G < NB * 4 * 16) { ATT_ITEM_PTRS(it + G); ATT_ITEM_PREFETCH(); }
        const float lt = lsum + __shfl_xor(lsum, 32);
        if (hf == 1) {
            const float sc1 = lam / lt;
#pragma unroll
            for (int eb = 0; eb < 4; ++eb)
#pragma unroll
                for (int i = 0; i < 16; ++i) X[(eb * 32 + (i & 3) + 8 * (i >> 2) + 4 * h) * 32 + r] = o[eb][i] * sc1;
        }
        __syncthreads();
        if (hf == 0) {
            const float i0 = 1.0f / lt;
            float ss = 0.f;
#pragma unroll
            for (int eb = 0; eb < 4; ++eb)
#pragma unroll
                for (int i = 0; i < 16; ++i) { const float v = o[eb][i] * i0 - X[(eb * 32 + (i & 3) + 8 * (i >> 2) + 4 * h) * 32 + r]; o[eb][i] = v; ss += v * v; }
            ss += __shfl_xor(ss, 32);
            const float rn = rsqrtf(ss * (1.f / 128.f) + EPS) * oscale;
#pragma unroll
            for (int eb = 0; eb < 4; ++eb)
#pragma unroll
                for (int g4 = 0; g4 < 4; ++g4) { const int e = eb * 32 + 8 * g4 + 4 * h;
                    const f32x4 gg = *(const f32x4*)(p.attn_norm_g + l * 128 + e);
                    u32x2 w; w.x = pk2(o[eb][4 * g4] * rn * gg[0], o[eb][4 * g4 + 1] * rn * gg[1]); w.y = pk2(o[eb][4 * g4 + 2] * rn * gg[2], o[eb][4 * g4 + 3] * rn * gg[3]);
                    *(u32x2*)(orow + e) = w; }
        }
        __syncthreads();
    }
#undef ATT_WRITE
#undef ATT_LOAD
#undef ATT_ITEM_PTRS
#undef ATT_ITEM_PREFETCH
}

#define XB_TMO      128
#define XB_XCNT(j)  (256  + 64 * (j))
#define XB_XSUB(j)  (1280 + 64 * (j))
#define XB_XGEN(j)  (2304 + 64 * (j))
#define XB_TOP      3328
#define XB_TOPGEN   3392
#define XCD_BAR_WORDS 3456
#define XB_SPIN_CAP (1u << 20)
DI unsigned xb_ld(unsigned* p)              { return __hip_atomic_load(p, __ATOMIC_RELAXED, __HIP_MEMORY_SCOPE_AGENT); }
DI unsigned xb_add(unsigned* p, unsigned v) { return __hip_atomic_fetch_add(p, v, __ATOMIC_RELAXED, __HIP_MEMORY_SCOPE_AGENT); }
DI unsigned xb_xcc_id() { return (unsigned)__builtin_amdgcn_s_getreg((3 << 11) | 20) & 0xFu; }
#define XB_SPIN(cond, bar) do { unsigned _sp = 0; while (cond) { __builtin_amdgcn_s_sleep(1); \
    if ((++_sp & 255u) == 0u) { if (xb_ld(&(bar)[XB_TMO])) break; if (_sp > XB_SPIN_CAP) { atomicAdd(&(bar)[XB_TMO], 1u); break; } } } } while (0)
struct XcdBarrier { unsigned* bar; unsigned x; volatile LAS unsigned* st; };
DI XcdBarrier xcd_barrier_post(unsigned* bar, volatile LAS unsigned* st) {
    XcdBarrier b; b.bar = bar; b.x = xb_xcc_id(); b.st = st;
    if (threadIdx.x == 0) (void)xb_add(&bar[XB_XCNT(b.x)], 1u);
    return b;
}
DI void xcd_barrier_complete(unsigned* bar, unsigned x, unsigned& nloc, unsigned& nx) {
    const unsigned G = gridDim.x * gridDim.y * gridDim.z;
    unsigned sum, cnt, mine, sp = 0u;
    for (;;) {
        sum = 0u; cnt = 0u; mine = 0u;
#pragma unroll
        for (unsigned j = 0; j < 16; ++j) { const unsigned c = xb_ld(&bar[XB_XCNT(j)]); sum += c; cnt += (c > 0u) ? 1u : 0u; mine = (j == x) ? c : mine; }
        if (sum == G) break;
        __builtin_amdgcn_s_sleep(1);
        if ((++sp & 255u) == 0u) { if (xb_ld(&bar[XB_TMO])) break; if (sp > XB_SPIN_CAP) { atomicAdd(&bar[XB_TMO], 1u); break; } }
    }
    nloc = mine > 0u ? mine : 1u; nx = cnt > 0u ? cnt : 1u;
}
DI void xcd_barrier(const XcdBarrier& b) {
    asm volatile("s_waitcnt vmcnt(0)" ::: "memory");
    __syncthreads();
    if (threadIdx.x == 0) {
        unsigned* bar = b.bar;
        __builtin_amdgcn_s_waitcnt(0);
        unsigned nloc = b.st[0], nx = b.st[1];
        if (nloc == 0u) { xcd_barrier_complete(bar, b.x, nloc, nx); b.st[0] = nloc; b.st[1] = nx; }
        const unsigned old = xb_add(&bar[XB_XSUB(b.x)], 1u);
        const unsigned gen = old / nloc;
        if (old + 1u == (gen + 1u) * nloc) {
            __builtin_amdgcn_fence(__ATOMIC_RELEASE, "agent");
            asm volatile("s_waitcnt vmcnt(0)" ::: "memory");
            const unsigned og = xb_add(&bar[XB_TOP], 1u);
            const unsigned tg = og / nx;
            if (og + 1u == (tg + 1u) * nx) xb_add(&bar[XB_TOPGEN], 1u);
            else XB_SPIN(xb_ld(&bar[XB_TOPGEN]) == tg, bar);
            __builtin_amdgcn_fence(__ATOMIC_ACQUIRE, "agent");
            xb_add(&bar[XB_XGEN(b.x)], 1u);
            asm volatile("s_waitcnt vmcnt(0)" ::: "memory");
        } else {
            XB_SPIN(xb_ld(&bar[XB_XGEN(b.x)]) == gen, bar);
            __builtin_amdgcn_fence(__ATOMIC_ACQUIRE, "agent");
            asm volatile("s_waitcnt vmcnt(0)" ::: "memory");
        }
    }
    __syncthreads();
}

__global__ void __launch_bounds__(512, 2) fwd_megakernel(Params p) {
    extern __shared__ __attribute__((aligned(16))) unsigned char shm[];
    LAS unsigned char* lds = (LAS unsigned char*)shm;
    cg::grid_group grid = cg::this_grid();
    const int G = gridDim.x, c = blockIdx.x;
    float* mod = (float*)(p.ws + WS_MOD);
    bf16_t* H = (bf16_t*)(p.ws + WS_H); bf16_t* Zb = (bf16_t*)(p.ws + WS_Z); bf16_t* MIX = (bf16_t*)(p.ws + WS_MIX);
    volatile LAS unsigned* bst = (volatile LAS unsigned*)(lds + 131072);
    if (threadIdx.x < 4) bst[threadIdx.x] = 0u;
    __syncthreads();
    const XcdBarrier xb = xcd_barrier_post((unsigned*)(p.ws + WS_BAR), bst);
    float* rowss = (float*)(p.ws + WS_ROWSS);
    for (int ph = p.ph_lo; ph < p.ph_hi; ++ph) {
        if (ph > p.ph_lo) { if (ph == p.ph_lo + 1) grid.sync(); else xcd_barrier(xb); }
        if (ph == 0) { phase0(p, lds); continue; }
        if (ph == 1) { phase_pre(p); continue; }
        const int l = (ph - 2) / 5, s5 = (ph - 2) % 5, sub = s5 + (s5 >= 2 ? 1 : 0);
        const float* modl = mod + (size_t)l * NB * MODW;
        float* rs1 = rowss + (size_t)(2 * l) * MTOK * 16; float* rs2 = rs1 + (size_t)MTOK * 16;
        const float* gml = (const float*)(p.ws + WS_GM) + (size_t)l * 2 * NB * DM;
        if (sub == 0) { pg8::StaticOrder S; S.init(MTOK, INW, G, c); pg8::Gemm g{H, (const bf16_t*)(p.ws + WS_WT_IN) + (size_t)l * INW * DM, MTOK, INW, DM};
            pg8::EpiZ E{Zb, INW, rs1, (const float*)(p.ws + WS_SHW_IN) + (size_t)l * NB * INW, (bf16_t*)(p.ws + WS_QH), (bf16_t*)(p.ws + WS_KH), p.q_norm_g + l * 64, p.k_norm_g + l * 64, (const float*)(p.ws + WS_ROPE), (const float*)(p.ws + WS_ROPE) + SEQ * 32}; pg8::gemm_phase(lds, g, S, E); }
        else if (sub == 1) { phase_prep(p, l, lds); const float lambda_init = 0.8f - 0.6f * expf(-0.3f * (float)l); phase_attn(p, l, lambda_init, lds); }
        else if (sub == 3 || sub == 5) {
            pg8::StaticOrder S; S.init(MTOK, DM, G, c);
            pg8::Gemm g; pg8::EpiRes E;
            _Float16* X16 = (_Float16*)(p.ws + WS_X16);
            if (sub == 3) { g = pg8::Gemm{MIX, (const bf16_t*)(p.ws + WS_WT_OUT) + (size_t)l * DM * DM, MTOK, DM, DM}; E = pg8::EpiRes{X16, X16, nullptr, modl + 2 * DM, gml + NB * DM, H, rs2}; }
            else { const bool lastl = (l == NL - 1);
                g = pg8::Gemm{Zb, (const bf16_t*)(p.ws + WS_WT_DN) + (size_t)l * DM * DFF, MTOK, DM, DFF};
                E = pg8::EpiRes{X16, X16, lastl ? p.out : nullptr, modl + 5 * DM, lastl ? nullptr : gml + 2 * NB * DM, H, lastl ? nullptr : rs1 + (size_t)2 * MTOK * 16}; }
            pg8::gemm_phase(lds, g, S, E); }
        else { pg8::StaticOrder S; S.init(MTOK, GU, G, c); pg8::Gemm g{H, (const bf16_t*)(p.ws + WS_WT_GU) + (size_t)l * GU * DM, MTOK, GU, DM};
            pg8::EpiSwiGLU E{Zb, rs2, (const float*)(p.ws + WS_SHW_GU) + (size_t)l * NB * GU}; pg8::gemm_phase(lds, g, S, E); }
    }
}

extern "C" void kernel_launch(void* const* d_in, const int* in_sizes, int n_in, void* d_out, int out_size, void* d_ws, size_t ws_size, hipStream_t stream) {
    static int grid = 0;
    if (grid == 0) {
        if (n_in != 23 || ws_size < WS_END) { fprintf(stderr, "kernel_launch: unexpected n_in %d or ws_size %zu < %zu\n", n_in, ws_size, (size_t)WS_END); grid = -1; return; }
        int dev = 0, cus = 0, per_cu = 0;
        if (hipGetDevice(&dev) != hipSuccess || hipDeviceGetAttribute(&cus, hipDeviceAttributeMultiprocessorCount, dev) != hipSuccess) { grid = -1; return; }
        if (hipFuncSetAttribute((const void*)fwd_megakernel, hipFuncAttributeMaxDynamicSharedMemorySize, LDS_BYTES) != hipSuccess) { fprintf(stderr, "kernel_launch: hipFuncSetAttribute failed\n"); grid = -1; return; }
        if (hipOccupancyMaxActiveBlocksPerMultiprocessor(&per_cu, (const void*)fwd_megakernel, 512, LDS_BYTES) != hipSuccess || per_cu < 1) { fprintf(stderr, "kernel_launch: occupancy query says %d\n", per_cu); per_cu = 1; }
        (void)hipGetLastError();
        grid = cus;
    }
    if (grid < 0) return;
    if (hipMemsetAsync((char*)d_ws + WS_BAR, 0, 16384, stream) != hipSuccess) { fprintf(stderr, "kernel_launch: memset of the barrier word failed\n"); return; }
    Params p{};
    p.x = (const float*)d_in[0]; p.c = (const float*)d_in[1]; p.pos = (const int*)d_in[2];
    p.norm1_g = (const float*)d_in[3]; p.norm2_g = (const float*)d_in[4]; p.w_ada = (const float*)d_in[5]; p.b_ada = (const float*)d_in[6];
    p.w_in = (const float*)d_in[7]; p.conv_a_w = (const float*)d_in[8]; p.conv_a_b = (const float*)d_in[9]; p.conv_a_norm_g = (const float*)d_in[10];
    p.conv_b_w = (const float*)d_in[11]; p.sc_norm_g = (const float*)d_in[12]; p.q_norm_g = (const float*)d_in[13]; p.k_norm_g = (const float*)d_in[14];
    p.lam_q1 = (const float*)d_in[15]; p.lam_k1 = (const float*)d_in[16]; p.lam_q2 = (const float*)d_in[17]; p.lam_k2 = (const float*)d_in[18];
    p.attn_norm_g = (const float*)d_in[19]; p.w_out = (const float*)d_in[20]; p.w_gate_up = (const float*)d_in[21]; p.w_down = (const float*)d_in[22];
    p.out = (float*)d_out; p.ws = (unsigned char*)d_ws;
#if MK_MULTI
    for (int ph = 0; ph < NPHASE; ++ph) {
        p.ph_lo = ph; p.ph_hi = ph + 1;
        hipLaunchKernelGGL(fwd_megakernel, dim3(grid), dim3(512), LDS_BYTES, stream, p);
    }
#else
    p.ph_lo = 0; p.ph_hi = NPHASE;
    void* args[] = {&p};
    hipError_t e = hipLaunchCooperativeKernel((const void*)fwd_megakernel, dim3(grid), dim3(512), args, LDS_BYTES, stream);
    if (e != hipSuccess) fprintf(stderr, "kernel_launch: cooperative launch failed: %s (grid %d)\n", hipGetErrorString(e), grid);
#endif
}
```
